# Optimizing an MI355X kernel written in HIP

```python
import jax, jax.numpy as jnp
from jax import lax
import numpy as np

D_MODEL = 2048
BATCH = 8
SEQ = 2048
DEPTH = 1

PLE_DIM = 256
BLK = 128
EPS = 1e-6

A_HEAD_DIM = 128
A_WIDTH = D_MODEL // 2
A_HEADS = A_WIDTH // A_HEAD_DIM
A_BRANCHES = ((128, 1), (512, 4), (2048, 16))

B_HEAD_DIM = 64
B_WIDTH = D_MODEL - A_WIDTH
B_HEADS = B_WIDTH // B_HEAD_DIM
B_GROUP = 8
B_KV_HEADS = B_HEADS // B_GROUP
B_WINDOW = 128

MIX_WIDTH = A_WIDTH + B_WIDTH
IN_COLS = 3 * A_WIDTH + B_WIDTH + 2 * B_KV_HEADS * B_HEAD_DIM

N_GROUPS = 4
EXPERTS_PER_GROUP = 8
N_EXPERTS = N_GROUPS * EXPERTS_PER_GROUP
TOP_K = 2
D_EXPERT = D_MODEL // 8

kernel_name = "hymba_dilated_sinkswa_hiermoe_ple"


def rms_norm(x, g):
    xf = x.astype(jnp.float32)
    y = xf * lax.rsqrt(jnp.mean(xf * xf, axis=-1, keepdims=True) + EPS)
    return (y * g.astype(jnp.float32)).astype(x.dtype)


def alibi_slopes(n):
    return jnp.asarray(np.array([2.0 ** (-8.0 * (i + 1) / n) for i in range(n)], dtype=np.float32))


def _with_prev_block(xb):
    prev = jnp.pad(xb[:, :, :-1], ((0, 0), (0, 0), (1, 0), (0, 0), (0, 0)))
    return jnp.concatenate([prev, xb], axis=3)


def banded_attention(q, k, v, slopes, max_delta, stride, sinks=None):
    n, hkv, g, L, hd = q.shape
    nb = L // BLK
    qb = q.reshape(n, hkv, g, nb, BLK, hd)
    kb = _with_prev_block(k.reshape(n, hkv, nb, BLK, hd))
    vb = _with_prev_block(v.reshape(n, hkv, nb, BLK, hd))
    s = jnp.einsum('nkgbqd,nkbsd->nkgbqs', qb, kb,
                   preferred_element_type=jnp.float32) * (hd ** -0.5)
    qi = jnp.arange(L).reshape(nb, BLK)
    ki = qi[:, :1] - BLK + jnp.arange(2 * BLK)[None, :]
    delta = qi[:, :, None] - ki[:, None, :]
    valid = (delta >= 0) & (delta <= max_delta) & (ki[:, None, :] >= 0)
    s = s - slopes.astype(jnp.float32)[:, :, None, None, None] * (stride * delta).astype(jnp.float32)
    s = jnp.where(valid, s, -jnp.inf)
    m = jnp.max(s, axis=-1)
    if sinks is not None:
        sk = sinks.astype(jnp.float32)[:, :, None, None]
        m = jnp.maximum(m, sk)
    pr = jnp.exp(s - m[..., None])
    den = jnp.sum(pr, axis=-1)
    if sinks is not None:
        den = den + jnp.exp(sk - m)
    o = jnp.einsum('nkgbqs,nkbsd->nkgbqd', pr.astype(v.dtype), vb,
                   preferred_element_type=jnp.float32) / den[..., None]
    lse = m + jnp.log(den)
    return o.reshape(n, hkv, g, L, hd).astype(q.dtype), lse.reshape(n, hkv, g, L)


def dilated_branch(q, k, v, slopes, window, dilation):
    b, h, s, hd = q.shape
    span = dilation * BLK
    sp = -(-s // span) * span
    L = sp // dilation

    def to_residues(t):
        t = jnp.pad(t, ((0, 0), (0, 0), (0, sp - s), (0, 0)))
        t = t.reshape(b, h, L, dilation, hd).transpose(0, 3, 1, 2, 4)
        return t.reshape(b * dilation, h, L, hd)

    qr, kr, vr = to_residues(q), to_residues(k), to_residues(v)
    o, lse = banded_attention(qr[:, :, None], kr, vr, slopes[:, None], window // dilation, dilation)
    o = o[:, :, 0].reshape(b, dilation, h, L, hd).transpose(0, 2, 3, 1, 4).reshape(b, h, sp, hd)[:, :, :s]
    lse = lse[:, :, 0].reshape(b, dilation, h, L).transpose(0, 2, 3, 1).reshape(b, h, sp)[:, :, :s]
    return o, lse


def dilated_attention(q, k, v, slopes):
    outs, lses = [], []
    for window, dilation in A_BRANCHES:
        o, lse = dilated_branch(q, k, v, slopes, window, dilation)
        outs.append(o)
        lses.append(lse)
    w = jax.nn.softmax(jnp.stack(lses), axis=0)
    return jnp.einsum('rbhs,rbhsd->bhsd', w.astype(q.dtype), jnp.stack(outs))


def sink_window_attention(q, k, v, slopes, sinks):
    b, hq, s, hd = q.shape
    qg = q.reshape(b, B_KV_HEADS, B_GROUP, s, hd)
    o, _ = banded_attention(qg, k, v, slopes.reshape(B_KV_HEADS, B_GROUP), B_WINDOW - 1, 1,
                            sinks.reshape(B_KV_HEADS, B_GROUP))
    return o.reshape(b, hq, s, hd)


def hier_moe(x, w_grp, b_grp, w_exp, b_exp, w_gate, w_up, w_down):
    t = x.shape[0]
    grp_logits = jnp.dot(x, w_grp, preferred_element_type=jnp.float32) + b_grp.astype(jnp.float32)
    grp_prob = jax.nn.softmax(grp_logits, axis=-1)
    grp_idx = jnp.argmax(grp_logits, axis=-1)
    grp_w = jnp.take_along_axis(grp_prob, grp_idx[:, None], axis=-1)
    exp_logits = jnp.einsum('td,dge->tge', x, w_exp,
                            preferred_element_type=jnp.float32) + b_exp.astype(jnp.float32)
    in_grp = jnp.take_along_axis(exp_logits, grp_idx[:, None, None], axis=1)[:, 0]
    top_val, top_idx = lax.top_k(in_grp, TOP_K)
    top_w = jax.nn.softmax(top_val, axis=-1) * grp_w
    eid = grp_idx[:, None] * EXPERTS_PER_GROUP + top_idx
    combine = jnp.sum(jax.nn.one_hot(eid, N_EXPERTS, dtype=jnp.float32) * top_w[..., None], axis=1)
    hg = jnp.einsum('td,edf->tef', x, w_gate)
    hu = jnp.einsum('td,edf->tef', x, w_up)
    hid = jax.nn.silu(hg) * hu * combine.astype(x.dtype)[..., None]
    return jnp.einsum('tef,efd->td', hid, w_down)


def setup_inputs(seed: int = 0) -> dict:
    key = jax.random.key(seed)
    ks = jax.random.split(key, 20)

    def nrm(k, shape, scale):
        return jax.random.normal(k, shape, jnp.float32) * scale

    return {
        "x": nrm(ks[0], (BATCH, SEQ, D_MODEL), 1.0),
        "p": nrm(ks[1], (DEPTH, BATCH, SEQ, PLE_DIM), 1.0),
        "w_in": nrm(ks[2], (DEPTH, D_MODEL, IN_COLS), D_MODEL ** -0.5),
        "w_out": nrm(ks[3], (DEPTH, MIX_WIDTH, D_MODEL), MIX_WIDTH ** -0.5),
        "sinks": nrm(ks[4], (DEPTH, B_HEADS), 1.0),
        "g_mix": 1.0 + nrm(ks[5], (DEPTH, D_MODEL), 0.02),
        "g_moe": 1.0 + nrm(ks[6], (DEPTH, D_MODEL), 0.02),
        "g_ple": 1.0 + nrm(ks[7], (DEPTH, D_MODEL), 0.02),
        "g_final": 1.0 + nrm(ks[8], (D_MODEL,), 0.02),
        "w_grp": nrm(ks[9], (DEPTH, D_MODEL, N_GROUPS), D_MODEL ** -0.5),
        "b_grp": nrm(ks[10], (DEPTH, N_GROUPS), 0.01),
        "w_exp": nrm(ks[11], (DEPTH, D_MODEL, N_GROUPS, EXPERTS_PER_GROUP), D_MODEL ** -0.5),
        "b_exp": nrm(ks[12], (DEPTH, N_GROUPS, EXPERTS_PER_GROUP), 0.01),
        "w_gate": nrm(ks[13], (DEPTH, N_EXPERTS, D_MODEL, D_EXPERT), D_MODEL ** -0.5),
        "w_up": nrm(ks[14], (DEPTH, N_EXPERTS, D_MODEL, D_EXPERT), D_MODEL ** -0.5),
        "w_down": nrm(ks[15], (DEPTH, N_EXPERTS, D_EXPERT, D_MODEL), D_EXPERT ** -0.5),
        "w_ple": nrm(ks[16], (DEPTH, PLE_DIM, D_MODEL), PLE_DIM ** -0.5),
        "w_ple_gate": nrm(ks[17], (DEPTH, D_MODEL, D_MODEL), D_MODEL ** -0.5),
    }


def reference(x, p, w_in, w_out, sinks, g_mix, g_moe, g_ple, g_final, w_grp, b_grp,
              w_exp, b_exp, w_gate, w_up, w_down, w_ple, w_ple_gate):
    b, s, d = x.shape
    slopes_a = alibi_slopes(A_HEADS)
    slopes_b = alibi_slopes(B_HEADS)
    kv_w = B_KV_HEADS * B_HEAD_DIM
    splits = [A_WIDTH, 2 * A_WIDTH, 3 * A_WIDTH, 3 * A_WIDTH + B_WIDTH, 3 * A_WIDTH + B_WIDTH + kv_w]

    def heads(t, n, hd):
        return t.reshape(b, s, n, hd).transpose(0, 2, 1, 3)

    h = x
    for i in range(DEPTH):
        a = rms_norm(h, g_mix[i])
        proj = a @ w_in[i]
        qa, ka, va, qb, kb, vb = jnp.split(proj, splits, axis=-1)
        oa = dilated_attention(heads(qa, A_HEADS, A_HEAD_DIM), heads(ka, A_HEADS, A_HEAD_DIM),
                               heads(va, A_HEADS, A_HEAD_DIM), slopes_a)
        ob = sink_window_attention(heads(qb, B_HEADS, B_HEAD_DIM), heads(kb, B_KV_HEADS, B_HEAD_DIM),
                                   heads(vb, B_KV_HEADS, B_HEAD_DIM), slopes_b, sinks[i])
        mixed = jnp.concatenate([oa.transpose(0, 2, 1, 3).reshape(b, s, A_WIDTH),
                                 ob.transpose(0, 2, 1, 3).reshape(b, s, B_WIDTH)], axis=-1)
        h = h + mixed @ w_out[i]
        m = rms_norm(h, g_moe[i]).reshape(b * s, d)
        h = h + hier_moe(m, w_grp[i], b_grp[i], w_exp[i], b_exp[i],
                         w_gate[i], w_up[i], w_down[i]).reshape(b, s, d)
        n = rms_norm(h, g_ple[i])
        h = h + jax.nn.sigmoid(n @ w_ple_gate[i]) * (p[i] @ w_ple[i])
    return rms_norm(h, g_final)
```

```cpp
#include <hip/hip_runtime.h>
#include <cstdint>
#include <cstdio>
#include <cmath>

typedef _Float16 h16;
typedef _Float16 half8 __attribute__((ext_vector_type(8)));
typedef _Float16 h16x4 __attribute__((ext_vector_type(4)));
typedef _Float16 h16x2 __attribute__((ext_vector_type(2)));
typedef float f32x4 __attribute__((ext_vector_type(4)));
typedef float f32x2 __attribute__((ext_vector_type(2)));
typedef float f32x16 __attribute__((ext_vector_type(16)));
typedef unsigned u32x4 __attribute__((ext_vector_type(4)));
typedef unsigned u32x2 __attribute__((ext_vector_type(2)));
#define UNR _Pragma("unroll")

constexpr int BATCH = 8, SEQ = 2048, T = BATCH * SEQ, D = 2048, PLE = 256;
constexpr int AH = 8, AHD = 128, BH = 16, BHD = 64, BKV = 2, BG = 8;
constexpr int NIN = 4352;
constexpr int NE = 32, DE = 256;
constexpr float EPS = 1e-6f;
constexpr float LOG2E = 1.4426950408889634f;
constexpr float QSCALE_A = 0.08838834764831845f * LOG2E;
constexpr float QSCALE_B = 0.125f * LOG2E;

constexpr size_t MiB = 1u << 20;
constexpr size_t WS_CTL = 0, CTL_ZERO_BYTES = 1 * MiB;
constexpr size_t CTL_CNT = 64 * 1024, CTL_SSQ = 128 * 1024;
constexpr size_t WS_R1 = 1 * MiB, WS_R2 = WS_R1 + 64 * 1024, WS_R3 = WS_R2 + 64 * 1024;
constexpr size_t WS_LTOK = 2 * MiB, WS_LW = 4 * MiB, WS_WR = 6 * MiB;
constexpr size_t WS_WIN = 8 * MiB, WS_WOUT = 25 * MiB, WS_WGU = 33 * MiB, WS_WD = 97 * MiB, WS_WPLE = 129 * MiB, WS_WPG = 130 * MiB;
constexpr size_t WS_P16 = 138 * MiB, WS_PW16 = 146 * MiB;
constexpr size_t WS_RA = 210 * MiB;
constexpr size_t WS_RB = 274 * MiB;
constexpr size_t WS_RD = 410 * MiB;
constexpr size_t WS_END = 474 * MiB;

namespace nv {

__device__ __forceinline__ float wave_sum(float v) {
#pragma unroll
    for (int o = 1; o < 64; o <<= 1) v += __shfl_xor(v, o);
    return v;
}
__device__ __forceinline__ float wave_max(float v) {
#pragma unroll
    for (int o = 1; o < 64; o <<= 1) v = fmaxf(v, __shfl_xor(v, o));
    return v;
}

__global__ __launch_bounds__(256) void k_prep_x(const float* __restrict__ x, h16* __restrict__ x16, float* __restrict__ r1,
                                                const float* __restrict__ p, h16* __restrict__ p16) {
    const int wid = threadIdx.x >> 6, lane = threadIdx.x & 63;
    const int row = blockIdx.x * 4 + wid;
    if (row >= T) return;
    const float* xr = x + (size_t)row * D;
    float ss = 0.f;
    for (int j = 0; j < D / 256; ++j) {
        const f32x4 v = *(const f32x4*)(xr + j * 256 + lane * 4);
        ss += v.x * v.x + v.y * v.y + v.z * v.z + v.w * v.w;
        h16x4 o = {(h16)v.x, (h16)v.y, (h16)v.z, (h16)v.w};
        *(h16x4*)(x16 + (size_t)row * D + j * 256 + lane * 4) = o;
    }
    ss = wave_sum(ss);
    if (lane == 0) r1[row] = 1.0f / sqrtf(ss * (1.0f / D) + EPS);
    {
        const f32x4 v = *(const f32x4*)(p + (size_t)row * PLE + lane * 4);
        h16x4 o = {(h16)v.x, (h16)v.y, (h16)v.z, (h16)v.w};
        *(h16x4*)(p16 + (size_t)row * PLE + lane * 4) = o;
    }
}

struct TrJob { const float* src; const float* src2; h16* dst; const float* gain; int pitch, K, N, mode; long src_z, dst_z; };
__global__ __launch_bounds__(256) void k_transpose(TrJob j) {
    __shared__ float tile[64][65];
    const int z = blockIdx.z;
    const int k0 = blockIdx.y * 64, n0 = blockIdx.x * 64;
    const int tx = threadIdx.x & 63, ty = threadIdx.x >> 6;
    const float* src = j.src; const float* src2 = j.src2; h16* dst = j.dst + (size_t)z * j.dst_z;
    int pn = 0;
    if (j.mode == 2) { const int e = z >> 1; pn = z & 1; src += (size_t)e * j.src_z; src2 += (size_t)e * j.src_z; }
    else { src += (size_t)z * j.src_z; }
    {
        const int n = n0 + tx;
        const float* s = src; int col = n;
        if (j.mode == 2) { s = (n < 128) ? src : src2; col = 128 * pn + (n & 127); }
        float cs = 1.f;
        if (j.mode == 1) { if (n < 1024) cs = QSCALE_A; else if (n >= 3072 && n < 4096) cs = QSCALE_B; }
        for (int i = 0; i < 16; ++i) {
            const int k = k0 + ty + 4 * i;
            float v = s[(size_t)k * j.pitch + col] * cs;
            if (j.gain) v *= j.gain[k];
            tile[ty + 4 * i][tx] = v;
        }
    }
    __syncthreads();
    for (int i = 0; i < 16; ++i) {
        const int n = n0 + ty + 4 * i;
        dst[(size_t)n * j.K + k0 + tx] = (h16)tile[tx][ty + 4 * i];
    }
}
__global__ void k_router_w(const float* __restrict__ w_grp, const float* __restrict__ w_exp, const float* __restrict__ g, float* __restrict__ Wr) {
    const int idx = blockIdx.x * blockDim.x + threadIdx.x;
    if (idx >= 36 * D) return;
    const int c = idx / D, k = idx % D;
    const float v = (c < 4) ? w_grp[(size_t)k * 4 + c] : w_exp[(size_t)k * 32 + (c - 4)];
    Wr[idx] = v * g[k];
}

template <class Op> __global__ __launch_bounds__(256) void k_gemm(Op op) {
    const int z = blockIdx.z;
    const int M = op.mrows(z);
    const int row0 = blockIdx.y * 128; if (row0 >= M) return;
    const int col0 = blockIdx.x * 128;
    const int wid = threadIdx.x >> 6, lane = threadIdx.x & 63, wy = wid >> 1, wx = wid & 1, fr = lane & 15, fq = lane >> 4;
    f32x4 acc[4][4];
#pragma unroll
    for (int a = 0; a < 4; ++a)
#pragma unroll
        for (int b = 0; b < 4; ++b) acc[a][b] = (f32x4){0.f, 0.f, 0.f, 0.f};
    const h16* ap[4]; const h16* bp[4];
#pragma unroll
    for (int mi = 0; mi < 4; ++mi) ap[mi] = op.arow(z, row0 + wy * 64 + mi * 16 + fr) + fq * 8;
#pragma unroll
    for (int ni = 0; ni < 4; ++ni) bp[ni] = op.brow(z, col0 + wx * 64, ni, fr) + fq * 8;
    for (int k0 = 0; k0 < op.K; k0 += 32) {
        half8 a[4], b[4];
#pragma unroll
        for (int i = 0; i < 4; ++i) { a[i] = *(const half8*)(ap[i] + k0); b[i] = *(const half8*)(bp[i] + k0); }
#pragma unroll
        for (int mi = 0; mi < 4; ++mi)
#pragma unroll
            for (int ni = 0; ni < 4; ++ni) acc[mi][ni] = __builtin_amdgcn_mfma_f32_16x16x32_f16(a[mi], b[ni], acc[mi][ni], 0, 0, 0);
    }
    op.epi(z, row0 + wy * 64, col0 + wx * 64, acc, fr, fq);
}

struct OpBase { int K; };
struct OpG1 : OpBase {
    const h16* A; const h16* Bt; const float* r1; h16* out;
    __device__ int mrows(int) const { return T; }
    __device__ const h16* arow(int, int r) const { return A + (size_t)r * D; }
    __device__ const h16* brow(int, int cb, int ni, int fr) const { return Bt + (size_t)(cb + ni * 16 + fr) * D; }
    __device__ void epi(int, int rb, int cb, f32x4 (&acc)[4][4], int fr, int fq) const {
        UNR for (int mi = 0; mi < 4; ++mi) UNR for (int r = 0; r < 4; ++r) { const int row = rb + mi * 16 + fq * 4 + r; const float s = r1[row];
            UNR for (int ni = 0; ni < 4; ++ni) out[(size_t)row * NIN + cb + ni * 16 + fr] = (h16)(acc[mi][ni][r] * s); }
    }
};
struct OpG3 : OpBase {
    const h16* A; const h16* Bt; const float* x; h16* out;
    __device__ int mrows(int) const { return T; }
    __device__ const h16* arow(int, int r) const { return A + (size_t)r * D; }
    __device__ const h16* brow(int, int cb, int ni, int fr) const { return Bt + (size_t)(cb + ni * 16 + fr) * D; }
    __device__ void epi(int, int rb, int cb, f32x4 (&acc)[4][4], int fr, int fq) const {
        UNR for (int mi = 0; mi < 4; ++mi) UNR for (int r = 0; r < 4; ++r) { const int row = rb + mi * 16 + fq * 4 + r;
            UNR for (int ni = 0; ni < 4; ++ni) { const size_t o = (size_t)row * D + cb + ni * 16 + fr; out[o] = (h16)(x[o] + acc[mi][ni][r]); } }
    }
};
__device__ __forceinline__ void moe_offsets(const int* cnt, int e, int& off, int& n) {
    int o = 0; for (int i = 0; i < e; ++i) o += (cnt[i] + 255) & ~255; off = o; n = cnt[e];
}
struct OpMU : OpBase {
    const h16* A; const h16* Wgu; const int* cnt; const int* ltok; const float* lw; const float* r2; h16* hid;
    __device__ int mrows(int z) const { return cnt[z]; }
    __device__ const h16* arow(int z, int r) const { const int n = cnt[z]; const int tok = (r < n) ? (ltok[(size_t)z * T + r] & 0x3fff) : 0; return A + (size_t)tok * D; }
    __device__ const h16* brow(int z, int cb, int ni, int fr) const {
        const int hc = (cb >> 6) * 32 + (ni & 1) * 16 + fr; const int pn = hc >> 7, i = hc & 127;
        return Wgu + ((size_t)(z * 2 + pn) * 256 + (ni >> 1) * 128 + i) * D;
    }
    __device__ void epi(int z, int rb, int cb, f32x4 (&acc)[4][4], int fr, int fq) const {
        int off, n; moe_offsets(cnt, z, off, n);
        UNR for (int mi = 0; mi < 4; ++mi) UNR for (int r = 0; r < 4; ++r) { const int pos = rb + mi * 16 + fq * 4 + r; if (pos >= n) continue;
            const int tok = ltok[(size_t)z * T + pos] & 0x3fff; const float s = r2[tok], w = lw[(size_t)z * T + pos];
            UNR for (int ni = 0; ni < 2; ++ni) { const float g = acc[mi][ni][r] * s, u = acc[mi][ni + 2][r] * s;
                const float v = g / (1.f + __expf(-g)) * u * w; const int hc = (cb >> 6) * 32 + ni * 16 + fr;
                hid[(size_t)(off + pos) * DE + hc] = (h16)v; } }
    }
};
struct OpMD : OpBase {
    const h16* hid; const h16* Wd; const int* cnt; const int* ltok; h16* y;
    __device__ int mrows(int z) const { return cnt[z]; }
    __device__ const h16* arow(int z, int r) const { int off, n; moe_offsets(cnt, z, off, n); return hid + (size_t)(off + r) * DE; }
    __device__ const h16* brow(int z, int cb, int ni, int fr) const { return Wd + ((size_t)z * D + cb + ni * 16 + fr) * DE; }
    __device__ void epi(int z, int rb, int cb, f32x4 (&acc)[4][4], int fr, int fq) const {
        const int n = cnt[z];
        UNR for (int mi = 0; mi < 4; ++mi) UNR for (int r = 0; r < 4; ++r) { const int pos = rb + mi * 16 + fq * 4 + r; if (pos >= n) continue;
            const int lt = ltok[(size_t)z * T + pos]; const int tok = lt & 0x3fff, slot = (lt >> 30) & 1;
            UNR for (int ni = 0; ni < 4; ++ni) y[((size_t)slot * T + tok) * D + cb + ni * 16 + fr] = (h16)acc[mi][ni][r]; }
    }
};
struct OpPW : OpBase {
    const h16* A; const h16* Bt; h16* out;
    __device__ int mrows(int) const { return T; }
    __device__ const h16* arow(int, int r) const { return A + (size_t)r * PLE; }
    __device__ const h16* brow(int, int cb, int ni, int fr) const { return Bt + (size_t)(cb + ni * 16 + fr) * PLE; }
    __device__ void epi(int, int rb, int cb, f32x4 (&acc)[4][4], int fr, int fq) const {
        UNR for (int mi = 0; mi < 4; ++mi) UNR for (int r = 0; r < 4; ++r) { const int row = rb + mi * 16 + fq * 4 + r;
            UNR for (int ni = 0; ni < 4; ++ni) out[(size_t)row * D + cb + ni * 16 + fr] = (h16)acc[mi][ni][r]; }
    }
};
struct OpG5 : OpBase {
    const h16* A; const h16* Bt; const float* r3; const h16* pw; float* out; float* ssq;
    __device__ int mrows(int) const { return T; }
    __device__ const h16* arow(int, int r) const { return A + (size_t)r * D; }
    __device__ const h16* brow(int, int cb, int ni, int fr) const { return Bt + (size_t)(cb + ni * 16 + fr) * D; }
    __device__ void epi(int, int rb, int cb, f32x4 (&acc)[4][4], int fr, int fq) const {
        UNR for (int mi = 0; mi < 4; ++mi) UNR for (int r = 0; r < 4; ++r) { const int row = rb + mi * 16 + fq * 4 + r; const float s = r3[row]; float q = 0.f;
            UNR for (int ni = 0; ni < 4; ++ni) { const size_t o = (size_t)row * D + cb + ni * 16 + fr; const float g = 1.f / (1.f + __expf(-acc[mi][ni][r] * s));
                const float h3 = (float)A[o] + g * (float)pw[o]; out[o] = h3; q += h3 * h3; }
            q += __shfl_xor(q, 1); q += __shfl_xor(q, 2); q += __shfl_xor(q, 4); q += __shfl_xor(q, 8);
            if (fr == 0) atomicAdd(ssq + row, q); }
    }
};

template <int HD, int NBR, int NJ> __global__ __launch_bounds__(256) void k_attn(const h16* __restrict__ proj, h16* __restrict__ mixed, const float* __restrict__ sinks) {
    constexpr int NH = (NBR == 3) ? AH : BH;
    __shared__ float qs[4][HD];
    __shared__ float sc[4][NBR * NJ + 1];
    const int wid = threadIdx.x >> 6, lane = threadIdx.x & 63;
    const int id = blockIdx.x * 4 + wid;
    const int tok = id / NH, head = id % NH;
    const int b = tok / SEQ, tpos = tok % SEQ;
    int qcol, kcol, vcol, ocol; float slope2, sink2 = -INFINITY;
    if (NBR == 3) { qcol = head * 128; kcol = 1024 + head * 128; vcol = 2048 + head * 128; ocol = head * 128; slope2 = exp2f(-(float)(head + 1)) * LOG2E; }
    else { const int kv = head / BG; qcol = 3072 + head * 64; kcol = 4096 + kv * 64; vcol = 4224 + kv * 64; ocol = 1024 + head * 64;
           slope2 = exp2f(-0.5f * (float)(head + 1)) * LOG2E; sink2 = sinks[head] * LOG2E; }
    const h16* base = proj + (size_t)b * SEQ * NIN;
    for (int d = lane; d < HD; d += 64) qs[wid][d] = (float)base[(size_t)tpos * NIN + qcol + d];
    __syncthreads();
    float mx = -INFINITY;
    for (int i = lane; i < NBR * NJ; i += 64) {
        const int br = i / NJ, j = i % NJ; const int dil = (br == 0) ? 1 : (br == 1 ? 4 : 16);
        const int s = tpos - dil * j; float v = -INFINITY;
        if (s >= 0) { const h16* kr = base + (size_t)s * NIN + kcol; float a = 0.f;
            for (int d = 0; d < HD; d += 8) { const half8 kk = *(const half8*)(kr + d);
#pragma unroll
                for (int e = 0; e < 8; ++e) a += qs[wid][d + e] * (float)kk[e]; }
            v = a - slope2 * (float)(dil * j); }
        sc[wid][i] = v; mx = fmaxf(mx, v);
    }
    mx = wave_max(mx); mx = fmaxf(mx, sink2);
    __syncthreads();
    float sum = 0.f;
    for (int i = lane; i < NBR * NJ; i += 64) { const float pv = exp2f(sc[wid][i] - mx); sc[wid][i] = pv; sum += pv; }
    sum = wave_sum(sum); sum += exp2f(sink2 - mx);
    __syncthreads();
    constexpr int DPL = HD / 64;
    float o[DPL]; UNR for (int e = 0; e < DPL; ++e) o[e] = 0.f;
    for (int i = 0; i < NBR * NJ; ++i) {
        const float pv = sc[wid][i]; if (pv == 0.f) continue;
        const int br = i / NJ, j = i % NJ; const int dil = (br == 0) ? 1 : (br == 1 ? 4 : 16);
        const int s = tpos - dil * j; const h16* vr = base + (size_t)s * NIN + vcol + lane * DPL;
        UNR for (int e = 0; e < DPL; ++e) o[e] += pv * (float)vr[e];
    }
    const float inv = 1.f / sum;
    UNR for (int e = 0; e < DPL; ++e) mixed[(size_t)tok * D + ocol + lane * DPL + e] = (h16)(o[e] * inv);
}

__global__ __launch_bounds__(256) void k_route(const h16* __restrict__ h1, const float* __restrict__ Wr, const float* __restrict__ b_grp, const float* __restrict__ b_exp,
                                               float* __restrict__ r2, int* __restrict__ cnt, int* __restrict__ ltok, float* __restrict__ lw) {
    const int wid = threadIdx.x >> 6, lane = threadIdx.x & 63; const int tok = blockIdx.x * 4 + wid;
    float v[32];
    float ss = 0.f;
    UNR for (int j = 0; j < 4; ++j) { const half8 hv = *(const half8*)(h1 + (size_t)tok * D + j * 512 + lane * 8);
#pragma unroll
        for (int e = 0; e < 8; ++e) { v[j * 8 + e] = (float)hv[e]; ss += v[j * 8 + e] * v[j * 8 + e]; } }
    ss = wave_sum(ss); const float rs = 1.0f / sqrtf(ss * (1.0f / D) + EPS);
    __shared__ float slg[4][40];
    float* lg = slg[wid];
    for (int c = 0; c < 36; ++c) { float a = 0.f;
        UNR for (int j = 0; j < 4; ++j) { const float* w = Wr + (size_t)c * D + j * 512 + lane * 8;
#pragma unroll
            for (int e = 0; e < 8; ++e) a += v[j * 8 + e] * w[e]; }
        a = wave_sum(a); if (lane == 0) lg[c] = a * rs + (c < 4 ? b_grp[c] : b_exp[c - 4]); }
    __builtin_amdgcn_s_waitcnt(0);
    if (lane == 0) {
        r2[tok] = rs;
        int gi = 0; float gm = lg[0]; for (int g = 1; g < 4; ++g) if (lg[g] > gm) { gm = lg[g]; gi = g; }
        float gs = 0.f; for (int g = 0; g < 4; ++g) gs += __expf(lg[g] - gm);
        const float gw = 1.f / gs;
        int i0 = 0; float v0 = lg[4 + gi * 8]; for (int e = 1; e < 8; ++e) if (lg[4 + gi * 8 + e] > v0) { v0 = lg[4 + gi * 8 + e]; i0 = e; }
        int i1 = -1; float v1 = -INFINITY; for (int e = 0; e < 8; ++e) if (e != i0 && lg[4 + gi * 8 + e] > v1) { v1 = lg[4 + gi * 8 + e]; i1 = e; }
        const float e1 = __expf(v1 - v0); const float w0 = gw / (1.f + e1), w1 = gw * e1 / (1.f + e1);
        const int ea = gi * 8 + i0, eb = gi * 8 + i1;
        const int pa = atomicAdd(cnt + ea, 1); ltok[(size_t)ea * T + pa] = tok; lw[(size_t)ea * T + pa] = w0;
        const int pb = atomicAdd(cnt + eb, 1); ltok[(size_t)eb * T + pb] = tok | (1 << 30); lw[(size_t)eb * T + pb] = w1;
    }
}
__global__ __launch_bounds__(256) void k_combine(const h16* __restrict__ h1, const h16* __restrict__ y, h16* __restrict__ h2, float* __restrict__ r3) {
    const int wid = threadIdx.x >> 6, lane = threadIdx.x & 63; const int tok = blockIdx.x * 4 + wid;
    float ss = 0.f;
    UNR for (int j = 0; j < 4; ++j) { const size_t o = (size_t)tok * D + j * 512 + lane * 8;
        const half8 a = *(const half8*)(h1 + o), b = *(const half8*)(y + o), c = *(const half8*)(y + (size_t)T * D + o); half8 r;
#pragma unroll
        for (int e = 0; e < 8; ++e) { const float s = (float)a[e] + (float)b[e] + (float)c[e]; ss += s * s; r[e] = (h16)s; }
        *(half8*)(h2 + o) = r; }
    ss = wave_sum(ss); if (lane == 0) r3[tok] = 1.0f / sqrtf(ss * (1.0f / D) + EPS);
}
__global__ __launch_bounds__(256) void k_final(float* __restrict__ out, const float* __restrict__ ssq, const float* __restrict__ g) {
    const int wid = threadIdx.x >> 6, lane = threadIdx.x & 63; const int tok = blockIdx.x * 4 + wid;
    const float rs = 1.0f / sqrtf(ssq[tok] * (1.0f / D) + EPS);
    for (int j = 0; j < 8; ++j) { const size_t o = (size_t)tok * D + j * 256 + lane * 4; f32x4 v = *(f32x4*)(out + o); const f32x4 gg = *(const f32x4*)(g + j * 256 + lane * 4);
        v.x *= rs * gg.x; v.y *= rs * gg.y; v.z *= rs * gg.z; v.w *= rs * gg.w; *(f32x4*)(out + o) = v; }
}

}
struct Bufs {
    const float *x, *p, *w_in, *w_out, *sinks, *g_mix, *g_moe, *g_ple, *g_final, *w_grp, *b_grp, *w_exp, *b_exp, *w_gate, *w_up, *w_down, *w_ple, *w_pg;
    float* out; unsigned char* ws;
    float *r1, *r2, *r3, *ssq, *lw, *Wr; int *cnt, *ltok;
    h16 *WinT, *WoutT, *WguT, *WdT, *WpleT, *WpgT, *p16, *pw16, *x16, *mixed, *hid, *h2, *proj, *y, *h1;
};
static Bufs make_bufs(void* const* d_in, void* d_out, void* d_ws) {
    Bufs b{};
    const float** f = (const float**)d_in;
    b.x = f[0]; b.p = f[1]; b.w_in = f[2]; b.w_out = f[3]; b.sinks = f[4]; b.g_mix = f[5]; b.g_moe = f[6]; b.g_ple = f[7]; b.g_final = f[8];
    b.w_grp = f[9]; b.b_grp = f[10]; b.w_exp = f[11]; b.b_exp = f[12]; b.w_gate = f[13]; b.w_up = f[14]; b.w_down = f[15]; b.w_ple = f[16]; b.w_pg = f[17];
    b.out = (float*)d_out; b.ws = (unsigned char*)d_ws; unsigned char* w = b.ws;
    b.cnt = (int*)(w + WS_CTL + CTL_CNT); b.ssq = (float*)(w + WS_CTL + CTL_SSQ);
    b.r1 = (float*)(w + WS_R1); b.r2 = (float*)(w + WS_R2); b.r3 = (float*)(w + WS_R3);
    b.ltok = (int*)(w + WS_LTOK); b.lw = (float*)(w + WS_LW); b.Wr = (float*)(w + WS_WR);
    b.WinT = (h16*)(w + WS_WIN); b.WoutT = (h16*)(w + WS_WOUT); b.WguT = (h16*)(w + WS_WGU); b.WdT = (h16*)(w + WS_WD); b.WpleT = (h16*)(w + WS_WPLE); b.WpgT = (h16*)(w + WS_WPG);
    b.p16 = (h16*)(w + WS_P16); b.pw16 = (h16*)(w + WS_PW16);
    b.x16 = (h16*)(w + WS_RA); b.mixed = b.x16; b.hid = b.x16; b.h2 = b.x16;
    b.proj = (h16*)(w + WS_RB); b.y = b.proj; b.h1 = (h16*)(w + WS_RD);
    return b;
}
static void naive_prep(const Bufs& b, hipStream_t s) {
    nv::k_prep_x<<<T / 4, 256, 0, s>>>(b.x, b.x16, b.r1, b.p, b.p16);
    { nv::TrJob j{b.w_in, nullptr, b.WinT, b.g_mix, NIN, D, NIN, 1, 0, 0}; nv::k_transpose<<<dim3(NIN / 64, D / 64, 1), 256, 0, s>>>(j); }
    { nv::TrJob j{b.w_out, nullptr, b.WoutT, nullptr, D, D, D, 0, 0, 0}; nv::k_transpose<<<dim3(D / 64, D / 64, 1), 256, 0, s>>>(j); }
    { nv::TrJob j{b.w_gate, b.w_up, b.WguT, b.g_moe, DE, D, 256, 2, (long)D * DE, (long)256 * D}; nv::k_transpose<<<dim3(256 / 64, D / 64, NE * 2), 256, 0, s>>>(j); }
    { nv::TrJob j{b.w_down, nullptr, b.WdT, nullptr, D, DE, D, 0, (long)DE * D, (long)D * DE}; nv::k_transpose<<<dim3(D / 64, DE / 64, NE), 256, 0, s>>>(j); }
    { nv::TrJob j{b.w_ple, nullptr, b.WpleT, nullptr, D, PLE, D, 0, 0, 0}; nv::k_transpose<<<dim3(D / 64, PLE / 64, 1), 256, 0, s>>>(j); }
    { nv::TrJob j{b.w_pg, nullptr, b.WpgT, b.g_ple, D, D, D, 0, 0, 0}; nv::k_transpose<<<dim3(D / 64, D / 64, 1), 256, 0, s>>>(j); }
    nv::k_router_w<<<(36 * D + 255) / 256, 256, 0, s>>>(b.w_grp, b.w_exp, b.g_moe, b.Wr);
}
static void naive_gemm1(const Bufs& b, hipStream_t s) { nv::OpG1 o; o.K = D; o.A = b.x16; o.Bt = b.WinT; o.r1 = b.r1; o.out = b.proj; nv::k_gemm<<<dim3(NIN / 128, T / 128, 1), 256, 0, s>>>(o); }
static void naive_pw(const Bufs& b, hipStream_t s) { nv::OpPW o; o.K = PLE; o.A = b.p16; o.Bt = b.WpleT; o.out = b.pw16; nv::k_gemm<<<dim3(D / 128, T / 128, 1), 256, 0, s>>>(o); }
static void naive_attn(const Bufs& b, hipStream_t s) {
    nv::k_attn<128, 3, 129><<<T * AH / 4, 256, 0, s>>>(b.proj, b.mixed, b.sinks);
    nv::k_attn<64, 1, 128><<<T * BH / 4, 256, 0, s>>>(b.proj, b.mixed, b.sinks);
}
static void naive_gemm3(const Bufs& b, hipStream_t s) { nv::OpG3 o; o.K = D; o.A = b.mixed; o.Bt = b.WoutT; o.x = b.x; o.out = b.h1; nv::k_gemm<<<dim3(D / 128, T / 128, 1), 256, 0, s>>>(o); }
static void naive_route(const Bufs& b, hipStream_t s) { nv::k_route<<<T / 4, 256, 0, s>>>(b.h1, b.Wr, b.b_grp, b.b_exp, b.r2, b.cnt, b.ltok, b.lw); }
static void naive_moe_up(const Bufs& b, hipStream_t s) { nv::OpMU o; o.K = D; o.A = b.h1; o.Wgu = b.WguT; o.cnt = b.cnt; o.ltok = b.ltok; o.lw = b.lw; o.r2 = b.r2; o.hid = b.hid;
    nv::k_gemm<<<dim3(512 / 128, T / 128, NE), 256, 0, s>>>(o); }
static void naive_moe_down(const Bufs& b, hipStream_t s) { nv::OpMD o; o.K = DE; o.hid = b.hid; o.Wd = b.WdT; o.cnt = b.cnt; o.ltok = b.ltok; o.y = b.y;
    nv::k_gemm<<<dim3(D / 128, T / 128, NE), 256, 0, s>>>(o); }
static void naive_combine(const Bufs& b, hipStream_t s) { nv::k_combine<<<T / 4, 256, 0, s>>>(b.h1, b.y, b.h2, b.r3); }
static void naive_gemm5(const Bufs& b, hipStream_t s) { nv::OpG5 o; o.K = D; o.A = b.h2; o.Bt = b.WpgT; o.r3 = b.r3; o.pw = b.pw16; o.out = b.out; o.ssq = b.ssq;
    nv::k_gemm<<<dim3(D / 128, T / 128, 1), 256, 0, s>>>(o); }
static void naive_final(const Bufs& b, hipStream_t s) { nv::k_final<<<T / 4, 256, 0, s>>>(b.out, b.ssq, b.g_final); }
extern "C" void kernel_launch(void* const* d_in, const int* in_sizes, int n_in, void* d_out, int out_size, void* d_ws, size_t ws_size, hipStream_t stream) {
    if (n_in != 18 || out_size != T * D || ws_size < WS_END) { fprintf(stderr, "kernel_launch: unexpected shapes: n_in %d out %d ws %zu\n", n_in, out_size, ws_size); return; }
    Bufs b = make_bufs(d_in, d_out, d_ws);
    (void)hipMemsetAsync((char*)d_ws + WS_CTL, 0, CTL_ZERO_BYTES, stream);
    naive_prep(b, stream);
    naive_gemm1(b, stream);
    naive_pw(b, stream);
    naive_attn(b, stream);
    naive_gemm3(b, stream);
    naive_route(b, stream);
    naive_moe_up(b, stream);
    naive_moe_down(b, stream);
    naive_combine(b, stream);
    naive_gemm5(b, stream);
    naive_final(b, stream);
}
```

```cpp
#include <hip/hip_runtime.h>
#include <cstdint>
#include <cstdio>
#include <cmath>

typedef _Float16 h16;
typedef _Float16 half8 __attribute__((ext_vector_type(8)));
typedef _Float16 h16x4 __attribute__((ext_vector_type(4)));
typedef _Float16 h16x2 __attribute__((ext_vector_type(2)));
typedef float f32x4 __attribute__((ext_vector_type(4)));
typedef float f32x2 __attribute__((ext_vector_type(2)));
typedef float f32x16 __attribute__((ext_vector_type(16)));
typedef unsigned u32x4 __attribute__((ext_vector_type(4)));
typedef unsigned u32x2 __attribute__((ext_vector_type(2)));
#define UNR _Pragma("unroll")

constexpr int BATCH = 8, SEQ = 2048, T = BATCH * SEQ, D = 2048, PLE = 256;
constexpr int AH = 8, AHD = 128, BH = 16, BHD = 64, BKV = 2, BG = 8;
constexpr int NIN = 4352;
constexpr int NE = 32, DE = 256;
constexpr float EPS = 1e-6f;
constexpr float LOG2E = 1.4426950408889634f;
constexpr float QSCALE_A = 0.08838834764831845f * LOG2E;
constexpr float QSCALE_B = 0.125f * LOG2E;

constexpr size_t MiB = 1u << 20;
constexpr size_t WS_CTL = 0, CTL_ZERO_BYTES = 1 * MiB;
constexpr size_t CTL_CNT = 256 * 1024, CTL_SSQ = 320 * 1024;
constexpr size_t WS_R1 = 1 * MiB, WS_R2 = WS_R1 + 64 * 1024, WS_R3 = WS_R2 + 64 * 1024;
constexpr size_t WS_LTOK = 2 * MiB, WS_LW = 4 * MiB, WS_WR = 6 * MiB, WS_WR16 = 7 * MiB;
constexpr size_t WS_WIN = 8 * MiB, WS_WOUT = 25 * MiB, WS_WGU = 33 * MiB, WS_WD = 97 * MiB, WS_WPLE = 129 * MiB, WS_WPG = 130 * MiB;
constexpr size_t WS_P16 = 138 * MiB, WS_PW16 = 146 * MiB;
constexpr size_t WS_RA = 210 * MiB;
constexpr size_t WS_RB = 274 * MiB;
constexpr size_t WS_RD = 410 * MiB;
constexpr size_t WS_END = 474 * MiB;

namespace nv {

__device__ __forceinline__ float wave_sum(float v) {
#pragma unroll
    for (int o = 1; o < 64; o <<= 1) v += __shfl_xor(v, o);
    return v;
}
__device__ __forceinline__ float wave_max(float v) {
#pragma unroll
    for (int o = 1; o < 64; o <<= 1) v = fmaxf(v, __shfl_xor(v, o));
    return v;
}

__global__ __launch_bounds__(256) void k_prep_x(const float* __restrict__ x, h16* __restrict__ x16, float* __restrict__ r1,
                                                const float* __restrict__ p, h16* __restrict__ p16) {
    const int wid = threadIdx.x >> 6, lane = threadIdx.x & 63;
    const int row = blockIdx.x * 4 + wid;
    if (row >= T) return;
    const float* xr = x + (size_t)row * D;
    float ss = 0.f;
    for (int j = 0; j < D / 256; ++j) {
        const f32x4 v = *(const f32x4*)(xr + j * 256 + lane * 4);
        ss += v.x * v.x + v.y * v.y + v.z * v.z + v.w * v.w;
        h16x4 o = {(h16)v.x, (h16)v.y, (h16)v.z, (h16)v.w};
        *(h16x4*)(x16 + (size_t)row * D + j * 256 + lane * 4) = o;
    }
    ss = wave_sum(ss);
    if (lane == 0) r1[row] = 1.0f / sqrtf(ss * (1.0f / D) + EPS);
    {
        const f32x4 v = *(const f32x4*)(p + (size_t)row * PLE + lane * 4);
        h16x4 o = {(h16)v.x, (h16)v.y, (h16)v.z, (h16)v.w};
        *(h16x4*)(p16 + (size_t)row * PLE + lane * 4) = o;
    }
}

struct TrJob { const float* src; const float* src2; h16* dst; const float* gain; int pitch, K, N, mode; long src_z, dst_z; };
__global__ __launch_bounds__(256) void k_transpose(TrJob j) {
    __shared__ float tile[64][65];
    const int z = blockIdx.z;
    const int k0 = blockIdx.y * 64, n0 = blockIdx.x * 64;
    const int tx = threadIdx.x & 63, ty = threadIdx.x >> 6;
    const float* src = j.src; const float* src2 = j.src2; h16* dst = j.dst + (size_t)z * j.dst_z;
    int pn = 0;
    if (j.mode == 2) { const int e = z >> 1; pn = z & 1; src += (size_t)e * j.src_z; src2 += (size_t)e * j.src_z; }
    else { src += (size_t)z * j.src_z; }
    {
        const int n = n0 + tx;
        const float* s = src; int col = n;
        if (j.mode == 2) { s = (n < 128) ? src : src2; col = 128 * pn + (n & 127); }
        float cs = 1.f;
        if (j.mode == 1) { if (n < 1024) cs = QSCALE_A; else if (n >= 3072 && n < 4096) cs = QSCALE_B; }
        for (int i = 0; i < 16; ++i) {
            const int k = k0 + ty + 4 * i;
            float v = s[(size_t)k * j.pitch + col] * cs;
            if (j.gain) v *= j.gain[k];
            tile[ty + 4 * i][tx] = v;
        }
    }
    __syncthreads();
    for (int i = 0; i < 16; ++i) {
        const int n = n0 + ty + 4 * i;
        dst[(size_t)n * j.K + k0 + tx] = (h16)tile[tx][ty + 4 * i];
    }
}
__global__ void k_router_w(const float* __restrict__ w_grp, const float* __restrict__ w_exp, const float* __restrict__ g, float* __restrict__ Wr) {
    const int idx = blockIdx.x * blockDim.x + threadIdx.x;
    if (idx >= 36 * D) return;
    const int c = idx / D, k = idx % D;
    const float v = (c < 4) ? w_grp[(size_t)k * 4 + c] : w_exp[(size_t)k * 32 + (c - 4)];
    Wr[idx] = v * g[k];
}

template <class Op> __global__ __launch_bounds__(256) void k_gemm(Op op) {
    const int z = blockIdx.z;
    const int M = op.mrows(z);
    const int row0 = blockIdx.y * 128; if (row0 >= M) return;
    const int col0 = blockIdx.x * 128;
    const int wid = threadIdx.x >> 6, lane = threadIdx.x & 63, wy = wid >> 1, wx = wid & 1, fr = lane & 15, fq = lane >> 4;
    f32x4 acc[4][4];
#pragma unroll
    for (int a = 0; a < 4; ++a)
#pragma unroll
        for (int b = 0; b < 4; ++b) acc[a][b] = (f32x4){0.f, 0.f, 0.f, 0.f};
    const h16* ap[4]; const h16* bp[4];
#pragma unroll
    for (int mi = 0; mi < 4; ++mi) ap[mi] = op.arow(z, row0 + wy * 64 + mi * 16 + fr) + fq * 8;
#pragma unroll
    for (int ni = 0; ni < 4; ++ni) bp[ni] = op.brow(z, col0 + wx * 64, ni, fr) + fq * 8;
    for (int k0 = 0; k0 < op.K; k0 += 32) {
        half8 a[4], b[4];
#pragma unroll
        for (int i = 0; i < 4; ++i) { a[i] = *(const half8*)(ap[i] + k0); b[i] = *(const half8*)(bp[i] + k0); }
#pragma unroll
        for (int mi = 0; mi < 4; ++mi)
#pragma unroll
            for (int ni = 0; ni < 4; ++ni) acc[mi][ni] = __builtin_amdgcn_mfma_f32_16x16x32_f16(a[mi], b[ni], acc[mi][ni], 0, 0, 0);
    }
    op.epi(z, row0 + wy * 64, col0 + wx * 64, acc, fr, fq);
}

struct OpBase { int K; };
struct OpG1 : OpBase {
    const h16* A; const h16* Bt; const float* r1; h16* out;
    __device__ int mrows(int) const { return T; }
    __device__ const h16* arow(int, int r) const { return A + (size_t)r * D; }
    __device__ const h16* brow(int, int cb, int ni, int fr) const { return Bt + (size_t)(cb + ni * 16 + fr) * D; }
    __device__ void epi(int, int rb, int cb, f32x4 (&acc)[4][4], int fr, int fq) const {
        UNR for (int mi = 0; mi < 4; ++mi) UNR for (int r = 0; r < 4; ++r) { const int row = rb + mi * 16 + fq * 4 + r; const float s = r1[row];
            UNR for (int ni = 0; ni < 4; ++ni) out[(size_t)row * NIN + cb + ni * 16 + fr] = (h16)(acc[mi][ni][r] * s); }
    }
};
struct OpG3 : OpBase {
    const h16* A; const h16* Bt; const float* x; h16* out;
    __device__ int mrows(int) const { return T; }
    __device__ const h16* arow(int, int r) const { return A + (size_t)r * D; }
    __device__ const h16* brow(int, int cb, int ni, int fr) const { return Bt + (size_t)(cb + ni * 16 + fr) * D; }
    __device__ void epi(int, int rb, int cb, f32x4 (&acc)[4][4], int fr, int fq) const {
        UNR for (int mi = 0; mi < 4; ++mi) UNR for (int r = 0; r < 4; ++r) { const int row = rb + mi * 16 + fq * 4 + r;
            UNR for (int ni = 0; ni < 4; ++ni) { const size_t o = (size_t)row * D + cb + ni * 16 + fr; out[o] = (h16)(x[o] + acc[mi][ni][r]); } }
    }
};
__device__ __forceinline__ void moe_offsets(const int* cnt, int e, int& off, int& n) {
    int o = 0; for (int i = 0; i < e; ++i) o += (cnt[i] + 255) & ~255; off = o; n = cnt[e];
}
struct OpMU : OpBase {
    const h16* A; const h16* Wgu; const int* cnt; const int* ltok; const float* lw; const float* r2; h16* hid;
    __device__ int mrows(int z) const { return cnt[z]; }
    __device__ const h16* arow(int z, int r) const { const int n = cnt[z]; const int tok = (r < n) ? (ltok[(size_t)z * T + r] & 0x3fff) : 0; return A + (size_t)tok * D; }
    __device__ const h16* brow(int z, int cb, int ni, int fr) const {
        const int hc = (cb >> 6) * 32 + (ni & 1) * 16 + fr; const int pn = hc >> 7, i = hc & 127;
        return Wgu + ((size_t)(z * 2 + pn) * 256 + (ni >> 1) * 128 + i) * D;
    }
    __device__ void epi(int z, int rb, int cb, f32x4 (&acc)[4][4], int fr, int fq) const {
        int off, n; moe_offsets(cnt, z, off, n);
        UNR for (int mi = 0; mi < 4; ++mi) UNR for (int r = 0; r < 4; ++r) { const int pos = rb + mi * 16 + fq * 4 + r; if (pos >= n) continue;
            const int tok = ltok[(size_t)z * T + pos] & 0x3fff; const float s = r2[tok], w = lw[(size_t)z * T + pos];
            UNR for (int ni = 0; ni < 2; ++ni) { const float g = acc[mi][ni][r] * s, u = acc[mi][ni + 2][r] * s;
                const float v = g / (1.f + __expf(-g)) * u * w; const int hc = (cb >> 6) * 32 + ni * 16 + fr;
                hid[(size_t)(off + pos) * DE + hc] = (h16)v; } }
    }
};
struct OpMD : OpBase {
    const h16* hid; const h16* Wd; const int* cnt; const int* ltok; h16* y;
    __device__ int mrows(int z) const { return cnt[z]; }
    __device__ const h16* arow(int z, int r) const { int off, n; moe_offsets(cnt, z, off, n); return hid + (size_t)(off + r) * DE; }
    __device__ const h16* brow(int z, int cb, int ni, int fr) const { return Wd + ((size_t)z * D + cb + ni * 16 + fr) * DE; }
    __device__ void epi(int z, int rb, int cb, f32x4 (&acc)[4][4], int fr, int fq) const {
        const int n = cnt[z];
        UNR for (int mi = 0; mi < 4; ++mi) UNR for (int r = 0; r < 4; ++r) { const int pos = rb + mi * 16 + fq * 4 + r; if (pos >= n) continue;
            const int lt = ltok[(size_t)z * T + pos]; const int tok = lt & 0x3fff, slot = (lt >> 30) & 1;
            UNR for (int ni = 0; ni < 4; ++ni) y[((size_t)slot * T + tok) * D + cb + ni * 16 + fr] = (h16)acc[mi][ni][r]; }
    }
};
struct OpPW : OpBase {
    const h16* A; const h16* Bt; h16* out;
    __device__ int mrows(int) const { return T; }
    __device__ const h16* arow(int, int r) const { return A + (size_t)r * PLE; }
    __device__ const h16* brow(int, int cb, int ni, int fr) const { return Bt + (size_t)(cb + ni * 16 + fr) * PLE; }
    __device__ void epi(int, int rb, int cb, f32x4 (&acc)[4][4], int fr, int fq) const {
        UNR for (int mi = 0; mi < 4; ++mi) UNR for (int r = 0; r < 4; ++r) { const int row = rb + mi * 16 + fq * 4 + r;
            UNR for (int ni = 0; ni < 4; ++ni) out[(size_t)row * D + cb + ni * 16 + fr] = (h16)acc[mi][ni][r]; }
    }
};
struct OpG5 : OpBase {
    const h16* A; const h16* Bt; const float* r3; const h16* pw; float* out; float* ssq;
    __device__ int mrows(int) const { return T; }
    __device__ const h16* arow(int, int r) const { return A + (size_t)r * D; }
    __device__ const h16* brow(int, int cb, int ni, int fr) const { return Bt + (size_t)(cb + ni * 16 + fr) * D; }
    __device__ void epi(int, int rb, int cb, f32x4 (&acc)[4][4], int fr, int fq) const {
        UNR for (int mi = 0; mi < 4; ++mi) UNR for (int r = 0; r < 4; ++r) { const int row = rb + mi * 16 + fq * 4 + r; const float s = r3[row]; float q = 0.f;
            UNR for (int ni = 0; ni < 4; ++ni) { const size_t o = (size_t)row * D + cb + ni * 16 + fr; const float g = 1.f / (1.f + __expf(-acc[mi][ni][r] * s));
                const float h3 = (float)A[o] + g * (float)pw[o]; out[o] = h3; q += h3 * h3; }
            q += __shfl_xor(q, 1); q += __shfl_xor(q, 2); q += __shfl_xor(q, 4); q += __shfl_xor(q, 8);
            if (fr == 0) atomicAdd(ssq + row, q); }
    }
};

template <int HD, int NBR, int NJ> __global__ __launch_bounds__(256) void k_attn(const h16* __restrict__ proj, h16* __restrict__ mixed, const float* __restrict__ sinks) {
    constexpr int NH = (NBR == 3) ? AH : BH;
    __shared__ float qs[4][HD];
    __shared__ float sc[4][NBR * NJ + 1];
    const int wid = threadIdx.x >> 6, lane = threadIdx.x & 63;
    const int id = blockIdx.x * 4 + wid;
    const int tok = id / NH, head = id % NH;
    const int b = tok / SEQ, tpos = tok % SEQ;
    int qcol, kcol, vcol, ocol; float slope2, sink2 = -INFINITY;
    if (NBR == 3) { qcol = head * 128; kcol = 1024 + head * 128; vcol = 2048 + head * 128; ocol = head * 128; slope2 = exp2f(-(float)(head + 1)) * LOG2E; }
    else { const int kv = head / BG; qcol = 3072 + head * 64; kcol = 4096 + kv * 64; vcol = 4224 + kv * 64; ocol = 1024 + head * 64;
           slope2 = exp2f(-0.5f * (float)(head + 1)) * LOG2E; sink2 = sinks[head] * LOG2E; }
    const h16* base = proj + (size_t)b * SEQ * NIN;
    for (int d = lane; d < HD; d += 64) qs[wid][d] = (float)base[(size_t)tpos * NIN + qcol + d];
    __syncthreads();
    float mx = -INFINITY;
    for (int i = lane; i < NBR * NJ; i += 64) {
        const int br = i / NJ, j = i % NJ; const int dil = (br == 0) ? 1 : (br == 1 ? 4 : 16);
        const int s = tpos - dil * j; float v = -INFINITY;
        if (s >= 0) { const h16* kr = base + (size_t)s * NIN + kcol; float a = 0.f;
            for (int d = 0; d < HD; d += 8) { const half8 kk = *(const half8*)(kr + d);
#pragma unroll
                for (int e = 0; e < 8; ++e) a += qs[wid][d + e] * (float)kk[e]; }
            v = a - slope2 * (float)(dil * j); }
        sc[wid][i] = v; mx = fmaxf(mx, v);
    }
    mx = wave_max(mx); mx = fmaxf(mx, sink2);
    __syncthreads();
    float sum = 0.f;
    for (int i = lane; i < NBR * NJ; i += 64) { const float pv = exp2f(sc[wid][i] - mx); sc[wid][i] = pv; sum += pv; }
    sum = wave_sum(sum); sum += exp2f(sink2 - mx);
    __syncthreads();
    constexpr int DPL = HD / 64;
    float o[DPL]; UNR for (int e = 0; e < DPL; ++e) o[e] = 0.f;
    for (int i = 0; i < NBR * NJ; ++i) {
        const float pv = sc[wid][i]; if (pv == 0.f) continue;
        const int br = i / NJ, j = i % NJ; const int dil = (br == 0) ? 1 : (br == 1 ? 4 : 16);
        const int s = tpos - dil * j; const h16* vr = base + (size_t)s * NIN + vcol + lane * DPL;
        UNR for (int e = 0; e < DPL; ++e) o[e] += pv * (float)vr[e];
    }
    const float inv = 1.f / sum;
    UNR for (int e = 0; e < DPL; ++e) mixed[(size_t)tok * D + ocol + lane * DPL + e] = (h16)(o[e] * inv);
}

__global__ __launch_bounds__(256) void k_route(const h16* __restrict__ h1, const float* __restrict__ Wr, const float* __restrict__ b_grp, const float* __restrict__ b_exp,
                                               float* __restrict__ r2, int* __restrict__ cnt, int* __restrict__ ltok, float* __restrict__ lw) {
    const int wid = threadIdx.x >> 6, lane = threadIdx.x & 63; const int tok = blockIdx.x * 4 + wid;
    float v[32];
    float ss = 0.f;
    UNR for (int j = 0; j < 4; ++j) { const half8 hv = *(const half8*)(h1 + (size_t)tok * D + j * 512 + lane * 8);
#pragma unroll
        for (int e = 0; e < 8; ++e) { v[j * 8 + e] = (float)hv[e]; ss += v[j * 8 + e] * v[j * 8 + e]; } }
    ss = wave_sum(ss); const float rs = 1.0f / sqrtf(ss * (1.0f / D) + EPS);
    __shared__ float slg[4][40];
    float* lg = slg[wid];
    for (int c = 0; c < 36; ++c) { float a = 0.f;
        UNR for (int j = 0; j < 4; ++j) { const float* w = Wr + (size_t)c * D + j * 512 + lane * 8;
#pragma unroll
            for (int e = 0; e < 8; ++e) a += v[j * 8 + e] * w[e]; }
        a = wave_sum(a); if (lane == 0) lg[c] = a * rs + (c < 4 ? b_grp[c] : b_exp[c - 4]); }
    __builtin_amdgcn_s_waitcnt(0);
    if (lane == 0) {
        r2[tok] = rs;
        int gi = 0; float gm = lg[0]; for (int g = 1; g < 4; ++g) if (lg[g] > gm) { gm = lg[g]; gi = g; }
        float gs = 0.f; for (int g = 0; g < 4; ++g) gs += __expf(lg[g] - gm);
        const float gw = 1.f / gs;
        int i0 = 0; float v0 = lg[4 + gi * 8]; for (int e = 1; e < 8; ++e) if (lg[4 + gi * 8 + e] > v0) { v0 = lg[4 + gi * 8 + e]; i0 = e; }
        int i1 = -1; float v1 = -INFINITY; for (int e = 0; e < 8; ++e) if (e != i0 && lg[4 + gi * 8 + e] > v1) { v1 = lg[4 + gi * 8 + e]; i1 = e; }
        const float e1 = __expf(v1 - v0); const float w0 = gw / (1.f + e1), w1 = gw * e1 / (1.f + e1);
        const int ea = gi * 8 + i0, eb = gi * 8 + i1;
        const int pa = atomicAdd(cnt + ea, 1); ltok[(size_t)ea * T + pa] = tok; lw[(size_t)ea * T + pa] = w0;
        const int pb = atomicAdd(cnt + eb, 1); ltok[(size_t)eb * T + pb] = tok | (1 << 30); lw[(size_t)eb * T + pb] = w1;
    }
}
__global__ __launch_bounds__(256) void k_combine(const h16* __restrict__ h1, const h16* __restrict__ y, h16* __restrict__ h2, float* __restrict__ r3) {
    const int wid = threadIdx.x >> 6, lane = threadIdx.x & 63; const int tok = blockIdx.x * 4 + wid;
    float ss = 0.f;
    UNR for (int j = 0; j < 4; ++j) { const size_t o = (size_t)tok * D + j * 512 + lane * 8;
        const half8 a = *(const half8*)(h1 + o), b = *(const half8*)(y + o), c = *(const half8*)(y + (size_t)T * D + o); half8 r;
#pragma unroll
        for (int e = 0; e < 8; ++e) { const float s = (float)a[e] + (float)b[e] + (float)c[e]; ss += s * s; r[e] = (h16)s; }
        *(half8*)(h2 + o) = r; }
    ss = wave_sum(ss); if (lane == 0) r3[tok] = 1.0f / sqrtf(ss * (1.0f / D) + EPS);
}
__global__ __launch_bounds__(256) void k_final(float* __restrict__ out, const float* __restrict__ ssq, const float* __restrict__ g) {
    const int wid = threadIdx.x >> 6, lane = threadIdx.x & 63; const int tok = blockIdx.x * 4 + wid;
    const float rs = 1.0f / sqrtf(ssq[tok] * (1.0f / D) + EPS);
    for (int j = 0; j < 8; ++j) { const size_t o = (size_t)tok * D + j * 256 + lane * 4; f32x4 v = *(f32x4*)(out + o); const f32x4 gg = *(const f32x4*)(g + j * 256 + lane * 4);
        v.x *= rs * gg.x; v.y *= rs * gg.y; v.z *= rs * gg.z; v.w *= rs * gg.w; *(f32x4*)(out + o) = v; }
}

}
struct Bufs {
    const float *x, *p, *w_in, *w_out, *sinks, *g_mix, *g_moe, *g_ple, *g_final, *w_grp, *b_grp, *w_exp, *b_exp, *w_gate, *w_up, *w_down, *w_ple, *w_pg;
    float* out; unsigned char* ws;
    float *r1, *r2, *r3, *ssq, *lw, *Wr; int *cnt, *ltok; h16* Wr16;
    h16 *WinT, *WoutT, *WguT, *WdT, *WpleT, *WpgT, *p16, *pw16, *x16, *mixed, *hid, *h2, *proj, *y, *h1;
};
static Bufs make_bufs(void* const* d_in, void* d_out, void* d_ws) {
    Bufs b{};
    const float** f = (const float**)d_in;
    b.x = f[0]; b.p = f[1]; b.w_in = f[2]; b.w_out = f[3]; b.sinks = f[4]; b.g_mix = f[5]; b.g_moe = f[6]; b.g_ple = f[7]; b.g_final = f[8];
    b.w_grp = f[9]; b.b_grp = f[10]; b.w_exp = f[11]; b.b_exp = f[12]; b.w_gate = f[13]; b.w_up = f[14]; b.w_down = f[15]; b.w_ple = f[16]; b.w_pg = f[17];
    b.out = (float*)d_out; b.ws = (unsigned char*)d_ws; unsigned char* w = b.ws;
    b.cnt = (int*)(w + WS_CTL + CTL_CNT); b.ssq = (float*)(w + WS_CTL + CTL_SSQ);
    b.r1 = (float*)(w + WS_R1); b.r2 = (float*)(w + WS_R2); b.r3 = (float*)(w + WS_R3);
    b.ltok = (int*)(w + WS_LTOK); b.lw = (float*)(w + WS_LW); b.Wr = (float*)(w + WS_WR); b.Wr16 = (h16*)(w + WS_WR16);
    b.WinT = (h16*)(w + WS_WIN); b.WoutT = (h16*)(w + WS_WOUT); b.WguT = (h16*)(w + WS_WGU); b.WdT = (h16*)(w + WS_WD); b.WpleT = (h16*)(w + WS_WPLE); b.WpgT = (h16*)(w + WS_WPG);
    b.p16 = (h16*)(w + WS_P16); b.pw16 = (h16*)(w + WS_PW16);
    b.x16 = (h16*)(w + WS_RA); b.mixed = b.x16; b.hid = b.x16; b.h2 = b.x16;
    b.proj = (h16*)(w + WS_RB); b.y = b.proj; b.h1 = (h16*)(w + WS_RD);
    return b;
}
static void naive_prep(const Bufs& b, hipStream_t s) {
    nv::k_prep_x<<<T / 4, 256, 0, s>>>(b.x, b.x16, b.r1, b.p, b.p16);
    { nv::TrJob j{b.w_in, nullptr, b.WinT, b.g_mix, NIN, D, NIN, 1, 0, 0}; nv::k_transpose<<<dim3(NIN / 64, D / 64, 1), 256, 0, s>>>(j); }
    { nv::TrJob j{b.w_out, nullptr, b.WoutT, nullptr, D, D, D, 0, 0, 0}; nv::k_transpose<<<dim3(D / 64, D / 64, 1), 256, 0, s>>>(j); }
    { nv::TrJob j{b.w_gate, b.w_up, b.WguT, b.g_moe, DE, D, 256, 2, (long)D * DE, (long)256 * D}; nv::k_transpose<<<dim3(256 / 64, D / 64, NE * 2), 256, 0, s>>>(j); }
    { nv::TrJob j{b.w_down, nullptr, b.WdT, nullptr, D, DE, D, 0, (long)DE * D, (long)D * DE}; nv::k_transpose<<<dim3(D / 64, DE / 64, NE), 256, 0, s>>>(j); }
    { nv::TrJob j{b.w_ple, nullptr, b.WpleT, nullptr, D, PLE, D, 0, 0, 0}; nv::k_transpose<<<dim3(D / 64, PLE / 64, 1), 256, 0, s>>>(j); }
    { nv::TrJob j{b.w_pg, nullptr, b.WpgT, b.g_ple, D, D, D, 0, 0, 0}; nv::k_transpose<<<dim3(D / 64, D / 64, 1), 256, 0, s>>>(j); }
    nv::k_router_w<<<(36 * D + 255) / 256, 256, 0, s>>>(b.w_grp, b.w_exp, b.g_moe, b.Wr);
}
static void naive_gemm1(const Bufs& b, hipStream_t s) { nv::OpG1 o; o.K = D; o.A = b.x16; o.Bt = b.WinT; o.r1 = b.r1; o.out = b.proj; nv::k_gemm<<<dim3(NIN / 128, T / 128, 1), 256, 0, s>>>(o); }
static void naive_pw(const Bufs& b, hipStream_t s) { nv::OpPW o; o.K = PLE; o.A = b.p16; o.Bt = b.WpleT; o.out = b.pw16; nv::k_gemm<<<dim3(D / 128, T / 128, 1), 256, 0, s>>>(o); }
static void naive_attn(const Bufs& b, hipStream_t s) {
    nv::k_attn<128, 3, 129><<<T * AH / 4, 256, 0, s>>>(b.proj, b.mixed, b.sinks);
    nv::k_attn<64, 1, 128><<<T * BH / 4, 256, 0, s>>>(b.proj, b.mixed, b.sinks);
}
static void naive_gemm3(const Bufs& b, hipStream_t s) { nv::OpG3 o; o.K = D; o.A = b.mixed; o.Bt = b.WoutT; o.x = b.x; o.out = b.h1; nv::k_gemm<<<dim3(D / 128, T / 128, 1), 256, 0, s>>>(o); }
static void naive_route(const Bufs& b, hipStream_t s) { nv::k_route<<<T / 4, 256, 0, s>>>(b.h1, b.Wr, b.b_grp, b.b_exp, b.r2, b.cnt, b.ltok, b.lw); }
static void naive_moe_up(const Bufs& b, hipStream_t s) { nv::OpMU o; o.K = D; o.A = b.h1; o.Wgu = b.WguT; o.cnt = b.cnt; o.ltok = b.ltok; o.lw = b.lw; o.r2 = b.r2; o.hid = b.hid;
    nv::k_gemm<<<dim3(512 / 128, T / 128, NE), 256, 0, s>>>(o); }
static void naive_moe_down(const Bufs& b, hipStream_t s) { nv::OpMD o; o.K = DE; o.hid = b.hid; o.Wd = b.WdT; o.cnt = b.cnt; o.ltok = b.ltok; o.y = b.y;
    nv::k_gemm<<<dim3(D / 128, T / 128, NE), 256, 0, s>>>(o); }
static void naive_combine(const Bufs& b, hipStream_t s) { nv::k_combine<<<T / 4, 256, 0, s>>>(b.h1, b.y, b.h2, b.r3); }
static void naive_gemm5(const Bufs& b, hipStream_t s) { nv::OpG5 o; o.K = D; o.A = b.h2; o.Bt = b.WpgT; o.r3 = b.r3; o.pw = b.pw16; o.out = b.out; o.ssq = b.ssq;
    nv::k_gemm<<<dim3(D / 128, T / 128, 1), 256, 0, s>>>(o); }
static void naive_final(const Bufs& b, hipStream_t s) { nv::k_final<<<T / 4, 256, 0, s>>>(b.out, b.ssq, b.g_final); }
namespace g8 {
#define G8_LAS __attribute__((address_space(3)))
constexpr int BM = 256, BK = 64, HALF = 128, HTB = HALF * BK * 2  , STAGE_BYTES = 8 * HTB, NXCD = 8, WGM = 8;

__host__ __device__ __forceinline__ int lds_byte(int r, int c) { const int st = (r >> 4) * 2 + (c >> 5), rr = r & 15, cc = c & 31, ob = rr * 64 + cc * 2; return st * 1024 + (ob ^ (((ob >> 9) & 1) << 5)); }
__host__ __device__ __forceinline__ void stage_rc(int b, int& R, int& C) { const int st = b / 1024, sb = b % 1024, swz = sb ^ (((sb >> 9) & 1) << 5); R = (st >> 1) * 16 + swz / 64; C = (st & 1) * 32 + (swz % 64) / 2; }
__host__ __device__ __forceinline__ int perm32(int rho) { const int n = rho >> 4, i = rho & 15; return 8 * (i >> 2) + 4 * n + (i & 3); }

struct Unit { int pm, pn, a0, a1, a2, a3; };
struct Gemm { const h16* A; const h16* Bt; int K; };

struct StaticOrder {
    int nM, nN, nwg, G, c;
    __device__ void init(int M, int N, int G_, int c_) { nM = M / BM; nN = N / BM; nwg = nM * nN; G = G_; c = c_; }
    __device__ bool next(int i, Unit& u) const {
        const long L = (long)i * G + c; if (L >= nwg) return false;
        int wgid = (int)L; { const int q = nwg / NXCD, r = nwg % NXCD, xcd = wgid % NXCD, off = wgid / NXCD; wgid = (xcd < r ? xcd * (q + 1) : r * (q + 1) + (xcd - r) * q) + off; }
        const int nig = WGM * nN, gid = wgid / nig, fm = gid * WGM, gsz = (nM - fm) < WGM ? (nM - fm) : WGM;
        u.pm = fm + ((wgid % nig) % gsz); u.pn = (wgid % nig) / gsz; u.a0 = u.a1 = u.a2 = u.a3 = 0; return true;
    }
    __device__ __forceinline__ unsigned arow(const Unit& u, int r) const { return (unsigned)(u.pm * BM + r); }
};

__device__ __forceinline__ unsigned pk_h2(float lo, float hi) { f32x2 v = {lo, hi}; return __builtin_bit_cast(unsigned, __builtin_convertvector(v, h16x2)); }

template <class Epi, class Sched, bool ALIGN_EPI = true>
__device__ __forceinline__ void gemm_phase(G8_LAS unsigned char* lds, const Gemm g, const Sched& S, const Epi& E) {
    const int tid = threadIdx.x, wid = __builtin_amdgcn_readfirstlane(tid >> 6), lane = tid & 63, wr = wid >> 2, wc = wid & 3, fr = lane & 15, fq = lane >> 4;
    const int K = g.K, nt = K / BK;
    unsigned voffB[2];
#pragma unroll
    for (int i = 0; i < 2; ++i) { int R, C; stage_rc(tid * 16 + i * 8192, R, C); const int Rb = Epi::PERM ? ((R & ~31) + perm32(R & 31)) : R; voffB[i] = (unsigned)(Rb * K + C) * 2u; }
    const unsigned pitch = (unsigned)K * 2u;
    const size_t kstep = (size_t)(BK * 2);
    const size_t hstep = (size_t)HALF * K * 2;
    const size_t tstep = 2 * hstep;
    const unsigned ldsw = (unsigned)wid * 1024u;
    const int aoff = lds_byte(wr * 64 + fr, fq * 8), boff = lds_byte(wc * 32 + fr, fq * 8);
#define G8_SA(b, h) (((b) * 2 + (h)) * HTB)
#define G8_SB(b, h) ((4 + (b) * 2 + (h)) * HTB)
#define G8_STAGE(bufoff, gbase, voff) do { _Pragma("unroll") for (int _i = 0; _i < 2; ++_i) \
        __builtin_amdgcn_global_load_lds((const unsigned*)((const char*)(gbase) + (voff)[_i]), (G8_LAS unsigned*)(lds + (bufoff) + ldsw + _i * 8192), 16, 0, 0); } while (0)
#define G8_LDA(dst, b, h) do { _Pragma("unroll") for (int m = 0; m < 4; ++m) _Pragma("unroll") for (int k = 0; k < 2; ++k) dst[m][k] = *(const G8_LAS half8*)(lds + G8_SA(b, h) + aoff + m * 2048 + k * 1024); } while (0)
#define G8_LDB(dst, b, h) do { _Pragma("unroll") for (int n = 0; n < 2; ++n) _Pragma("unroll") for (int k = 0; k < 2; ++k) dst[n][k] = *(const G8_LAS half8*)(lds + G8_SB(b, h) + boff + n * 2048 + k * 1024); } while (0)
#define G8_MMA(ai, bj, At, Bt) do { __builtin_amdgcn_s_setprio(1); _Pragma("unroll") for (int m = 0; m < 4; ++m) _Pragma("unroll") for (int n = 0; n < 2; ++n) _Pragma("unroll") for (int k = 0; k < 2; ++k) \
        acc[ai][bj][m][n] = __builtin_amdgcn_mfma_f32_16x16x32_f16(Bt[n][k], At[m][k], acc[ai][bj][m][n], 0, 0, 0); __builtin_amdgcn_s_setprio(0); } while (0)
#define G8_WAIT_V(n) asm volatile("s_waitcnt vmcnt(" #n ")" ::: "memory")
#define G8_WAIT_L(n) asm volatile("s_waitcnt lgkmcnt(" #n ")" ::: "memory")
#define G8_BAR __builtin_amdgcn_s_barrier()
#define G8_SCHED __builtin_amdgcn_sched_barrier(0)
#define G8_SETVO(dst, u) do { int _t = tid; asm volatile("" : "+v"(_t)); _Pragma("unroll") for (int _i = 0; _i < 2; ++_i) { int _R, _C; stage_rc(_t * 16 + _i * 8192, _R, _C); \
        _Pragma("unroll") for (int _h = 0; _h < 2; ++_h) dst[_h][_i] = S.arow(u, _h * HALF + _R) * pitch + (unsigned)_C * 2u; } } while (0)
    Unit cur, nxt; int ui = 0;
    if (!S.next(0, cur)) return;
    f32x4 acc[2][2][4][2];
#pragma unroll
    for (int a = 0; a < 2; ++a)
#pragma unroll
        for (int b = 0; b < 2; ++b)
#pragma unroll
            for (int m = 0; m < 4; ++m)
#pragma unroll
                for (int n = 0; n < 2; ++n) acc[a][b][m][n] = (f32x4){0.f, 0.f, 0.f, 0.f};
    half8 At[4][2], B0[2][2], B1[2][2];
    unsigned cv[2][2], nv[2][2];
    G8_SETVO(cv, cur);
    const char* const gA = (const char*)g.A;
    const char* cB = (const char*)g.Bt + (size_t)cur.pn * tstep;
    G8_STAGE(G8_SB(0, 0), cB, voffB); G8_STAGE(G8_SB(0, 1), cB + hstep, voffB); G8_STAGE(G8_SA(0, 0), gA, cv[0]); G8_STAGE(G8_SA(0, 1), gA, cv[1]);
    if (wr == 1) G8_BAR;
    G8_WAIT_V(2); G8_BAR;
    G8_STAGE(G8_SB(1, 0), cB + kstep, voffB); G8_STAGE(G8_SA(1, 0), gA + kstep, cv[0]); G8_STAGE(G8_SB(1, 1), cB + hstep + kstep, voffB);
    G8_WAIT_V(6); G8_BAR;
    for (;;) {
        const bool has_next = S.next(ui + 1, nxt);
        if (has_next) { G8_SETVO(nv, nxt); } else {
#pragma unroll
            for (int _h = 0; _h < 2; ++_h)
#pragma unroll
                for (int _i = 0; _i < 2; ++_i) nv[_h][_i] = cv[_h][_i]; }
        const char* nB = has_next ? (const char*)g.Bt + (size_t)nxt.pn * tstep : cB;
#pragma nounroll
        for (int t = 0; t < nt; t += 2) {
            const bool last = (t == nt - 2);
            const char* a1 = gA + (size_t)(t + 1) * kstep;
            const char* a2 = last ? gA : gA + (size_t)(t + 2) * kstep; const char* b2 = last ? nB : cB + (size_t)(t + 2) * kstep;
            const char* a3 = a2 + kstep; const char* b3 = b2 + kstep;
            unsigned v20[2], v21[2];
#pragma unroll
            for (int _i = 0; _i < 2; ++_i) { v20[_i] = last ? nv[0][_i] : cv[0][_i]; v21[_i] = last ? nv[1][_i] : cv[1][_i]; }
            G8_LDB(B0, 0, 0); G8_LDB(B1, 0, 1); G8_SCHED; G8_LDA(At, 0, 0); G8_STAGE(G8_SA(1, 1), a1, cv[1]);
            G8_WAIT_V(8); G8_WAIT_L(0); G8_BAR; G8_MMA(0, 0, At, B0); G8_MMA(0, 1, At, B1); G8_BAR; G8_SCHED;
            G8_LDA(At, 0, 1); G8_STAGE(G8_SB(0, 0), b2, voffB); G8_STAGE(G8_SB(0, 1), b2 + hstep, voffB); G8_STAGE(G8_SA(0, 0), a2, v20);
            G8_WAIT_V(8); G8_WAIT_L(0); G8_BAR; G8_MMA(1, 0, At, B0); G8_MMA(1, 1, At, B1); G8_BAR; G8_SCHED;
            G8_LDB(B0, 1, 0); G8_LDB(B1, 1, 1); G8_SCHED; G8_LDA(At, 1, 0); G8_STAGE(G8_SA(0, 1), a2, v21);
            G8_WAIT_V(8); G8_WAIT_L(0); G8_BAR; G8_MMA(0, 0, At, B0); G8_MMA(0, 1, At, B1); G8_BAR; G8_SCHED;
            G8_LDA(At, 1, 1); G8_STAGE(G8_SB(1, 0), b3, voffB); G8_STAGE(G8_SB(1, 1), b3 + hstep, voffB); G8_STAGE(G8_SA(1, 0), a3, v20);
            G8_WAIT_V(8); G8_WAIT_L(0); G8_BAR; G8_MMA(1, 0, At, B0); G8_MMA(1, 1, At, B1); G8_BAR; G8_SCHED;
        }
        if constexpr (ALIGN_EPI) { if (wr == 0) G8_BAR; }
        E(acc, cur, wr, wc, fr, fq);
        if (!has_next) break;
#pragma unroll
        for (int a = 0; a < 2; ++a)
#pragma unroll
            for (int b = 0; b < 2; ++b)
#pragma unroll
                for (int m = 0; m < 4; ++m)
#pragma unroll
                    for (int n = 0; n < 2; ++n) acc[a][b][m][n] = (f32x4){0.f, 0.f, 0.f, 0.f};
        cur = nxt; cB = nB; ++ui;
#pragma unroll
        for (int _h = 0; _h < 2; ++_h)
#pragma unroll
            for (int _i = 0; _i < 2; ++_i) cv[_h][_i] = nv[_h][_i];
        if constexpr (ALIGN_EPI) { if (wr == 1) G8_BAR; }
    }
    G8_WAIT_V(0);
    if constexpr (!ALIGN_EPI) { if (wr == 0) G8_BAR; }
    G8_BAR;
#undef G8_SA
#undef G8_SB
#undef G8_STAGE
#undef G8_LDA
#undef G8_LDB
#undef G8_MMA
#undef G8_WAIT_V
#undef G8_WAIT_L
#undef G8_BAR
#undef G8_SCHED
#undef G8_SETVO
}
}
namespace g8 {
#define EPI_ROWS UNR for (int ai = 0; ai < 2; ++ai) UNR for (int m = 0; m < 4; ++m)
#define EPI_FENCE asm volatile("" ::: "memory")
#define RFL(x) __builtin_amdgcn_readfirstlane(x)

struct EpiProj {
    static constexpr bool PERM = true;
    h16* out; const float* r1;
    __device__ __forceinline__ void operator()(const f32x4 (&acc)[2][2][4][2], const Unit& u, int wr, int wc, int fr, int fq) const {
        const int row0 = u.pm * BM + wr * 64 + fr, col0 = u.pn * BM + wc * 32 + 8 * fq;
        EPI_ROWS { const int row = row0 + ai * HALF + m * 16; const float s = r1[row]; h16* rp = out + (size_t)row * NIN + col0;
            UNR for (int bj = 0; bj < 2; ++bj) { const f32x4 v0 = acc[ai][bj][m][0] * s, v1 = acc[ai][bj][m][1] * s;
                u32x4 w; w.x = pk_h2(v0[0], v0[1]); w.y = pk_h2(v0[2], v0[3]); w.z = pk_h2(v1[0], v1[1]); w.w = pk_h2(v1[2], v1[3]); *(u32x4*)(rp + bj * HALF) = w; } EPI_FENCE; }
    }
};
struct EpiPlain {
    static constexpr bool PERM = true;
    h16* out; int ldc;
    __device__ __forceinline__ void operator()(const f32x4 (&acc)[2][2][4][2], const Unit& u, int wr, int wc, int fr, int fq) const {
        const int row0 = u.pm * BM + wr * 64 + fr, col0 = u.pn * BM + wc * 32 + 8 * fq;
        EPI_ROWS { const int row = row0 + ai * HALF + m * 16; h16* rp = out + (size_t)row * ldc + col0;
            UNR for (int bj = 0; bj < 2; ++bj) { const f32x4 v0 = acc[ai][bj][m][0], v1 = acc[ai][bj][m][1];
                u32x4 w; w.x = pk_h2(v0[0], v0[1]); w.y = pk_h2(v0[2], v0[3]); w.z = pk_h2(v1[0], v1[1]); w.w = pk_h2(v1[2], v1[3]); *(u32x4*)(rp + bj * HALF) = w; } EPI_FENCE; }
    }
};
struct EpiRes {
    static constexpr bool PERM = true;
    h16* out; const float* x;
    __device__ __forceinline__ void operator()(const f32x4 (&acc)[2][2][4][2], const Unit& u, int wr, int wc, int fr, int fq) const {
        const int row0 = u.pm * BM + wr * 64 + fr, col0 = u.pn * BM + wc * 32 + 8 * fq;
        EPI_ROWS { const int row = row0 + ai * HALF + m * 16; const size_t o = (size_t)row * D + col0;
            UNR for (int bj = 0; bj < 2; ++bj) { const f32x4 x0 = *(const f32x4*)(x + o + bj * HALF), x1 = *(const f32x4*)(x + o + bj * HALF + 4);
                const f32x4 v0 = acc[ai][bj][m][0] + x0, v1 = acc[ai][bj][m][1] + x1;
                u32x4 w; w.x = pk_h2(v0[0], v0[1]); w.y = pk_h2(v0[2], v0[3]); w.z = pk_h2(v1[0], v1[1]); w.w = pk_h2(v1[2], v1[3]); *(u32x4*)(out + o + bj * HALF) = w; } EPI_FENCE; }
    }
};
struct EpiMoeUp {
    static constexpr bool PERM = true;
    h16* hid; const int* ltok; const float* lw; const float* r2;
    __device__ __forceinline__ void operator()(const f32x4 (&acc)[2][2][4][2], const Unit& u, int wr, int wc, int fr, int fq) const {
        const int e = u.a0, hc0 = (u.pn & 1) * 128 + wc * 32 + 8 * fq;
        EPI_ROWS { const int rr = ai * HALF + wr * 64 + m * 16 + fr; if (rr < u.a1) {
            const size_t li = (size_t)e * T + u.a3 + rr; const int tok = ltok[li] & 0x3fff; const float s = r2[tok], w = lw[li];
            float hv[8];
            UNR for (int n = 0; n < 2; ++n) UNR for (int j = 0; j < 4; ++j) { const float gt = acc[ai][0][m][n][j] * s, up = acc[ai][1][m][n][j] * s;
                hv[n * 4 + j] = gt / (1.f + __expf(-gt)) * up * w; }
            u32x4 o; o.x = pk_h2(hv[0], hv[1]); o.y = pk_h2(hv[2], hv[3]); o.z = pk_h2(hv[4], hv[5]); o.w = pk_h2(hv[6], hv[7]);
            *(u32x4*)(hid + (size_t)(u.a2 + rr) * DE + hc0) = o; } EPI_FENCE; }
    }
};
struct EpiMoeDown {
    static constexpr bool PERM = true;
    h16* y; const int* ltok;
    __device__ __forceinline__ void operator()(const f32x4 (&acc)[2][2][4][2], const Unit& u, int wr, int wc, int fr, int fq) const {
        const int e = u.a0, col0 = u.a2 * BM + wc * 32 + 8 * fq;
        EPI_ROWS { const int rr = ai * HALF + wr * 64 + m * 16 + fr; if (rr < u.a1) {
            const int lt = ltok[(size_t)e * T + u.a3 + rr]; const int tok = lt & 0x3fff, slot = (lt >> 30) & 1; h16* rp = y + ((size_t)slot * T + tok) * D + col0;
            UNR for (int bj = 0; bj < 2; ++bj) { const f32x4 v0 = acc[ai][bj][m][0], v1 = acc[ai][bj][m][1];
                u32x4 w; w.x = pk_h2(v0[0], v0[1]); w.y = pk_h2(v0[2], v0[3]); w.z = pk_h2(v1[0], v1[1]); w.w = pk_h2(v1[2], v1[3]); *(u32x4*)(rp + bj * HALF) = w; } } EPI_FENCE; }
    }
};
struct EpiPle {
    static constexpr bool PERM = true;
    float* out; const h16* h2; const h16* pw; const float* r3; float* ssq;
    __device__ __forceinline__ void operator()(const f32x4 (&acc)[2][2][4][2], const Unit& u, int wr, int wc, int fr, int fq) const {
        const int row0 = u.pm * BM + wr * 64 + fr, col0 = u.pn * BM + wc * 32 + 8 * fq;
        EPI_ROWS { const int row = row0 + ai * HALF + m * 16; const float s = r3[row]; const size_t o = (size_t)row * D + col0; float q = 0.f;
            UNR for (int bj = 0; bj < 2; ++bj) { const half8 hh = *(const half8*)(h2 + o + bj * HALF), pp = *(const half8*)(pw + o + bj * HALF); f32x4 r0, r1v;
                UNR for (int j = 0; j < 4; ++j) { const float g0 = 1.f / (1.f + __expf(-acc[ai][bj][m][0][j] * s)), g1 = 1.f / (1.f + __expf(-acc[ai][bj][m][1][j] * s));
                    r0[j] = (float)hh[j] + g0 * (float)pp[j]; r1v[j] = (float)hh[4 + j] + g1 * (float)pp[4 + j]; q += r0[j] * r0[j] + r1v[j] * r1v[j]; }
                *(f32x4*)(out + o + bj * HALF) = r0; *(f32x4*)(out + o + bj * HALF + 4) = r1v; }
            q += __shfl_xor(q, 16); q += __shfl_xor(q, 32);
            if (fq == 0) atomicAdd(ssq + row, q); EPI_FENCE; }
    }
};

__device__ __forceinline__ void moe_table(volatile G8_LAS int* tab, const int* cnt) {
    if (threadIdx.x == 0) { int o = 0; for (int e = 0; e < NE; ++e) { tab[e] = o; tab[64 + e] = cnt[e]; o += (cnt[e] + 255) >> 8; } tab[32] = o; }
}
struct MoeUpOrder {
    const volatile G8_LAS int* tab; const int* ltok; int G, v;
    __device__ bool next(int i, Unit& u) const {
        const int L = i * G + v; const int total = RFL(tab[32]); if (L >= 2 * total) return false;
        int e = 0; UNR for (int k = 1; k < NE; ++k) e = (L >= 2 * tab[k]) ? k : e;
        const int base = tab[e], nte = tab[e + 1] - base, l = L - 2 * base, pn = l / nte, rt = l - pn * nte;
        u.pm = RFL(rt); u.pn = RFL(e * 2 + pn); u.a0 = RFL(e); u.a1 = RFL(tab[64 + e] - rt * 256); u.a2 = RFL((base + rt) * 256); u.a3 = RFL(rt * 256); return true;
    }
    __device__ __forceinline__ unsigned arow(const Unit& u, int r) const { return (r < u.a1) ? (unsigned)(ltok[(size_t)u.a0 * T + u.a3 + r] & 0x3fff) : 0u; }
};
struct MoeDownOrder {
    const volatile G8_LAS int* tab; int G, v;
    __device__ bool next(int i, Unit& u) const {
        const int L = i * G + v; const int total = RFL(tab[32]); if (L >= 8 * total) return false;
        const int gt = L >> 3, pn = L & 7;
        int e = 0; UNR for (int k = 1; k < NE; ++k) e = (gt >= tab[k]) ? k : e;
        const int rt = gt - tab[e];
        u.pm = RFL(gt); u.pn = RFL(e * 8 + pn); u.a0 = RFL(e); u.a1 = RFL(tab[64 + e] - rt * 256); u.a2 = RFL(pn); u.a3 = RFL(rt * 256); return true;
    }
    __device__ __forceinline__ unsigned arow(const Unit& u, int r) const { return (unsigned)(u.pm * BM + r); }
};
}
constexpr int NWAVES = 8;
constexpr int RING_OFF = 0, RING_BYTES = 131072;
constexpr int LDSCTL_OFF = RING_BYTES, MISC_OFF = LDSCTL_OFF, TAB_OFF = LDSCTL_OFF + 512;
constexpr int LDS_BYTES = 147456;
constexpr int CW_TMO = 0, CW_CODE = 1, CW_BAR = 4096;

#define GAS __attribute__((address_space(1)))
#define LAS __attribute__((address_space(3)))
typedef GAS unsigned gu32;
#define RLX_AGENT __ATOMIC_RELAXED, __HIP_MEMORY_SCOPE_AGENT
#define LDS_WAIT() asm volatile("s_waitcnt lgkmcnt(0)" ::: "memory")
#define VM_WAIT() asm volatile("s_waitcnt vmcnt(0)" ::: "memory")

#define XB_TMO      128
#define XB_XCNT(j)  (256  + 64 * (j))
#define XB_XSUB(j)  (1280 + 64 * (j))
#define XB_XGEN(j)  (2304 + 64 * (j))
#define XB_TOP      3328
#define XB_TOPGEN   3392
#define XCD_BAR_WORDS 3456
#define XB_SPIN_CAP (1u << 18)
__device__ __forceinline__ unsigned xb_ld(unsigned* p)              { return __hip_atomic_load(p, __ATOMIC_RELAXED, __HIP_MEMORY_SCOPE_AGENT); }
__device__ __forceinline__ unsigned xb_add(unsigned* p, unsigned v) { return __hip_atomic_fetch_add(p, v, __ATOMIC_RELAXED, __HIP_MEMORY_SCOPE_AGENT); }
__device__ __forceinline__ unsigned xb_xcc_id() { return (unsigned)__builtin_amdgcn_s_getreg((3 << 11) | 20) & 0xFu; }
#define XB_SPIN(cond, bar) do { unsigned _sp = 0; while (cond) { __builtin_amdgcn_s_sleep(1); \
    if ((++_sp & 255u) == 0u) { if (xb_ld(&(bar)[XB_TMO])) break; if (_sp > XB_SPIN_CAP) { atomicAdd(&(bar)[XB_TMO], 1u); break; } } } } while (0)
struct XcdBarrier { unsigned* bar; unsigned x; volatile LAS unsigned* st; };
__device__ __forceinline__ XcdBarrier xcd_barrier_post(unsigned* bar, volatile LAS unsigned* st) {
    XcdBarrier b; b.bar = bar; b.x = xb_xcc_id(); b.st = st;
    if (threadIdx.x == 0) (void)xb_add(&bar[XB_XCNT(b.x)], 1u);
    return b;
}
__device__ __forceinline__ void xcd_barrier_complete(unsigned* bar, unsigned x, unsigned& nloc, unsigned& nx) {
    const unsigned G = gridDim.x * gridDim.y * gridDim.z;
    unsigned sum, cnt, mine, sp = 0u;
    for (;;) {
        sum = 0u; cnt = 0u; mine = 0u;
#pragma unroll
        for (unsigned j = 0; j < 16; ++j) { const unsigned c = xb_ld(&bar[XB_XCNT(j)]); sum += c; cnt += (c > 0u) ? 1u : 0u; mine = (j == x) ? c : mine; }
        if (sum == G) break;
        __builtin_amdgcn_s_sleep(1);
        if ((++sp & 255u) == 0u) { if (xb_ld(&bar[XB_TMO])) break; if (sp > XB_SPIN_CAP) { atomicAdd(&bar[XB_TMO], 1u); break; } }
    }
    nloc = mine > 0u ? mine : 1u; nx = cnt > 0u ? cnt : 1u;
}
__device__ __forceinline__ void xcd_barrier(const XcdBarrier& b) {
    asm volatile("s_waitcnt vmcnt(0)" ::: "memory");
    __syncthreads();
    if (threadIdx.x == 0) {
        unsigned* bar = b.bar;
        __builtin_amdgcn_s_waitcnt(0);
        unsigned nloc = b.st[0], nx = b.st[1];
        if (nloc == 0u) { xcd_barrier_complete(bar, b.x, nloc, nx); b.st[0] = nloc; b.st[1] = nx; }
        const unsigned old = xb_add(&bar[XB_XSUB(b.x)], 1u);
        const unsigned gen = old / nloc;
        if (old + 1u == (gen + 1u) * nloc) {
            __builtin_amdgcn_fence(__ATOMIC_RELEASE, "agent");
            asm volatile("s_waitcnt vmcnt(0)" ::: "memory");
            const unsigned og = xb_add(&bar[XB_TOP], 1u);
            const unsigned tg = og / nx;
            if (og + 1u == (tg + 1u) * nx) xb_add(&bar[XB_TOPGEN], 1u);
            else XB_SPIN(xb_ld(&bar[XB_TOPGEN]) == tg, bar);
            __builtin_amdgcn_fence(__ATOMIC_ACQUIRE, "agent");
            xb_add(&bar[XB_XGEN(b.x)], 1u);
            asm volatile("s_waitcnt vmcnt(0)" ::: "memory");
        } else {
            XB_SPIN(xb_ld(&bar[XB_XGEN(b.x)]) == gen, bar);
            __builtin_amdgcn_fence(__ATOMIC_ACQUIRE, "agent");
            asm volatile("s_waitcnt vmcnt(0)" ::: "memory");
        }
    }
    __syncthreads();
}

struct Args { Bufs b; int ph_lo, ph_hi, li, pad; };

struct Frame {
    LAS unsigned char* lds;
    int tid, lane, wave, vcu, G;
};
__device__ __forceinline__ float wave_sum(float v) {
#pragma unroll
    for (int o = 1; o < 64; o <<= 1) v += __shfl_xor(v, o);
    return v;
}
__device__ __forceinline__ float wave_max(float v) {
#pragma unroll
    for (int o = 1; o < 64; o <<= 1) v = fmaxf(v, __shfl_xor(v, o));
    return v;
}

__device__ __forceinline__ void p0_item(const float* W, int pitch, int K, h16* WT, int scol0, int drow0, int k0, const float* gain, float cs, LAS float* scr, int lane) {
#pragma unroll 8
    for (int i = 0; i < 32; ++i) { const int kk = 2 * i + (lane >> 5); float v = W[(size_t)(k0 + kk) * pitch + scol0 + (lane & 31)] * cs; if (gain) v *= gain[k0 + kk]; scr[kk * 33 + (lane & 31)] = v; }
    LDS_WAIT(); asm volatile("" ::: "memory");
    const int c = lane & 7;
#pragma unroll
    for (int j = 0; j < 4; ++j) { const int n = (lane >> 3) + 8 * j; const LAS float* s = scr + (8 * c) * 33 + n;
        u32x4 o; o.x = g8::pk_h2(s[0 * 33], s[1 * 33]); o.y = g8::pk_h2(s[2 * 33], s[3 * 33]); o.z = g8::pk_h2(s[4 * 33], s[5 * 33]); o.w = g8::pk_h2(s[6 * 33], s[7 * 33]);
        *(u32x4*)(WT + (size_t)(drow0 + n) * K + k0 + 8 * c) = o; }
    LDS_WAIT(); asm volatile("" ::: "memory");
}
__device__ __forceinline__ void phase_prologue(const Frame& F, const Bufs& b) {
    LAS float* scr = (LAS float*)(F.lds + RING_OFF + F.wave * 16384);
    const int gw = F.vcu * NWAVES + F.wave, NGW = F.G * NWAVES, lane = F.lane;
    constexpr int I0 = 32 * 136, I1 = 32 * 64, I2 = 64 * 256, I3 = 32 * 256, I4 = 4 * 64, I5 = 32 * 64, NITEMS = I0 + I1 + I2 + I3 + I4 + I5;
    for (int row = gw; row < T; row += NGW) {
        const float* xr = b.x + (size_t)row * D; float ss = 0.f;
#pragma unroll
        for (int j = 0; j < D / 256; ++j) { const f32x4 v = *(const f32x4*)(xr + j * 256 + lane * 4); ss += v.x * v.x + v.y * v.y + v.z * v.z + v.w * v.w;
            u32x2 o; o.x = g8::pk_h2(v.x, v.y); o.y = g8::pk_h2(v.z, v.w); *(u32x2*)(b.x16 + (size_t)row * D + j * 256 + lane * 4) = o; }
        ss = wave_sum(ss); if (lane == 0) b.r1[row] = 1.0f / sqrtf(ss * (1.0f / D) + EPS);
        { const f32x4 v = *(const f32x4*)(b.p + (size_t)row * PLE + lane * 4); u32x2 o; o.x = g8::pk_h2(v.x, v.y); o.y = g8::pk_h2(v.z, v.w); *(u32x2*)(b.p16 + (size_t)row * PLE + lane * 4) = o; }
    }
    for (int it = gw; it < NITEMS; it += NGW) {
        int r = it;
        if (r < I0) { const int kb = r / 136, nb = r % 136, n0 = 32 * nb; const float cs = (n0 < 1024) ? QSCALE_A : ((n0 >= 3072 && n0 < 4096) ? QSCALE_B : 1.f);
            p0_item(b.w_in, NIN, D, b.WinT, n0, n0, 64 * kb, b.g_mix, cs, scr, lane); continue; } r -= I0;
        if (r < I1) { const int kb = r / 64, nb = r % 64; p0_item(b.w_out, D, D, b.WoutT, 32 * nb, 32 * nb, 64 * kb, nullptr, 1.f, scr, lane); continue; } r -= I1;
        if (r < I2) { const int z = r / 256, q = r % 256, kb = q / 8, nb = q % 8, n0 = 32 * nb, e = z >> 1, pn = z & 1;
            const float* src = ((n0 < 128) ? b.w_gate : b.w_up) + (size_t)e * D * DE;
            p0_item(src, DE, D, b.WguT + (size_t)z * 256 * D, 128 * pn + (n0 & 127), n0, 64 * kb, b.g_moe, 1.f, scr, lane); continue; } r -= I2;
        if (r < I3) { const int e = r / 256, q = r % 256, kb = q / 64, nb = q % 64;
            p0_item(b.w_down + (size_t)e * DE * D, D, DE, b.WdT + (size_t)e * D * DE, 32 * nb, 32 * nb, 64 * kb, nullptr, 1.f, scr, lane); continue; } r -= I3;
        if (r < I4) { const int kb = r / 64, nb = r % 64; p0_item(b.w_ple, D, PLE, b.WpleT, 32 * nb, 32 * nb, 64 * kb, nullptr, 1.f, scr, lane); continue; } r -= I4;
        { const int kb = r / 64, nb = r % 64; p0_item(b.w_pg, D, D, b.WpgT, 32 * nb, 32 * nb, 64 * kb, b.g_ple, 1.f, scr, lane); }
    }
    for (int idx = (F.vcu * NWAVES * 64) + F.tid; idx < 80 * D; idx += F.G * NWAVES * 64) {
        const int c = idx / D, k = idx % D; h16 o = (h16)0.f;
        if (c < 72) { const int cc = (c < 36) ? c : c - 36; const float v = ((cc < 4) ? b.w_grp[(size_t)k * 4 + cc] : b.w_exp[(size_t)k * 32 + (cc - 4)]) * b.g_moe[k];
            const h16 hi = (h16)v; o = (c < 36) ? hi : (h16)(v - (float)hi); }
        b.Wr16[idx] = o;
    }
}

template <int HD, int NBR, int NJ> __device__ __forceinline__ void attn_wave_task(const Bufs& b, int id, LAS float* qs, LAS float* sc, int lane) {
    constexpr int NH = (NBR == 3) ? AH : BH;
    const int tok = id / NH, head = id % NH; const int bb = tok / SEQ, tpos = tok % SEQ;
    int qcol, kcol, vcol, ocol; float slope2, sink2 = -INFINITY;
    if (NBR == 3) { qcol = head * 128; kcol = 1024 + head * 128; vcol = 2048 + head * 128; ocol = head * 128; slope2 = exp2f(-(float)(head + 1)) * LOG2E; }
    else { const int kv = head / BG; qcol = 3072 + head * 64; kcol = 4096 + kv * 64; vcol = 4224 + kv * 64; ocol = 1024 + head * 64; slope2 = exp2f(-0.5f * (float)(head + 1)) * LOG2E; sink2 = b.sinks[head] * LOG2E; }
    const h16* base = b.proj + (size_t)bb * SEQ * NIN;
    for (int d = lane; d < HD; d += 64) qs[d] = (float)base[(size_t)tpos * NIN + qcol + d];
    LDS_WAIT();
    float mx = -INFINITY;
    for (int i = lane; i < NBR * NJ; i += 64) {
        const int br = i / NJ, j = i % NJ; const int dil = (br == 0) ? 1 : (br == 1 ? 4 : 16); const int s = tpos - dil * j; float v = -INFINITY;
        if (s >= 0) { const h16* kr = base + (size_t)s * NIN + kcol; float a = 0.f;
            for (int d = 0; d < HD; d += 8) { const half8 kk = *(const half8*)(kr + d);
#pragma unroll
                for (int e = 0; e < 8; ++e) a += qs[d + e] * (float)kk[e]; }
            v = a - slope2 * (float)(dil * j); }
        sc[i] = v; mx = fmaxf(mx, v);
    }
    mx = wave_max(mx); mx = fmaxf(mx, sink2);
    LDS_WAIT();
    float sum = 0.f;
    for (int i = lane; i < NBR * NJ; i += 64) { const float pv = exp2f(sc[i] - mx); sc[i] = pv; sum += pv; }
    sum = wave_sum(sum); sum += exp2f(sink2 - mx);
    LDS_WAIT();
    constexpr int DPL = HD / 64;
    float o[DPL];
#pragma unroll
    for (int e = 0; e < DPL; ++e) o[e] = 0.f;
    for (int i = 0; i < NBR * NJ; ++i) {
        const float pv = sc[i]; if (pv == 0.f) continue;
        const int br = i / NJ, j = i % NJ; const int dil = (br == 0) ? 1 : (br == 1 ? 4 : 16); const int s = tpos - dil * j; const h16* vr = base + (size_t)s * NIN + vcol + lane * DPL;
#pragma unroll
        for (int e = 0; e < DPL; ++e) o[e] += pv * (float)vr[e];
    }
    const float inv = 1.f / sum;
#pragma unroll
    for (int e = 0; e < DPL; ++e) b.mixed[(size_t)tok * D + ocol + lane * DPL + e] = (h16)(o[e] * inv);
    LDS_WAIT();
}
__device__ __forceinline__ void phase_attn_simple(const Frame& F, const Bufs& b) {
    LAS float* qs = (LAS float*)(F.lds + RING_OFF + F.wave * 4096); LAS float* sc = qs + 128;
    const int gw = F.vcu * NWAVES + F.wave, NGW = F.G * NWAVES;
    for (int id = gw; id < T * AH; id += NGW) attn_wave_task<128, 3, 129>(b, id, qs, sc, F.lane);
    for (int id = gw; id < T * BH; id += NGW) attn_wave_task<64, 1, 128>(b, id, qs, sc, F.lane);
}

__device__ __forceinline__ void phase_route(const Frame& F, const Bufs& b) {
    LAS float* lg = (LAS float*)(F.lds + RING_OFF);
    LAS float* sq = lg + 64 * 81;
    const int lane = F.lane, fr = lane & 15, fq = lane >> 4, rt = F.wave & 3, cg = F.wave >> 2;
    for (int tb = F.vcu; tb < T / 64; tb += F.G) {
        const int r0 = tb * 64;
        const h16* ap = b.h1 + (size_t)(r0 + rt * 16 + fr) * D + fq * 8;
        const h16* bp = b.Wr16 + (size_t)(cg * 48 + fr) * D + fq * 8;
        f32x4 acc0 = {0.f, 0.f, 0.f, 0.f}, acc1 = acc0, acc2 = acc0; float ss = 0.f;
#pragma unroll 4
        for (int ks = 0; ks < D / 32; ++ks) {
            const half8 a = *(const half8*)(ap + ks * 32);
            const half8 b0 = *(const half8*)(bp + ks * 32), b1 = *(const half8*)(bp + 16 * D + ks * 32);
            acc0 = __builtin_amdgcn_mfma_f32_16x16x32_f16(a, b0, acc0, 0, 0, 0);
            acc1 = __builtin_amdgcn_mfma_f32_16x16x32_f16(a, b1, acc1, 0, 0, 0);
            if (cg == 0) { const half8 b2 = *(const half8*)(bp + 32 * D + ks * 32); acc2 = __builtin_amdgcn_mfma_f32_16x16x32_f16(a, b2, acc2, 0, 0, 0);
#pragma unroll
                for (int j = 0; j < 8; ++j) { const float v = (float)a[j]; ss += v * v; } }
        }
#pragma unroll
        for (int r = 0; r < 4; ++r) { const int row = rt * 16 + 4 * fq + r; lg[row * 81 + cg * 48 + fr] = acc0[r]; lg[row * 81 + cg * 48 + 16 + fr] = acc1[r]; if (cg == 0) lg[row * 81 + 32 + fr] = acc2[r]; }
        if (cg == 0) { ss += __shfl_xor(ss, 16); ss += __shfl_xor(ss, 32); if (fq == 0) sq[rt * 16 + fr] = ss; }
        LDS_WAIT(); __syncthreads();
        if (F.tid < 64) {
            const int tok = r0 + F.tid; const LAS float* L = lg + F.tid * 81;
            const float rs = 1.0f / sqrtf(sq[F.tid] * (1.0f / D) + EPS);
            float gl[4];
#pragma unroll
            for (int g = 0; g < 4; ++g) gl[g] = (L[g] + L[36 + g]) * rs + b.b_grp[g];
            int gi = 0; float gm = gl[0];
#pragma unroll
            for (int g = 1; g < 4; ++g) if (gl[g] > gm) { gm = gl[g]; gi = g; }
            float gs = 0.f;
#pragma unroll
            for (int g = 0; g < 4; ++g) gs += __expf(gl[g] - gm);
            const float gw = 1.f / gs;
            int i0 = 0, i1 = 0; float v0 = -INFINITY, v1 = -INFINITY;
            for (int e = 0; e < 8; ++e) { const float v = (L[4 + gi * 8 + e] + L[40 + gi * 8 + e]) * rs + b.b_exp[gi * 8 + e];
                if (v > v0) { v1 = v0; i1 = i0; v0 = v; i0 = e; } else if (v > v1) { v1 = v; i1 = e; } }
            const float e1 = __expf(v1 - v0); const float w0 = gw / (1.f + e1), w1 = gw * e1 / (1.f + e1);
            const int ea = gi * 8 + i0, eb = gi * 8 + i1;
            b.r2[tok] = rs;
            const int pa = atomicAdd(b.cnt + ea, 1); b.ltok[(size_t)ea * T + pa] = tok; b.lw[(size_t)ea * T + pa] = w0;
            const int pb = atomicAdd(b.cnt + eb, 1); b.ltok[(size_t)eb * T + pb] = tok | (1 << 30); b.lw[(size_t)eb * T + pb] = w1;
        }
        __syncthreads();
    }
}

__device__ __forceinline__ void phase_combine(const Frame& F, const Bufs& b) {
    const int gw = F.vcu * NWAVES + F.wave, NGW = F.G * NWAVES, lane = F.lane;
    for (int tok = gw; tok < T; tok += NGW) {
        float ss = 0.f;
#pragma unroll
        for (int j = 0; j < 4; ++j) { const size_t o = (size_t)tok * D + j * 512 + lane * 8;
            const half8 a = *(const half8*)(b.h1 + o), c0 = *(const half8*)(b.y + o), c1 = *(const half8*)(b.y + (size_t)T * D + o); half8 r;
#pragma unroll
            for (int e = 0; e < 8; ++e) { const float s = (float)a[e] + (float)c0[e] + (float)c1[e]; ss += s * s; r[e] = (h16)s; }
            *(half8*)(b.h2 + o) = r; }
        ss = wave_sum(ss); if (lane == 0) b.r3[tok] = 1.0f / sqrtf(ss * (1.0f / D) + EPS);
    }
}
__device__ __forceinline__ void phase_final(const Frame& F, const Bufs& b) {
    const int gw = F.vcu * NWAVES + F.wave, NGW = F.G * NWAVES, lane = F.lane;
    for (int tok = gw; tok < T; tok += NGW) {
        const float rs = 1.0f / sqrtf(b.ssq[tok] * (1.0f / D) + EPS);
#pragma unroll
        for (int j = 0; j < 8; ++j) { const size_t o = (size_t)tok * D + j * 256 + lane * 4; f32x4 v = *(f32x4*)(b.out + o); const f32x4 gg = *(const f32x4*)(b.g_final + j * 256 + lane * 4);
            v.x *= rs * gg.x; v.y *= rs * gg.y; v.z *= rs * gg.z; v.w *= rs * gg.w; *(f32x4*)(b.out + o) = v; }
    }
}
constexpr int NPH = 10;
__global__ void __launch_bounds__(NWAVES * 64, 2) mega(Args args) {
    extern __shared__ __attribute__((aligned(16))) unsigned char lds[];
    const Bufs& b = args.b;
    Frame F;
    F.lds = (LAS unsigned char*)lds;
    F.tid = threadIdx.x; F.lane = F.tid & 63; F.wave = __builtin_amdgcn_readfirstlane(F.tid >> 6);
    F.G = gridDim.x; { const int bx = blockIdx.x; F.vcu = (F.G % 8 == 0) ? (bx % 8) * (F.G / 8) + bx / 8 : bx; }
    volatile LAS unsigned* MISC = (volatile LAS unsigned*)(F.lds + MISC_OFF);
    volatile LAS int* tab = (volatile LAS int*)(F.lds + TAB_OFF);
    for (int u = F.tid; u < (LDS_BYTES - LDSCTL_OFF) / 4; u += NWAVES * 64) ((LAS unsigned*)(F.lds + LDSCTL_OFF))[u] = 0u;
    __syncthreads();
    unsigned* ctl = (unsigned*)(b.ws + WS_CTL);
    XcdBarrier bar = xcd_barrier_post(ctl + CW_BAR + args.li * XCD_BAR_WORDS, MISC + 8);
    const int lo = args.ph_lo, hi = args.ph_hi;
#ifdef ONLY_PHASE
#define IN(k) ((k) == ONLY_PHASE && lo <= (k) && (k) < hi)
#else
#define IN(k) (lo <= (k) && (k) < hi)
#endif
#define SEAM(k) do { if (IN(k) && IN((k) + 1)) xcd_barrier(bar); } while (0)
    G8_LAS unsigned char* ring = F.lds + RING_OFF;

    if (IN(0)) { phase_prologue(F, b); } SEAM(0);
    if (IN(1)) {
        { g8::Gemm g{b.x16, b.WinT, D}; g8::StaticOrder S; S.init(T, NIN, F.G, (int)blockIdx.x); g8::EpiProj E{b.proj, b.r1}; g8::gemm_phase<g8::EpiProj, g8::StaticOrder>(ring, g, S, E); }
        { g8::Gemm g{b.p16, b.WpleT, PLE}; g8::StaticOrder S; S.init(T, D, F.G, (int)blockIdx.x); g8::EpiPlain E{b.pw16, D}; g8::gemm_phase<g8::EpiPlain, g8::StaticOrder>(ring, g, S, E); }
    } SEAM(1);
    if (IN(2)) { phase_attn_simple(F, b); } SEAM(2);
    if (IN(3)) { g8::Gemm g{b.mixed, b.WoutT, D}; g8::StaticOrder S; S.init(T, D, F.G, (int)blockIdx.x); g8::EpiRes E{b.h1, b.x}; g8::gemm_phase<g8::EpiRes, g8::StaticOrder>(ring, g, S, E); } SEAM(3);
    if (IN(4)) { phase_route(F, b); } SEAM(4);
    if (IN(5)) { g8::moe_table(tab, b.cnt); LDS_WAIT(); __syncthreads();
        g8::Gemm g{b.h1, b.WguT, D}; g8::MoeUpOrder S{tab, b.ltok, F.G, F.vcu}; g8::EpiMoeUp E{b.hid, b.ltok, b.lw, b.r2}; g8::gemm_phase<g8::EpiMoeUp, g8::MoeUpOrder>(ring, g, S, E); } SEAM(5);
    if (IN(6)) { g8::moe_table(tab, b.cnt); LDS_WAIT(); __syncthreads();
        g8::Gemm g{b.hid, b.WdT, DE}; g8::MoeDownOrder S{tab, F.G, F.vcu}; g8::EpiMoeDown E{b.y, b.ltok}; g8::gemm_phase<g8::EpiMoeDown, g8::MoeDownOrder>(ring, g, S, E); } SEAM(6);
    if (IN(7)) { phase_combine(F, b); } SEAM(7);
    if (IN(8)) { g8::Gemm g{b.h2, b.WpgT, D}; g8::StaticOrder S; S.init(T, D, F.G, (int)blockIdx.x); g8::EpiPle E{b.out, b.h2, b.pw16, b.r3, b.ssq}; g8::gemm_phase<g8::EpiPle, g8::StaticOrder>(ring, g, S, E); } SEAM(8);
    if (IN(9)) { phase_final(F, b); }
#undef IN
#undef SEAM
}

static int g_grid = 0;
static bool mega_setup() {
    if (g_grid) return g_grid > 0;
    int dev = 0, cus = 0, per_cu = 0;
    if (hipGetDevice(&dev) != hipSuccess || hipDeviceGetAttribute(&cus, hipDeviceAttributeMultiprocessorCount, dev) != hipSuccess) { g_grid = -1; return false; }
    if (hipFuncSetAttribute((const void*)mega, hipFuncAttributeMaxDynamicSharedMemorySize, LDS_BYTES) != hipSuccess) { fprintf(stderr, "hipFuncSetAttribute failed\n"); g_grid = -1; return false; }
    if (hipOccupancyMaxActiveBlocksPerMultiprocessor(&per_cu, (const void*)mega, NWAVES * 64, LDS_BYTES) != hipSuccess || per_cu < 1) { fprintf(stderr, "occupancy query: %d\n", per_cu); (void)hipGetLastError(); g_grid = -1; return false; }
    g_grid = cus;
    return true;
}
static void mega_run(const Bufs& b, int lo, int hi, int li, hipStream_t s) {
    Args a{}; a.b = b; a.ph_lo = lo; a.ph_hi = hi; a.li = li; a.pad = 0;
    hipLaunchKernelGGL(mega, dim3(g_grid), dim3(NWAVES * 64), LDS_BYTES, s, a);
}
extern "C" void kernel_launch(void* const* d_in, const int* in_sizes, int n_in, void* d_out, int out_size, void* d_ws, size_t ws_size, hipStream_t stream) {
    if (n_in != 18 || out_size != T * D || ws_size < WS_END) { fprintf(stderr, "kernel_launch: unexpected shapes: n_in %d out %d ws %zu\n", n_in, out_size, ws_size); return; }
    if (!mega_setup()) return;
    Bufs b = make_bufs(d_in, d_out, d_ws);
    (void)hipMemsetAsync((char*)d_ws + WS_CTL, 0, CTL_ZERO_BYTES, stream);
    mega_run(b, 0, NPH, 0, stream);
}
```

```cpp
#include <hip/hip_runtime.h>
#include <cstdint>
#include <cstdio>
#include <cmath>

typedef _Float16 h16;
typedef _Float16 half8 __attribute__((ext_vector_type(8)));
typedef _Float16 h16x4 __attribute__((ext_vector_type(4)));
typedef _Float16 h16x2 __attribute__((ext_vector_type(2)));
typedef float f32x4 __attribute__((ext_vector_type(4)));
typedef float f32x2 __attribute__((ext_vector_type(2)));
typedef float f32x16 __attribute__((ext_vector_type(16)));
typedef unsigned u32x4 __attribute__((ext_vector_type(4)));
typedef unsigned u32x2 __attribute__((ext_vector_type(2)));
#define UNR _Pragma("unroll")

constexpr int BATCH = 8, SEQ = 2048, T = BATCH * SEQ, D = 2048, PLE = 256;
constexpr int AH = 8, AHD = 128, BH = 16, BHD = 64, BKV = 2, BG = 8;
constexpr int NIN = 4352;
constexpr int NE = 32, DE = 256;
constexpr float EPS = 1e-6f;
constexpr float LOG2E = 1.4426950408889634f;
constexpr float QSCALE_A = 0.08838834764831845f * LOG2E;
constexpr float QSCALE_B = 0.125f * LOG2E;

constexpr size_t MiB = 1u << 20;
constexpr size_t WS_CTL = 0, CTL_ZERO_BYTES = 1 * MiB;
constexpr size_t CTL_CNT = 256 * 1024, CTL_SSQ = 320 * 1024;
constexpr size_t WS_R1 = 1 * MiB, WS_R2 = WS_R1 + 64 * 1024, WS_R3 = WS_R2 + 64 * 1024;
constexpr size_t WS_LTOK = 2 * MiB, WS_LW = 4 * MiB, WS_WR = 6 * MiB, WS_WR16 = 7 * MiB;
constexpr size_t WS_WIN = 8 * MiB, WS_WOUT = 25 * MiB, WS_WGU = 33 * MiB, WS_WD = 97 * MiB, WS_WPLE = 129 * MiB, WS_WPG = 130 * MiB;
constexpr size_t WS_P16 = 138 * MiB, WS_PW16 = 146 * MiB;
constexpr size_t WS_RA = 210 * MiB;
constexpr size_t WS_RB = 274 * MiB;
constexpr size_t WS_RD = 410 * MiB;
constexpr size_t WS_END = 474 * MiB;

namespace nv {

__device__ __forceinline__ float wave_sum(float v) {
#pragma unroll
    for (int o = 1; o < 64; o <<= 1) v += __shfl_xor(v, o);
    return v;
}
__device__ __forceinline__ float wave_max(float v) {
#pragma unroll
    for (int o = 1; o < 64; o <<= 1) v = fmaxf(v, __shfl_xor(v, o));
    return v;
}

__global__ __launch_bounds__(256) void k_prep_x(const float* __restrict__ x, h16* __restrict__ x16, float* __restrict__ r1,
                                                const float* __restrict__ p, h16* __restrict__ p16) {
    const int wid = threadIdx.x >> 6, lane = threadIdx.x & 63;
    const int row = blockIdx.x * 4 + wid;
    if (row >= T) return;
    const float* xr = x + (size_t)row * D;
    float ss = 0.f;
    for (int j = 0; j < D / 256; ++j) {
        const f32x4 v = *(const f32x4*)(xr + j * 256 + lane * 4);
        ss += v.x * v.x + v.y * v.y + v.z * v.z + v.w * v.w;
        h16x4 o = {(h16)v.x, (h16)v.y, (h16)v.z, (h16)v.w};
        *(h16x4*)(x16 + (size_t)row * D + j * 256 + lane * 4) = o;
    }
    ss = wave_sum(ss);
    if (lane == 0) r1[row] = 1.0f / sqrtf(ss * (1.0f / D) + EPS);
    {
        const f32x4 v = *(const f32x4*)(p + (size_t)row * PLE + lane * 4);
        h16x4 o = {(h16)v.x, (h16)v.y, (h16)v.z, (h16)v.w};
        *(h16x4*)(p16 + (size_t)row * PLE + lane * 4) = o;
    }
}

struct TrJob { const float* src; const float* src2; h16* dst; const float* gain; int pitch, K, N, mode; long src_z, dst_z; };
__global__ __launch_bounds__(256) void k_transpose(TrJob j) {
    __shared__ float tile[64][65];
    const int z = blockIdx.z;
    const int k0 = blockIdx.y * 64, n0 = blockIdx.x * 64;
    const int tx = threadIdx.x & 63, ty = threadIdx.x >> 6;
    const float* src = j.src; const float* src2 = j.src2; h16* dst = j.dst + (size_t)z * j.dst_z;
    int pn = 0;
    if (j.mode == 2) { const int e = z >> 1; pn = z & 1; src += (size_t)e * j.src_z; src2 += (size_t)e * j.src_z; }
    else { src += (size_t)z * j.src_z; }
    {
        const int n = n0 + tx;
        const float* s = src; int col = n;
        if (j.mode == 2) { s = (n < 128) ? src : src2; col = 128 * pn + (n & 127); }
        float cs = 1.f;
        if (j.mode == 1) { if (n < 1024) cs = QSCALE_A; else if (n >= 3072 && n < 4096) cs = QSCALE_B; }
        for (int i = 0; i < 16; ++i) {
            const int k = k0 + ty + 4 * i;
            float v = s[(size_t)k * j.pitch + col] * cs;
            if (j.gain) v *= j.gain[k];
            tile[ty + 4 * i][tx] = v;
        }
    }
    __syncthreads();
    for (int i = 0; i < 16; ++i) {
        const int n = n0 + ty + 4 * i;
        dst[(size_t)n * j.K + k0 + tx] = (h16)tile[tx][ty + 4 * i];
    }
}
__global__ void k_router_w(const float* __restrict__ w_grp, const float* __restrict__ w_exp, const float* __restrict__ g, float* __restrict__ Wr) {
    const int idx = blockIdx.x * blockDim.x + threadIdx.x;
    if (idx >= 36 * D) return;
    const int c = idx / D, k = idx % D;
    const float v = (c < 4) ? w_grp[(size_t)k * 4 + c] : w_exp[(size_t)k * 32 + (c - 4)];
    Wr[idx] = v * g[k];
}

template <class Op> __global__ __launch_bounds__(256) void k_gemm(Op op) {
    const int z = blockIdx.z;
    const int M = op.mrows(z);
    const int row0 = blockIdx.y * 128; if (row0 >= M) return;
    const int col0 = blockIdx.x * 128;
    const int wid = threadIdx.x >> 6, lane = threadIdx.x & 63, wy = wid >> 1, wx = wid & 1, fr = lane & 15, fq = lane >> 4;
    f32x4 acc[4][4];
#pragma unroll
    for (int a = 0; a < 4; ++a)
#pragma unroll
        for (int b = 0; b < 4; ++b) acc[a][b] = (f32x4){0.f, 0.f, 0.f, 0.f};
    const h16* ap[4]; const h16* bp[4];
#pragma unroll
    for (int mi = 0; mi < 4; ++mi) ap[mi] = op.arow(z, row0 + wy * 64 + mi * 16 + fr) + fq * 8;
#pragma unroll
    for (int ni = 0; ni < 4; ++ni) bp[ni] = op.brow(z, col0 + wx * 64, ni, fr) + fq * 8;
    for (int k0 = 0; k0 < op.K; k0 += 32) {
        half8 a[4], b[4];
#pragma unroll
        for (int i = 0; i < 4; ++i) { a[i] = *(const half8*)(ap[i] + k0); b[i] = *(const half8*)(bp[i] + k0); }
#pragma unroll
        for (int mi = 0; mi < 4; ++mi)
#pragma unroll
            for (int ni = 0; ni < 4; ++ni) acc[mi][ni] = __builtin_amdgcn_mfma_f32_16x16x32_f16(a[mi], b[ni], acc[mi][ni], 0, 0, 0);
    }
    op.epi(z, row0 + wy * 64, col0 + wx * 64, acc, fr, fq);
}

struct OpBase { int K; };
struct OpG1 : OpBase {
    const h16* A; const h16* Bt; const float* r1; h16* out;
    __device__ int mrows(int) const { return T; }
    __device__ const h16* arow(int, int r) const { return A + (size_t)r * D; }
    __device__ const h16* brow(int, int cb, int ni, int fr) const { return Bt + (size_t)(cb + ni * 16 + fr) * D; }
    __device__ void epi(int, int rb, int cb, f32x4 (&acc)[4][4], int fr, int fq) const {
        UNR for (int mi = 0; mi < 4; ++mi) UNR for (int r = 0; r < 4; ++r) { const int row = rb + mi * 16 + fq * 4 + r; const float s = r1[row];
            UNR for (int ni = 0; ni < 4; ++ni) out[(size_t)row * NIN + cb + ni * 16 + fr] = (h16)(acc[mi][ni][r] * s); }
    }
};
struct OpG3 : OpBase {
    const h16* A; const h16* Bt; const float* x; h16* out;
    __device__ int mrows(int) const { return T; }
    __device__ const h16* arow(int, int r) const { return A + (size_t)r * D; }
    __device__ const h16* brow(int, int cb, int ni, int fr) const { return Bt + (size_t)(cb + ni * 16 + fr) * D; }
    __device__ void epi(int, int rb, int cb, f32x4 (&acc)[4][4], int fr, int fq) const {
        UNR for (int mi = 0; mi < 4; ++mi) UNR for (int r = 0; r < 4; ++r) { const int row = rb + mi * 16 + fq * 4 + r;
            UNR for (int ni = 0; ni < 4; ++ni) { const size_t o = (size_t)row * D + cb + ni * 16 + fr; out[o] = (h16)(x[o] + acc[mi][ni][r]); } }
    }
};
__device__ __forceinline__ void moe_offsets(const int* cnt, int e, int& off, int& n) {
    int o = 0; for (int i = 0; i < e; ++i) o += (cnt[i] + 255) & ~255; off = o; n = cnt[e];
}
struct OpMU : OpBase {
    const h16* A; const h16* Wgu; const int* cnt; const int* ltok; const float* lw; const float* r2; h16* hid;
    __device__ int mrows(int z) const { return cnt[z]; }
    __device__ const h16* arow(int z, int r) const { const int n = cnt[z]; const int tok = (r < n) ? (ltok[(size_t)z * T + r] & 0x3fff) : 0; return A + (size_t)tok * D; }
    __device__ const h16* brow(int z, int cb, int ni, int fr) const {
        const int hc = (cb >> 6) * 32 + (ni & 1) * 16 + fr; const int pn = hc >> 7, i = hc & 127;
        return Wgu + ((size_t)(z * 2 + pn) * 256 + (ni >> 1) * 128 + i) * D;
    }
    __device__ void epi(int z, int rb, int cb, f32x4 (&acc)[4][4], int fr, int fq) const {
        int off, n; moe_offsets(cnt, z, off, n);
        UNR for (int mi = 0; mi < 4; ++mi) UNR for (int r = 0; r < 4; ++r) { const int pos = rb + mi * 16 + fq * 4 + r; if (pos >= n) continue;
            const int tok = ltok[(size_t)z * T + pos] & 0x3fff; const float s = r2[tok], w = lw[(size_t)z * T + pos];
            UNR for (int ni = 0; ni < 2; ++ni) { const float g = acc[mi][ni][r] * s, u = acc[mi][ni + 2][r] * s;
                const float v = g / (1.f + __expf(-g)) * u * w; const int hc = (cb >> 6) * 32 + ni * 16 + fr;
                hid[(size_t)(off + pos) * DE + hc] = (h16)v; } }
    }
};
struct OpMD : OpBase {
    const h16* hid; const h16* Wd; const int* cnt; const int* ltok; h16* y;
    __device__ int mrows(int z) const { return cnt[z]; }
    __device__ const h16* arow(int z, int r) const { int off, n; moe_offsets(cnt, z, off, n); return hid + (size_t)(off + r) * DE; }
    __device__ const h16* brow(int z, int cb, int ni, int fr) const { return Wd + ((size_t)z * D + cb + ni * 16 + fr) * DE; }
    __device__ void epi(int z, int rb, int cb, f32x4 (&acc)[4][4], int fr, int fq) const {
        const int n = cnt[z];
        UNR for (int mi = 0; mi < 4; ++mi) UNR for (int r = 0; r < 4; ++r) { const int pos = rb + mi * 16 + fq * 4 + r; if (pos >= n) continue;
            const int lt = ltok[(size_t)z * T + pos]; const int tok = lt & 0x3fff, slot = (lt >> 30) & 1;
            UNR for (int ni = 0; ni < 4; ++ni) y[((size_t)slot * T + tok) * D + cb + ni * 16 + fr] = (h16)acc[mi][ni][r]; }
    }
};
struct OpPW : OpBase {
    const h16* A; const h16* Bt; h16* out;
    __device__ int mrows(int) const { return T; }
    __device__ const h16* arow(int, int r) const { return A + (size_t)r * PLE; }
    __device__ const h16* brow(int, int cb, int ni, int fr) const { return Bt + (size_t)(cb + ni * 16 + fr) * PLE; }
    __device__ void epi(int, int rb, int cb, f32x4 (&acc)[4][4], int fr, int fq) const {
        UNR for (int mi = 0; mi < 4; ++mi) UNR for (int r = 0; r < 4; ++r) { const int row = rb + mi * 16 + fq * 4 + r;
            UNR for (int ni = 0; ni < 4; ++ni) out[(size_t)row * D + cb + ni * 16 + fr] = (h16)acc[mi][ni][r]; }
    }
};
struct OpG5 : OpBase {
    const h16* A; const h16* Bt; const float* r3; const h16* pw; float* out; float* ssq;
    __device__ int mrows(int) const { return T; }
    __device__ const h16* arow(int, int r) const { return A + (size_t)r * D; }
    __device__ const h16* brow(int, int cb, int ni, int fr) const { return Bt + (size_t)(cb + ni * 16 + fr) * D; }
    __device__ void epi(int, int rb, int cb, f32x4 (&acc)[4][4], int fr, int fq) const {
        UNR for (int mi = 0; mi < 4; ++mi) UNR for (int r = 0; r < 4; ++r) { const int row = rb + mi * 16 + fq * 4 + r; const float s = r3[row]; float q = 0.f;
            UNR for (int ni = 0; ni < 4; ++ni) { const size_t o = (size_t)row * D + cb + ni * 16 + fr; const float g = 1.f / (1.f + __expf(-acc[mi][ni][r] * s));
                const float h3 = (float)A[o] + g * (float)pw[o]; out[o] = h3; q += h3 * h3; }
            q += __shfl_xor(q, 1); q += __shfl_xor(q, 2); q += __shfl_xor(q, 4); q += __shfl_xor(q, 8);
            if (fr == 0) atomicAdd(ssq + row, q); }
    }
};

template <int HD, int NBR, int NJ> __global__ __launch_bounds__(256) void k_attn(const h16* __restrict__ proj, h16* __restrict__ mixed, const float* __restrict__ sinks) {
    constexpr int NH = (NBR == 3) ? AH : BH;
    __shared__ float qs[4][HD];
    __shared__ float sc[4][NBR * NJ + 1];
    const int wid = threadIdx.x >> 6, lane = threadIdx.x & 63;
    const int id = blockIdx.x * 4 + wid;
    const int tok = id / NH, head = id % NH;
    const int b = tok / SEQ, tpos = tok % SEQ;
    int qcol, kcol, vcol, ocol; float slope2, sink2 = -INFINITY;
    if (NBR == 3) { qcol = head * 128; kcol = 1024 + head * 128; vcol = 2048 + head * 128; ocol = head * 128; slope2 = exp2f(-(float)(head + 1)) * LOG2E; }
    else { const int kv = head / BG; qcol = 3072 + head * 64; kcol = 4096 + kv * 64; vcol = 4224 + kv * 64; ocol = 1024 + head * 64;
           slope2 = exp2f(-0.5f * (float)(head + 1)) * LOG2E; sink2 = sinks[head] * LOG2E; }
    const h16* base = proj + (size_t)b * SEQ * NIN;
    for (int d = lane; d < HD; d += 64) qs[wid][d] = (float)base[(size_t)tpos * NIN + qcol + d];
    __syncthreads();
    float mx = -INFINITY;
    for (int i = lane; i < NBR * NJ; i += 64) {
        const int br = i / NJ, j = i % NJ; const int dil = (br == 0) ? 1 : (br == 1 ? 4 : 16);
        const int s = tpos - dil * j; float v = -INFINITY;
        if (s >= 0) { const h16* kr = base + (size_t)s * NIN + kcol; float a = 0.f;
            for (int d = 0; d < HD; d += 8) { const half8 kk = *(const half8*)(kr + d);
#pragma unroll
                for (int e = 0; e < 8; ++e) a += qs[wid][d + e] * (float)kk[e]; }
            v = a - slope2 * (float)(dil * j); }
        sc[wid][i] = v; mx = fmaxf(mx, v);
    }
    mx = wave_max(mx); mx = fmaxf(mx, sink2);
    __syncthreads();
    float sum = 0.f;
    for (int i = lane; i < NBR * NJ; i += 64) { const float pv = exp2f(sc[wid][i] - mx); sc[wid][i] = pv; sum += pv; }
    sum = wave_sum(sum); sum += exp2f(sink2 - mx);
    __syncthreads();
    constexpr int DPL = HD / 64;
    float o[DPL]; UNR for (int e = 0; e < DPL; ++e) o[e] = 0.f;
    for (int i = 0; i < NBR * NJ; ++i) {
        const float pv = sc[wid][i]; if (pv == 0.f) continue;
        const int br = i / NJ, j = i % NJ; const int dil = (br == 0) ? 1 : (br == 1 ? 4 : 16);
        const int s = tpos - dil * j; const h16* vr = base + (size_t)s * NIN + vcol + lane * DPL;
        UNR for (int e = 0; e < DPL; ++e) o[e] += pv * (float)vr[e];
    }
    const float inv = 1.f / sum;
    UNR for (int e = 0; e < DPL; ++e) mixed[(size_t)tok * D + ocol + lane * DPL + e] = (h16)(o[e] * inv);
}

__global__ __launch_bounds__(256) void k_route(const h16* __restrict__ h1, const float* __restrict__ Wr, const float* __restrict__ b_grp, const float* __restrict__ b_exp,
                                               float* __restrict__ r2, int* __restrict__ cnt, int* __restrict__ ltok, float* __restrict__ lw) {
    const int wid = threadIdx.x >> 6, lane = threadIdx.x & 63; const int tok = blockIdx.x * 4 + wid;
    float v[32];
    float ss = 0.f;
    UNR for (int j = 0; j < 4; ++j) { const half8 hv = *(const half8*)(h1 + (size_t)tok * D + j * 512 + lane * 8);
#pragma unroll
        for (int e = 0; e < 8; ++e) { v[j * 8 + e] = (float)hv[e]; ss += v[j * 8 + e] * v[j * 8 + e]; } }
    ss = wave_sum(ss); const float rs = 1.0f / sqrtf(ss * (1.0f / D) + EPS);
    __shared__ float slg[4][40];
    float* lg = slg[wid];
    for (int c = 0; c < 36; ++c) { float a = 0.f;
        UNR for (int j = 0; j < 4; ++j) { const float* w = Wr + (size_t)c * D + j * 512 + lane * 8;
#pragma unroll
            for (int e = 0; e < 8; ++e) a += v[j * 8 + e] * w[e]; }
        a = wave_sum(a); if (lane == 0) lg[c] = a * rs + (c < 4 ? b_grp[c] : b_exp[c - 4]); }
    __builtin_amdgcn_s_waitcnt(0);
    if (lane == 0) {
        r2[tok] = rs;
        int gi = 0; float gm = lg[0]; for (int g = 1; g < 4; ++g) if (lg[g] > gm) { gm = lg[g]; gi = g; }
        float gs = 0.f; for (int g = 0; g < 4; ++g) gs += __expf(lg[g] - gm);
        const float gw = 1.f / gs;
        int i0 = 0; float v0 = lg[4 + gi * 8]; for (int e = 1; e < 8; ++e) if (lg[4 + gi * 8 + e] > v0) { v0 = lg[4 + gi * 8 + e]; i0 = e; }
        int i1 = -1; float v1 = -INFINITY; for (int e = 0; e < 8; ++e) if (e != i0 && lg[4 + gi * 8 + e] > v1) { v1 = lg[4 + gi * 8 + e]; i1 = e; }
        const float e1 = __expf(v1 - v0); const float w0 = gw / (1.f + e1), w1 = gw * e1 / (1.f + e1);
        const int ea = gi * 8 + i0, eb = gi * 8 + i1;
        const int pa = atomicAdd(cnt + ea, 1); ltok[(size_t)ea * T + pa] = tok; lw[(size_t)ea * T + pa] = w0;
        const int pb = atomicAdd(cnt + eb, 1); ltok[(size_t)eb * T + pb] = tok | (1 << 30); lw[(size_t)eb * T + pb] = w1;
    }
}
__global__ __launch_bounds__(256) void k_combine(const h16* __restrict__ h1, const h16* __restrict__ y, h16* __restrict__ h2, float* __restrict__ r3) {
    const int wid = threadIdx.x >> 6, lane = threadIdx.x & 63; const int tok = blockIdx.x * 4 + wid;
    float ss = 0.f;
    UNR for (int j = 0; j < 4; ++j) { const size_t o = (size_t)tok * D + j * 512 + lane * 8;
        const half8 a = *(const half8*)(h1 + o), b = *(const half8*)(y + o), c = *(const half8*)(y + (size_t)T * D + o); half8 r;
#pragma unroll
        for (int e = 0; e < 8; ++e) { const float s = (float)a[e] + (float)b[e] + (float)c[e]; ss += s * s; r[e] = (h16)s; }
        *(half8*)(h2 + o) = r; }
    ss = wave_sum(ss); if (lane == 0) r3[tok] = 1.0f / sqrtf(ss * (1.0f / D) + EPS);
}
__global__ __launch_bounds__(256) void k_final(float* __restrict__ out, const float* __restrict__ ssq, const float* __restrict__ g) {
    const int wid = threadIdx.x >> 6, lane = threadIdx.x & 63; const int tok = blockIdx.x * 4 + wid;
    const float rs = 1.0f / sqrtf(ssq[tok] * (1.0f / D) + EPS);
    for (int j = 0; j < 8; ++j) { const size_t o = (size_t)tok * D + j * 256 + lane * 4; f32x4 v = *(f32x4*)(out + o); const f32x4 gg = *(const f32x4*)(g + j * 256 + lane * 4);
        v.x *= rs * gg.x; v.y *= rs * gg.y; v.z *= rs * gg.z; v.w *= rs * gg.w; *(f32x4*)(out + o) = v; }
}

}
struct Bufs {
    const float *x, *p, *w_in, *w_out, *sinks, *g_mix, *g_moe, *g_ple, *g_final, *w_grp, *b_grp, *w_exp, *b_exp, *w_gate, *w_up, *w_down, *w_ple, *w_pg;
    float* out; unsigned char* ws;
    float *r1, *r2, *r3, *ssq, *lw, *Wr; int *cnt, *ltok; h16* Wr16;
    h16 *WinT, *WoutT, *WguT, *WdT, *WpleT, *WpgT, *p16, *pw16, *x16, *mixed, *hid, *h2, *proj, *y, *h1;
};
static Bufs make_bufs(void* const* d_in, void* d_out, void* d_ws) {
    Bufs b{};
    const float** f = (const float**)d_in;
    b.x = f[0]; b.p = f[1]; b.w_in = f[2]; b.w_out = f[3]; b.sinks = f[4]; b.g_mix = f[5]; b.g_moe = f[6]; b.g_ple = f[7]; b.g_final = f[8];
    b.w_grp = f[9]; b.b_grp = f[10]; b.w_exp = f[11]; b.b_exp = f[12]; b.w_gate = f[13]; b.w_up = f[14]; b.w_down = f[15]; b.w_ple = f[16]; b.w_pg = f[17];
    b.out = (float*)d_out; b.ws = (unsigned char*)d_ws; unsigned char* w = b.ws;
    b.cnt = (int*)(w + WS_CTL + CTL_CNT); b.ssq = (float*)(w + WS_CTL + CTL_SSQ);
    b.r1 = (float*)(w + WS_R1); b.r2 = (float*)(w + WS_R2); b.r3 = (float*)(w + WS_R3);
    b.ltok = (int*)(w + WS_LTOK); b.lw = (float*)(w + WS_LW); b.Wr = (float*)(w + WS_WR); b.Wr16 = (h16*)(w + WS_WR16);
    b.WinT = (h16*)(w + WS_WIN); b.WoutT = (h16*)(w + WS_WOUT); b.WguT = (h16*)(w + WS_WGU); b.WdT = (h16*)(w + WS_WD); b.WpleT = (h16*)(w + WS_WPLE); b.WpgT = (h16*)(w + WS_WPG);
    b.p16 = (h16*)(w + WS_P16); b.pw16 = (h16*)(w + WS_PW16);
    b.x16 = (h16*)(w + WS_RA); b.mixed = b.x16; b.hid = b.x16; b.h2 = b.x16;
    b.proj = (h16*)(w + WS_RB); b.y = b.proj; b.h1 = (h16*)(w + WS_RD);
    return b;
}
static void naive_prep(const Bufs& b, hipStream_t s) {
    nv::k_prep_x<<<T / 4, 256, 0, s>>>(b.x, b.x16, b.r1, b.p, b.p16);
    { nv::TrJob j{b.w_in, nullptr, b.WinT, b.g_mix, NIN, D, NIN, 1, 0, 0}; nv::k_transpose<<<dim3(NIN / 64, D / 64, 1), 256, 0, s>>>(j); }
    { nv::TrJob j{b.w_out, nullptr, b.WoutT, nullptr, D, D, D, 0, 0, 0}; nv::k_transpose<<<dim3(D / 64, D / 64, 1), 256, 0, s>>>(j); }
    { nv::TrJob j{b.w_gate, b.w_up, b.WguT, b.g_moe, DE, D, 256, 2, (long)D * DE, (long)256 * D}; nv::k_transpose<<<dim3(256 / 64, D / 64, NE * 2), 256, 0, s>>>(j); }
    { nv::TrJob j{b.w_down, nullptr, b.WdT, nullptr, D, DE, D, 0, (long)DE * D, (long)D * DE}; nv::k_transpose<<<dim3(D / 64, DE / 64, NE), 256, 0, s>>>(j); }
    { nv::TrJob j{b.w_ple, nullptr, b.WpleT, nullptr, D, PLE, D, 0, 0, 0}; nv::k_transpose<<<dim3(D / 64, PLE / 64, 1), 256, 0, s>>>(j); }
    { nv::TrJob j{b.w_pg, nullptr, b.WpgT, b.g_ple, D, D, D, 0, 0, 0}; nv::k_transpose<<<dim3(D / 64, D / 64, 1), 256, 0, s>>>(j); }
    nv::k_router_w<<<(36 * D + 255) / 256, 256, 0, s>>>(b.w_grp, b.w_exp, b.g_moe, b.Wr);
}
static void naive_gemm1(const Bufs& b, hipStream_t s) { nv::OpG1 o; o.K = D; o.A = b.x16; o.Bt = b.WinT; o.r1 = b.r1; o.out = b.proj; nv::k_gemm<<<dim3(NIN / 128, T / 128, 1), 256, 0, s>>>(o); }
static void naive_pw(const Bufs& b, hipStream_t s) { nv::OpPW o; o.K = PLE; o.A = b.p16; o.Bt = b.WpleT; o.out = b.pw16; nv::k_gemm<<<dim3(D / 128, T / 128, 1), 256, 0, s>>>(o); }
static void naive_attn(const Bufs& b, hipStream_t s) {
    nv::k_attn<128, 3, 129><<<T * AH / 4, 256, 0, s>>>(b.proj, b.mixed, b.sinks);
    nv::k_attn<64, 1, 128><<<T * BH / 4, 256, 0, s>>>(b.proj, b.mixed, b.sinks);
}
static void naive_gemm3(const Bufs& b, hipStream_t s) { nv::OpG3 o; o.K = D; o.A = b.mixed; o.Bt = b.WoutT; o.x = b.x; o.out = b.h1; nv::k_gemm<<<dim3(D / 128, T / 128, 1), 256, 0, s>>>(o); }
static void naive_route(const Bufs& b, hipStream_t s) { nv::k_route<<<T / 4, 256, 0, s>>>(b.h1, b.Wr, b.b_grp, b.b_exp, b.r2, b.cnt, b.ltok, b.lw); }
static void naive_moe_up(const Bufs& b, hipStream_t s) { nv::OpMU o; o.K = D; o.A = b.h1; o.Wgu = b.WguT; o.cnt = b.cnt; o.ltok = b.ltok; o.lw = b.lw; o.r2 = b.r2; o.hid = b.hid;
    nv::k_gemm<<<dim3(512 / 128, T / 128, NE), 256, 0, s>>>(o); }
static void naive_moe_down(const Bufs& b, hipStream_t s) { nv::OpMD o; o.K = DE; o.hid = b.hid; o.Wd = b.WdT; o.cnt = b.cnt; o.ltok = b.ltok; o.y = b.y;
    nv::k_gemm<<<dim3(D / 128, T / 128, NE), 256, 0, s>>>(o); }
static void naive_combine(const Bufs& b, hipStream_t s) { nv::k_combine<<<T / 4, 256, 0, s>>>(b.h1, b.y, b.h2, b.r3); }
static void naive_gemm5(const Bufs& b, hipStream_t s) { nv::OpG5 o; o.K = D; o.A = b.h2; o.Bt = b.WpgT; o.r3 = b.r3; o.pw = b.pw16; o.out = b.out; o.ssq = b.ssq;
    nv::k_gemm<<<dim3(D / 128, T / 128, 1), 256, 0, s>>>(o); }
static void naive_final(const Bufs& b, hipStream_t s) { nv::k_final<<<T / 4, 256, 0, s>>>(b.out, b.ssq, b.g_final); }
namespace g8 {
#define G8_LAS __attribute__((address_space(3)))
constexpr int BM = 256, BK = 64, HALF = 128, HTB = HALF * BK * 2  , STAGE_BYTES = 8 * HTB, NXCD = 8, WGM = 8;

__host__ __device__ __forceinline__ int lds_byte(int r, int c) { const int st = (r >> 4) * 2 + (c >> 5), rr = r & 15, cc = c & 31, ob = rr * 64 + cc * 2; return st * 1024 + (ob ^ (((ob >> 9) & 1) << 5)); }
__host__ __device__ __forceinline__ void stage_rc(int b, int& R, int& C) { const int st = b / 1024, sb = b % 1024, swz = sb ^ (((sb >> 9) & 1) << 5); R = (st >> 1) * 16 + swz / 64; C = (st & 1) * 32 + (swz % 64) / 2; }
__host__ __device__ __forceinline__ int perm32(int rho) { const int n = rho >> 4, i = rho & 15; return 8 * (i >> 2) + 4 * n + (i & 3); }

struct Unit { int pm, pn, a0, a1, a2, a3; };
struct Gemm { const h16* A; const h16* Bt; int K; };

struct StaticOrder {
    int nM, nN, nwg, G, c;
    __device__ void init(int M, int N, int G_, int c_) { nM = M / BM; nN = N / BM; nwg = nM * nN; G = G_; c = c_; }
    __device__ bool next(int i, Unit& u) const {
        const long L = (long)i * G + c; if (L >= nwg) return false;
        int wgid = (int)L; { const int q = nwg / NXCD, r = nwg % NXCD, xcd = wgid % NXCD, off = wgid / NXCD; wgid = (xcd < r ? xcd * (q + 1) : r * (q + 1) + (xcd - r) * q) + off; }
        const int nig = WGM * nN, gid = wgid / nig, fm = gid * WGM, gsz = (nM - fm) < WGM ? (nM - fm) : WGM;
        u.pm = fm + ((wgid % nig) % gsz); u.pn = (wgid % nig) / gsz; u.a0 = u.a1 = u.a2 = u.a3 = 0; return true;
    }
    __device__ __forceinline__ unsigned arow(const Unit& u, int r) const { return (unsigned)(u.pm * BM + r); }
};

__device__ __forceinline__ unsigned pk_h2(float lo, float hi) { f32x2 v = {lo, hi}; return __builtin_bit_cast(unsigned, __builtin_convertvector(v, h16x2)); }

template <class Epi, class Sched, bool ALIGN_EPI = true>
__device__ __forceinline__ void gemm_phase(G8_LAS unsigned char* lds, const Gemm g, const Sched& S, const Epi& E) {
    const int tid = threadIdx.x, wid = __builtin_amdgcn_readfirstlane(tid >> 6), lane = tid & 63, wr = wid >> 2, wc = wid & 3, fr = lane & 15, fq = lane >> 4;
    const int K = g.K, nt = K / BK;
    unsigned voffB[2];
#pragma unroll
    for (int i = 0; i < 2; ++i) { int R, C; stage_rc(tid * 16 + i * 8192, R, C); const int Rb = Epi::PERM ? ((R & ~31) + perm32(R & 31)) : R; voffB[i] = (unsigned)(Rb * K + C) * 2u; }
    const unsigned pitch = (unsigned)K * 2u;
    const size_t kstep = (size_t)(BK * 2);
    const size_t hstep = (size_t)HALF * K * 2;
    const size_t tstep = 2 * hstep;
    const unsigned ldsw = (unsigned)wid * 1024u;
    const int aoff = lds_byte(wr * 64 + fr, fq * 8), boff = lds_byte(wc * 32 + fr, fq * 8);
#define G8_SA(b, h) (((b) * 2 + (h)) * HTB)
#define G8_SB(b, h) ((4 + (b) * 2 + (h)) * HTB)
#define G8_STAGE(bufoff, gbase, voff) do { _Pragma("unroll") for (int _i = 0; _i < 2; ++_i) \
        __builtin_amdgcn_global_load_lds((const unsigned*)((const char*)(gbase) + (voff)[_i]), (G8_LAS unsigned*)(lds + (bufoff) + ldsw + _i * 8192), 16, 0, 0); } while (0)
#define G8_LDA(dst, b, h) do { _Pragma("unroll") for (int m = 0; m < 4; ++m) _Pragma("unroll") for (int k = 0; k < 2; ++k) dst[m][k] = *(const G8_LAS half8*)(lds + G8_SA(b, h) + aoff + m * 2048 + k * 1024); } while (0)
#define G8_LDB(dst, b, h) do { _Pragma("unroll") for (int n = 0; n < 2; ++n) _Pragma("unroll") for (int k = 0; k < 2; ++k) dst[n][k] = *(const G8_LAS half8*)(lds + G8_SB(b, h) + boff + n * 2048 + k * 1024); } while (0)
#define G8_MMA(ai, bj, At, Bt) do { __builtin_amdgcn_s_setprio(1); _Pragma("unroll") for (int m = 0; m < 4; ++m) _Pragma("unroll") for (int n = 0; n < 2; ++n) _Pragma("unroll") for (int k = 0; k < 2; ++k) \
        acc[ai][bj][m][n] = __builtin_amdgcn_mfma_f32_16x16x32_f16(Bt[n][k], At[m][k], acc[ai][bj][m][n], 0, 0, 0); __builtin_amdgcn_s_setprio(0); } while (0)
#define G8_WAIT_V(n) asm volatile("s_waitcnt vmcnt(" #n ")" ::: "memory")
#define G8_WAIT_L(n) asm volatile("s_waitcnt lgkmcnt(" #n ")" ::: "memory")
#define G8_BAR __builtin_amdgcn_s_barrier()
#define G8_SCHED __builtin_amdgcn_sched_barrier(0)
#define G8_SETVO(dst, u) do { int _t = tid; asm volatile("" : "+v"(_t)); _Pragma("unroll") for (int _i = 0; _i < 2; ++_i) { int _R, _C; stage_rc(_t * 16 + _i * 8192, _R, _C); \
        _Pragma("unroll") for (int _h = 0; _h < 2; ++_h) dst[_h][_i] = S.arow(u, _h * HALF + _R) * pitch + (unsigned)_C * 2u; } } while (0)
    Unit cur, nxt; int ui = 0;
    if (!S.next(0, cur)) return;
    f32x4 acc[2][2][4][2];
#pragma unroll
    for (int a = 0; a < 2; ++a)
#pragma unroll
        for (int b = 0; b < 2; ++b)
#pragma unroll
            for (int m = 0; m < 4; ++m)
#pragma unroll
                for (int n = 0; n < 2; ++n) acc[a][b][m][n] = (f32x4){0.f, 0.f, 0.f, 0.f};
    half8 At[4][2], B0[2][2], B1[2][2];
    unsigned cv[2][2], nv[2][2];
    G8_SETVO(cv, cur);
    const char* const gA = (const char*)g.A;
    const char* cB = (const char*)g.Bt + (size_t)cur.pn * tstep;
    G8_STAGE(G8_SB(0, 0), cB, voffB); G8_STAGE(G8_SB(0, 1), cB + hstep, voffB); G8_STAGE(G8_SA(0, 0), gA, cv[0]); G8_STAGE(G8_SA(0, 1), gA, cv[1]);
    if (wr == 1) G8_BAR;
    G8_WAIT_V(2); G8_BAR;
    G8_STAGE(G8_SB(1, 0), cB + kstep, voffB); G8_STAGE(G8_SA(1, 0), gA + kstep, cv[0]); G8_STAGE(G8_SB(1, 1), cB + hstep + kstep, voffB);
    G8_WAIT_V(6); G8_BAR;
    for (;;) {
        const bool has_next = S.next(ui + 1, nxt);
        if (has_next) { G8_SETVO(nv, nxt); } else {
#pragma unroll
            for (int _h = 0; _h < 2; ++_h)
#pragma unroll
                for (int _i = 0; _i < 2; ++_i) nv[_h][_i] = cv[_h][_i]; }
        const char* nB = has_next ? (const char*)g.Bt + (size_t)nxt.pn * tstep : cB;
#pragma nounroll
        for (int t = 0; t < nt; t += 2) {
            const bool last = (t == nt - 2);
            const char* a1 = gA + (size_t)(t + 1) * kstep;
            const char* a2 = last ? gA : gA + (size_t)(t + 2) * kstep; const char* b2 = last ? nB : cB + (size_t)(t + 2) * kstep;
            const char* a3 = a2 + kstep; const char* b3 = b2 + kstep;
            unsigned v20[2], v21[2];
#pragma unroll
            for (int _i = 0; _i < 2; ++_i) { v20[_i] = last ? nv[0][_i] : cv[0][_i]; v21[_i] = last ? nv[1][_i] : cv[1][_i]; }
            G8_LDB(B0, 0, 0); G8_LDB(B1, 0, 1); G8_SCHED; G8_LDA(At, 0, 0); G8_STAGE(G8_SA(1, 1), a1, cv[1]);
            G8_WAIT_V(8); G8_WAIT_L(0); G8_BAR; G8_MMA(0, 0, At, B0); G8_MMA(0, 1, At, B1); G8_BAR; G8_SCHED;
            G8_LDA(At, 0, 1); G8_STAGE(G8_SB(0, 0), b2, voffB); G8_STAGE(G8_SB(0, 1), b2 + hstep, voffB); G8_STAGE(G8_SA(0, 0), a2, v20);
            G8_WAIT_V(8); G8_WAIT_L(0); G8_BAR; G8_MMA(1, 0, At, B0); G8_MMA(1, 1, At, B1); G8_BAR; G8_SCHED;
            G8_LDB(B0, 1, 0); G8_LDB(B1, 1, 1); G8_SCHED; G8_LDA(At, 1, 0); G8_STAGE(G8_SA(0, 1), a2, v21);
            G8_WAIT_V(8); G8_WAIT_L(0); G8_BAR; G8_MMA(0, 0, At, B0); G8_MMA(0, 1, At, B1); G8_BAR; G8_SCHED;
            G8_LDA(At, 1, 1); G8_STAGE(G8_SB(1, 0), b3, voffB); G8_STAGE(G8_SB(1, 1), b3 + hstep, voffB); G8_STAGE(G8_SA(1, 0), a3, v20);
            G8_WAIT_V(8); G8_WAIT_L(0); G8_BAR; G8_MMA(1, 0, At, B0); G8_MMA(1, 1, At, B1); G8_BAR; G8_SCHED;
        }
        if constexpr (ALIGN_EPI) { if (wr == 0) G8_BAR; }
        E(acc, cur, wr, wc, fr, fq);
        if (!has_next) break;
#pragma unroll
        for (int a = 0; a < 2; ++a)
#pragma unroll
            for (int b = 0; b < 2; ++b)
#pragma unroll
                for (int m = 0; m < 4; ++m)
#pragma unroll
                    for (int n = 0; n < 2; ++n) acc[a][b][m][n] = (f32x4){0.f, 0.f, 0.f, 0.f};
        cur = nxt; cB = nB; ++ui;
#pragma unroll
        for (int _h = 0; _h < 2; ++_h)
#pragma unroll
            for (int _i = 0; _i < 2; ++_i) cv[_h][_i] = nv[_h][_i];
        if constexpr (ALIGN_EPI) { if (wr == 1) G8_BAR; }
    }
    G8_WAIT_V(0);
    if constexpr (!ALIGN_EPI) { if (wr == 0) G8_BAR; }
    G8_BAR;
#undef G8_SA
#undef G8_SB
#undef G8_STAGE
#undef G8_LDA
#undef G8_LDB
#undef G8_MMA
#undef G8_WAIT_V
#undef G8_WAIT_L
#undef G8_BAR
#undef G8_SCHED
#undef G8_SETVO
}
}
namespace g8 {
#define EPI_ROWS UNR for (int ai = 0; ai < 2; ++ai) UNR for (int m = 0; m < 4; ++m)
#define EPI_FENCE asm volatile("" ::: "memory")
#define RFL(x) __builtin_amdgcn_readfirstlane(x)

struct EpiProj {
    static constexpr bool PERM = true;
    h16* out; const float* r1;
    __device__ __forceinline__ void operator()(const f32x4 (&acc)[2][2][4][2], const Unit& u, int wr, int wc, int fr, int fq) const {
        const int row0 = u.pm * BM + wr * 64 + fr, col0 = u.pn * BM + wc * 32 + 8 * fq;
        EPI_ROWS { const int row = row0 + ai * HALF + m * 16; const float s = r1[row]; h16* rp = out + (size_t)row * NIN + col0;
            UNR for (int bj = 0; bj < 2; ++bj) { const f32x4 v0 = acc[ai][bj][m][0] * s, v1 = acc[ai][bj][m][1] * s;
                u32x4 w; w.x = pk_h2(v0[0], v0[1]); w.y = pk_h2(v0[2], v0[3]); w.z = pk_h2(v1[0], v1[1]); w.w = pk_h2(v1[2], v1[3]); *(u32x4*)(rp + bj * HALF) = w; } EPI_FENCE; }
    }
};
struct EpiPlain {
    static constexpr bool PERM = true;
    h16* out; int ldc;
    __device__ __forceinline__ void operator()(const f32x4 (&acc)[2][2][4][2], const Unit& u, int wr, int wc, int fr, int fq) const {
        const int row0 = u.pm * BM + wr * 64 + fr, col0 = u.pn * BM + wc * 32 + 8 * fq;
        EPI_ROWS { const int row = row0 + ai * HALF + m * 16; h16* rp = out + (size_t)row * ldc + col0;
            UNR for (int bj = 0; bj < 2; ++bj) { const f32x4 v0 = acc[ai][bj][m][0], v1 = acc[ai][bj][m][1];
                u32x4 w; w.x = pk_h2(v0[0], v0[1]); w.y = pk_h2(v0[2], v0[3]); w.z = pk_h2(v1[0], v1[1]); w.w = pk_h2(v1[2], v1[3]); *(u32x4*)(rp + bj * HALF) = w; } EPI_FENCE; }
    }
};
struct EpiRes {
    static constexpr bool PERM = true;
    h16* out; const float* x;
    __device__ __forceinline__ void operator()(const f32x4 (&acc)[2][2][4][2], const Unit& u, int wr, int wc, int fr, int fq) const {
        const int row0 = u.pm * BM + wr * 64 + fr, col0 = u.pn * BM + wc * 32 + 8 * fq;
        EPI_ROWS { const int row = row0 + ai * HALF + m * 16; const size_t o = (size_t)row * D + col0;
            UNR for (int bj = 0; bj < 2; ++bj) { const f32x4 x0 = *(const f32x4*)(x + o + bj * HALF), x1 = *(const f32x4*)(x + o + bj * HALF + 4);
                const f32x4 v0 = acc[ai][bj][m][0] + x0, v1 = acc[ai][bj][m][1] + x1;
                u32x4 w; w.x = pk_h2(v0[0], v0[1]); w.y = pk_h2(v0[2], v0[3]); w.z = pk_h2(v1[0], v1[1]); w.w = pk_h2(v1[2], v1[3]); *(u32x4*)(out + o + bj * HALF) = w; } EPI_FENCE; }
    }
};
struct EpiMoeUp {
    static constexpr bool PERM = true;
    h16* hid; const int* ltok; const float* lw; const float* r2;
    __device__ __forceinline__ void operator()(const f32x4 (&acc)[2][2][4][2], const Unit& u, int wr, int wc, int fr, int fq) const {
        const int e = u.a0, hc0 = (u.pn & 1) * 128 + wc * 32 + 8 * fq;
        EPI_ROWS { const int rr = ai * HALF + wr * 64 + m * 16 + fr; if (rr < u.a1) {
            const size_t li = (size_t)e * T + u.a3 + rr; const int tok = ltok[li] & 0x3fff; const float s = r2[tok], w = lw[li];
            float hv[8];
            UNR for (int n = 0; n < 2; ++n) UNR for (int j = 0; j < 4; ++j) { const float gt = acc[ai][0][m][n][j] * s, up = acc[ai][1][m][n][j] * s;
                hv[n * 4 + j] = gt / (1.f + __expf(-gt)) * up * w; }
            u32x4 o; o.x = pk_h2(hv[0], hv[1]); o.y = pk_h2(hv[2], hv[3]); o.z = pk_h2(hv[4], hv[5]); o.w = pk_h2(hv[6], hv[7]);
            *(u32x4*)(hid + (size_t)(u.a2 + rr) * DE + hc0) = o; } EPI_FENCE; }
    }
};
struct EpiMoeDown {
    static constexpr bool PERM = true;
    h16* y; const int* ltok;
    __device__ __forceinline__ void operator()(const f32x4 (&acc)[2][2][4][2], const Unit& u, int wr, int wc, int fr, int fq) const {
        const int e = u.a0, col0 = u.a2 * BM + wc * 32 + 8 * fq;
        EPI_ROWS { const int rr = ai * HALF + wr * 64 + m * 16 + fr; if (rr < u.a1) {
            const int lt = ltok[(size_t)e * T + u.a3 + rr]; const int tok = lt & 0x3fff, slot = (lt >> 30) & 1; h16* rp = y + ((size_t)slot * T + tok) * D + col0;
            UNR for (int bj = 0; bj < 2; ++bj) { const f32x4 v0 = acc[ai][bj][m][0], v1 = acc[ai][bj][m][1];
                u32x4 w; w.x = pk_h2(v0[0], v0[1]); w.y = pk_h2(v0[2], v0[3]); w.z = pk_h2(v1[0], v1[1]); w.w = pk_h2(v1[2], v1[3]); *(u32x4*)(rp + bj * HALF) = w; } } EPI_FENCE; }
    }
};
struct EpiPle {
    static constexpr bool PERM = true;
    float* out; const h16* h2; const h16* pw; const float* r3; float* ssq;
    __device__ __forceinline__ void operator()(const f32x4 (&acc)[2][2][4][2], const Unit& u, int wr, int wc, int fr, int fq) const {
        const int row0 = u.pm * BM + wr * 64 + fr, col0 = u.pn * BM + wc * 32 + 8 * fq;
        EPI_ROWS { const int row = row0 + ai * HALF + m * 16; const float s = r3[row]; const size_t o = (size_t)row * D + col0; float q = 0.f;
            UNR for (int bj = 0; bj < 2; ++bj) { const half8 hh = *(const half8*)(h2 + o + bj * HALF), pp = *(const half8*)(pw + o + bj * HALF); f32x4 r0, r1v;
                UNR for (int j = 0; j < 4; ++j) { const float g0 = 1.f / (1.f + __expf(-acc[ai][bj][m][0][j] * s)), g1 = 1.f / (1.f + __expf(-acc[ai][bj][m][1][j] * s));
                    r0[j] = (float)hh[j] + g0 * (float)pp[j]; r1v[j] = (float)hh[4 + j] + g1 * (float)pp[4 + j]; q += r0[j] * r0[j] + r1v[j] * r1v[j]; }
                *(f32x4*)(out + o + bj * HALF) = r0; *(f32x4*)(out + o + bj * HALF + 4) = r1v; }
            q += __shfl_xor(q, 16); q += __shfl_xor(q, 32);
            if (fq == 0) atomicAdd(ssq + row, q); EPI_FENCE; }
    }
};

__device__ __forceinline__ void moe_table(volatile G8_LAS int* tab, const int* cnt) {
    if (threadIdx.x == 0) { int o = 0; for (int e = 0; e < NE; ++e) { tab[e] = o; tab[64 + e] = cnt[e]; o += (cnt[e] + 255) >> 8; } tab[32] = o; }
}
struct MoeUpOrder {
    const volatile G8_LAS int* tab; const int* ltok; int G, v;
    __device__ bool next(int i, Unit& u) const {
        const int L = i * G + v; const int total = RFL(tab[32]); if (L >= 2 * total) return false;
        int e = 0; UNR for (int k = 1; k < NE; ++k) e = (L >= 2 * tab[k]) ? k : e;
        const int base = tab[e], nte = tab[e + 1] - base, l = L - 2 * base, pn = l / nte, rt = l - pn * nte;
        u.pm = RFL(rt); u.pn = RFL(e * 2 + pn); u.a0 = RFL(e); u.a1 = RFL(tab[64 + e] - rt * 256); u.a2 = RFL((base + rt) * 256); u.a3 = RFL(rt * 256); return true;
    }
    __device__ __forceinline__ unsigned arow(const Unit& u, int r) const { return (r < u.a1) ? (unsigned)(ltok[(size_t)u.a0 * T + u.a3 + r] & 0x3fff) : 0u; }
};
struct MoeDownOrder {
    const volatile G8_LAS int* tab; int G, v;
    __device__ bool next(int i, Unit& u) const {
        const int L = i * G + v; const int total = RFL(tab[32]); if (L >= 8 * total) return false;
        const int gt = L >> 3, pn = L & 7;
        int e = 0; UNR for (int k = 1; k < NE; ++k) e = (gt >= tab[k]) ? k : e;
        const int rt = gt - tab[e];
        u.pm = RFL(gt); u.pn = RFL(e * 8 + pn); u.a0 = RFL(e); u.a1 = RFL(tab[64 + e] - rt * 256); u.a2 = RFL(pn); u.a3 = RFL(rt * 256); return true;
    }
    __device__ __forceinline__ unsigned arow(const Unit& u, int r) const { return (unsigned)(u.pm * BM + r); }
};
}
constexpr int NWAVES = 8;
constexpr int RING_OFF = 0, RING_BYTES = 131072;
constexpr int LDSCTL_OFF = RING_BYTES, MISC_OFF = LDSCTL_OFF, TAB_OFF = LDSCTL_OFF + 512;
constexpr int LDS_BYTES = 147456;
constexpr int CW_TMO = 0, CW_CODE = 1, CW_BAR = 4096;

#define GAS __attribute__((address_space(1)))
#define LAS __attribute__((address_space(3)))
typedef GAS unsigned gu32;
#define RLX_AGENT __ATOMIC_RELAXED, __HIP_MEMORY_SCOPE_AGENT
#define LDS_WAIT() asm volatile("s_waitcnt lgkmcnt(0)" ::: "memory")
#define VM_WAIT() asm volatile("s_waitcnt vmcnt(0)" ::: "memory")

#define XB_TMO      128
#define XB_XCNT(j)  (256  + 64 * (j))
#define XB_XSUB(j)  (1280 + 64 * (j))
#define XB_XGEN(j)  (2304 + 64 * (j))
#define XB_TOP      3328
#define XB_TOPGEN   3392
#define XCD_BAR_WORDS 3456
#define XB_SPIN_CAP (1u << 18)
__device__ __forceinline__ unsigned xb_ld(unsigned* p)              { return __hip_atomic_load(p, __ATOMIC_RELAXED, __HIP_MEMORY_SCOPE_AGENT); }
__device__ __forceinline__ unsigned xb_add(unsigned* p, unsigned v) { return __hip_atomic_fetch_add(p, v, __ATOMIC_RELAXED, __HIP_MEMORY_SCOPE_AGENT); }
__device__ __forceinline__ unsigned xb_xcc_id() { return (unsigned)__builtin_amdgcn_s_getreg((3 << 11) | 20) & 0xFu; }
#define XB_SPIN(cond, bar) do { unsigned _sp = 0; while (cond) { __builtin_amdgcn_s_sleep(1); \
    if ((++_sp & 255u) == 0u) { if (xb_ld(&(bar)[XB_TMO])) break; if (_sp > XB_SPIN_CAP) { atomicAdd(&(bar)[XB_TMO], 1u); break; } } } } while (0)
struct XcdBarrier { unsigned* bar; unsigned x; volatile LAS unsigned* st; };
__device__ __forceinline__ XcdBarrier xcd_barrier_post(unsigned* bar, volatile LAS unsigned* st) {
    XcdBarrier b; b.bar = bar; b.x = xb_xcc_id(); b.st = st;
    if (threadIdx.x == 0) (void)xb_add(&bar[XB_XCNT(b.x)], 1u);
    return b;
}
__device__ __forceinline__ void xcd_barrier_complete(unsigned* bar, unsigned x, unsigned& nloc, unsigned& nx) {
    const unsigned G = gridDim.x * gridDim.y * gridDim.z;
    unsigned sum, cnt, mine, sp = 0u;
    for (;;) {
        sum = 0u; cnt = 0u; mine = 0u;
#pragma unroll
        for (unsigned j = 0; j < 16; ++j) { const unsigned c = xb_ld(&bar[XB_XCNT(j)]); sum += c; cnt += (c > 0u) ? 1u : 0u; mine = (j == x) ? c : mine; }
        if (sum == G) break;
        __builtin_amdgcn_s_sleep(1);
        if ((++sp & 255u) == 0u) { if (xb_ld(&bar[XB_TMO])) break; if (sp > XB_SPIN_CAP) { atomicAdd(&bar[XB_TMO], 1u); break; } }
    }
    nloc = mine > 0u ? mine : 1u; nx = cnt > 0u ? cnt : 1u;
}
__device__ __forceinline__ void xcd_barrier(const XcdBarrier& b) {
    asm volatile("s_waitcnt vmcnt(0)" ::: "memory");
    __syncthreads();
    if (threadIdx.x == 0) {
        unsigned* bar = b.bar;
        __builtin_amdgcn_s_waitcnt(0);
        unsigned nloc = b.st[0], nx = b.st[1];
        if (nloc == 0u) { xcd_barrier_complete(bar, b.x, nloc, nx); b.st[0] = nloc; b.st[1] = nx; }
        const unsigned old = xb_add(&bar[XB_XSUB(b.x)], 1u);
        const unsigned gen = old / nloc;
        if (old + 1u == (gen + 1u) * nloc) {
            __builtin_amdgcn_fence(__ATOMIC_RELEASE, "agent");
            asm volatile("s_waitcnt vmcnt(0)" ::: "memory");
            const unsigned og = xb_add(&bar[XB_TOP], 1u);
            const unsigned tg = og / nx;
            if (og + 1u == (tg + 1u) * nx) xb_add(&bar[XB_TOPGEN], 1u);
            else XB_SPIN(xb_ld(&bar[XB_TOPGEN]) == tg, bar);
            __builtin_amdgcn_fence(__ATOMIC_ACQUIRE, "agent");
            xb_add(&bar[XB_XGEN(b.x)], 1u);
            asm volatile("s_waitcnt vmcnt(0)" ::: "memory");
        } else {
            XB_SPIN(xb_ld(&bar[XB_XGEN(b.x)]) == gen, bar);
            __builtin_amdgcn_fence(__ATOMIC_ACQUIRE, "agent");
            asm volatile("s_waitcnt vmcnt(0)" ::: "memory");
        }
    }
    __syncthreads();
}

struct Args { Bufs b; int ph_lo, ph_hi, li, pad; };

struct Frame {
    LAS unsigned char* lds;
    int tid, lane, wave, vcu, G;
};
__device__ __forceinline__ float wave_sum(float v) {
#pragma unroll
    for (int o = 1; o < 64; o <<= 1) v += __shfl_xor(v, o);
    return v;
}
__device__ __forceinline__ float wave_max(float v) {
#pragma unroll
    for (int o = 1; o < 64; o <<= 1) v = fmaxf(v, __shfl_xor(v, o));
    return v;
}

__device__ __forceinline__ void p0_item(const float* W, int pitch, int K, h16* WT, int scol0, int drow0, int k0, const float* gain, float cs, LAS float* scr, int lane) {
#pragma unroll 8
    for (int i = 0; i < 32; ++i) { const int kk = 2 * i + (lane >> 5); float v = W[(size_t)(k0 + kk) * pitch + scol0 + (lane & 31)] * cs; if (gain) v *= gain[k0 + kk]; scr[kk * 33 + (lane & 31)] = v; }
    LDS_WAIT(); asm volatile("" ::: "memory");
    const int c = lane & 7;
#pragma unroll
    for (int j = 0; j < 4; ++j) { const int n = (lane >> 3) + 8 * j; const LAS float* s = scr + (8 * c) * 33 + n;
        u32x4 o; o.x = g8::pk_h2(s[0 * 33], s[1 * 33]); o.y = g8::pk_h2(s[2 * 33], s[3 * 33]); o.z = g8::pk_h2(s[4 * 33], s[5 * 33]); o.w = g8::pk_h2(s[6 * 33], s[7 * 33]);
        *(u32x4*)(WT + (size_t)(drow0 + n) * K + k0 + 8 * c) = o; }
    LDS_WAIT(); asm volatile("" ::: "memory");
}
__device__ __forceinline__ void phase_prologue(const Frame& F, const Bufs& b) {
    LAS float* scr = (LAS float*)(F.lds + RING_OFF + F.wave * 16384);
    const int gw = F.vcu * NWAVES + F.wave, NGW = F.G * NWAVES, lane = F.lane;
    constexpr int I0 = 32 * 136, I1 = 32 * 64, I2 = 64 * 256, I3 = 32 * 256, I4 = 4 * 64, I5 = 32 * 64, NITEMS = I0 + I1 + I2 + I3 + I4 + I5;
    for (int row = gw; row < T; row += NGW) {
        const float* xr = b.x + (size_t)row * D; float ss = 0.f;
#pragma unroll
        for (int j = 0; j < D / 256; ++j) { const f32x4 v = *(const f32x4*)(xr + j * 256 + lane * 4); ss += v.x * v.x + v.y * v.y + v.z * v.z + v.w * v.w;
            u32x2 o; o.x = g8::pk_h2(v.x, v.y); o.y = g8::pk_h2(v.z, v.w); *(u32x2*)(b.x16 + (size_t)row * D + j * 256 + lane * 4) = o; }
        ss = wave_sum(ss); if (lane == 0) b.r1[row] = 1.0f / sqrtf(ss * (1.0f / D) + EPS);
        { const f32x4 v = *(const f32x4*)(b.p + (size_t)row * PLE + lane * 4); u32x2 o; o.x = g8::pk_h2(v.x, v.y); o.y = g8::pk_h2(v.z, v.w); *(u32x2*)(b.p16 + (size_t)row * PLE + lane * 4) = o; }
    }
    for (int it = gw; it < NITEMS; it += NGW) {
        int r = it;
        if (r < I0) { const int kb = r / 136, nb = r % 136, n0 = 32 * nb; const float cs = (n0 < 1024) ? QSCALE_A : ((n0 >= 3072 && n0 < 4096) ? QSCALE_B : 1.f);
            p0_item(b.w_in, NIN, D, b.WinT, n0, n0, 64 * kb, b.g_mix, cs, scr, lane); continue; } r -= I0;
        if (r < I1) { const int kb = r / 64, nb = r % 64; p0_item(b.w_out, D, D, b.WoutT, 32 * nb, 32 * nb, 64 * kb, nullptr, 1.f, scr, lane); continue; } r -= I1;
        if (r < I2) { const int z = r / 256, q = r % 256, kb = q / 8, nb = q % 8, n0 = 32 * nb, e = z >> 1, pn = z & 1;
            const float* src = ((n0 < 128) ? b.w_gate : b.w_up) + (size_t)e * D * DE;
            p0_item(src, DE, D, b.WguT + (size_t)z * 256 * D, 128 * pn + (n0 & 127), n0, 64 * kb, b.g_moe, 1.f, scr, lane); continue; } r -= I2;
        if (r < I3) { const int e = r / 256, q = r % 256, kb = q / 64, nb = q % 64;
            p0_item(b.w_down + (size_t)e * DE * D, D, DE, b.WdT + (size_t)e * D * DE, 32 * nb, 32 * nb, 64 * kb, nullptr, 1.f, scr, lane); continue; } r -= I3;
        if (r < I4) { const int kb = r / 64, nb = r % 64; p0_item(b.w_ple, D, PLE, b.WpleT, 32 * nb, 32 * nb, 64 * kb, nullptr, 1.f, scr, lane); continue; } r -= I4;
        { const int kb = r / 64, nb = r % 64; p0_item(b.w_pg, D, D, b.WpgT, 32 * nb, 32 * nb, 64 * kb, b.g_ple, 1.f, scr, lane); }
    }
    for (int idx = (F.vcu * NWAVES * 64) + F.tid; idx < 80 * D; idx += F.G * NWAVES * 64) {
        const int c = idx / D, k = idx % D; h16 o = (h16)0.f;
        if (c < 72) { const int cc = (c < 36) ? c : c - 36; const float v = ((cc < 4) ? b.w_grp[(size_t)k * 4 + cc] : b.w_exp[(size_t)k * 32 + (cc - 4)]) * b.g_moe[k];
            const h16 hi = (h16)v; o = (c < 36) ? hi : (h16)(v - (float)hi); }
        b.Wr16[idx] = o;
    }
}

template <int HD, int NBR, int NJ> __device__ __forceinline__ void attn_wave_task(const Bufs& b, int id, LAS float* qs, LAS float* sc, int lane) {
    constexpr int NH = (NBR == 3) ? AH : BH;
    const int tok = id / NH, head = id % NH; const int bb = tok / SEQ, tpos = tok % SEQ;
    int qcol, kcol, vcol, ocol; float slope2, sink2 = -INFINITY;
    if (NBR == 3) { qcol = head * 128; kcol = 1024 + head * 128; vcol = 2048 + head * 128; ocol = head * 128; slope2 = exp2f(-(float)(head + 1)) * LOG2E; }
    else { const int kv = head / BG; qcol = 3072 + head * 64; kcol = 4096 + kv * 64; vcol = 4224 + kv * 64; ocol = 1024 + head * 64; slope2 = exp2f(-0.5f * (float)(head + 1)) * LOG2E; sink2 = b.sinks[head] * LOG2E; }
    const h16* base = b.proj + (size_t)bb * SEQ * NIN;
    for (int d = lane; d < HD; d += 64) qs[d] = (float)base[(size_t)tpos * NIN + qcol + d];
    LDS_WAIT();
    float mx = -INFINITY;
    for (int i = lane; i < NBR * NJ; i += 64) {
        const int br = i / NJ, j = i % NJ; const int dil = (br == 0) ? 1 : (br == 1 ? 4 : 16); const int s = tpos - dil * j; float v = -INFINITY;
        if (s >= 0) { const h16* kr = base + (size_t)s * NIN + kcol; float a = 0.f;
            for (int d = 0; d < HD; d += 8) { const half8 kk = *(const half8*)(kr + d);
#pragma unroll
                for (int e = 0; e < 8; ++e) a += qs[d + e] * (float)kk[e]; }
            v = a - slope2 * (float)(dil * j); }
        sc[i] = v; mx = fmaxf(mx, v);
    }
    mx = wave_max(mx); mx = fmaxf(mx, sink2);
    LDS_WAIT();
    float sum = 0.f;
    for (int i = lane; i < NBR * NJ; i += 64) { const float pv = exp2f(sc[i] - mx); sc[i] = pv; sum += pv; }
    sum = wave_sum(sum); sum += exp2f(sink2 - mx);
    LDS_WAIT();
    constexpr int DPL = HD / 64;
    float o[DPL];
#pragma unroll
    for (int e = 0; e < DPL; ++e) o[e] = 0.f;
    for (int i = 0; i < NBR * NJ; ++i) {
        const float pv = sc[i]; if (pv == 0.f) continue;
        const int br = i / NJ, j = i % NJ; const int dil = (br == 0) ? 1 : (br == 1 ? 4 : 16); const int s = tpos - dil * j; const h16* vr = base + (size_t)s * NIN + vcol + lane * DPL;
#pragma unroll
        for (int e = 0; e < DPL; ++e) o[e] += pv * (float)vr[e];
    }
    const float inv = 1.f / sum;
#pragma unroll
    for (int e = 0; e < DPL; ++e) b.mixed[(size_t)tok * D + ocol + lane * DPL + e] = (h16)(o[e] * inv);
    LDS_WAIT();
}
__device__ __forceinline__ void phase_attn_simple(const Frame& F, const Bufs& b) {
    LAS float* qs = (LAS float*)(F.lds + RING_OFF + F.wave * 4096); LAS float* sc = qs + 128;
    const int gw = F.vcu * NWAVES + F.wave, NGW = F.G * NWAVES;
    for (int id = gw; id < T * AH; id += NGW) attn_wave_task<128, 3, 129>(b, id, qs, sc, F.lane);
    for (int id = gw; id < T * BH; id += NGW) attn_wave_task<64, 1, 128>(b, id, qs, sc, F.lane);
}

__device__ __forceinline__ void phase_route(const Frame& F, const Bufs& b) {
    LAS float* lg = (LAS float*)(F.lds + RING_OFF);
    LAS float* sq = lg + 64 * 81;
    const int lane = F.lane, fr = lane & 15, fq = lane >> 4, rt = F.wave & 3, cg = F.wave >> 2;
    for (int tb = F.vcu; tb < T / 64; tb += F.G) {
        const int r0 = tb * 64;
        const h16* ap = b.h1 + (size_t)(r0 + rt * 16 + fr) * D + fq * 8;
        const h16* bp = b.Wr16 + (size_t)(cg * 48 + fr) * D + fq * 8;
        f32x4 acc0 = {0.f, 0.f, 0.f, 0.f}, acc1 = acc0, acc2 = acc0; float ss = 0.f;
#pragma unroll 4
        for (int ks = 0; ks < D / 32; ++ks) {
            const half8 a = *(const half8*)(ap + ks * 32);
            const half8 b0 = *(const half8*)(bp + ks * 32), b1 = *(const half8*)(bp + 16 * D + ks * 32);
            acc0 = __builtin_amdgcn_mfma_f32_16x16x32_f16(a, b0, acc0, 0, 0, 0);
            acc1 = __builtin_amdgcn_mfma_f32_16x16x32_f16(a, b1, acc1, 0, 0, 0);
            if (cg == 0) { const half8 b2 = *(const half8*)(bp + 32 * D + ks * 32); acc2 = __builtin_amdgcn_mfma_f32_16x16x32_f16(a, b2, acc2, 0, 0, 0);
#pragma unroll
                for (int j = 0; j < 8; ++j) { const float v = (float)a[j]; ss += v * v; } }
        }
#pragma unroll
        for (int r = 0; r < 4; ++r) { const int row = rt * 16 + 4 * fq + r; lg[row * 81 + cg * 48 + fr] = acc0[r]; lg[row * 81 + cg * 48 + 16 + fr] = acc1[r]; if (cg == 0) lg[row * 81 + 32 + fr] = acc2[r]; }
        if (cg == 0) { ss += __shfl_xor(ss, 16); ss += __shfl_xor(ss, 32); if (fq == 0) sq[rt * 16 + fr] = ss; }
        LDS_WAIT(); __syncthreads();
        if (F.tid < 64) {
            const int tok = r0 + F.tid; const LAS float* L = lg + F.tid * 81;
            const float rs = 1.0f / sqrtf(sq[F.tid] * (1.0f / D) + EPS);
            float gl[4];
#pragma unroll
            for (int g = 0; g < 4; ++g) gl[g] = (L[g] + L[36 + g]) * rs + b.b_grp[g];
            int gi = 0; float gm = gl[0];
#pragma unroll
            for (int g = 1; g < 4; ++g) if (gl[g] > gm) { gm = gl[g]; gi = g; }
            float gs = 0.f;
#pragma unroll
            for (int g = 0; g < 4; ++g) gs += __expf(gl[g] - gm);
            const float gw = 1.f / gs;
            int i0 = 0, i1 = 0; float v0 = -INFINITY, v1 = -INFINITY;
            for (int e = 0; e < 8; ++e) { const float v = (L[4 + gi * 8 + e] + L[40 + gi * 8 + e]) * rs + b.b_exp[gi * 8 + e];
                if (v > v0) { v1 = v0; i1 = i0; v0 = v; i0 = e; } else if (v > v1) { v1 = v; i1 = e; } }
            const float e1 = __expf(v1 - v0); const float w0 = gw / (1.f + e1), w1 = gw * e1 / (1.f + e1);
            const int ea = gi * 8 + i0, eb = gi * 8 + i1;
            b.r2[tok] = rs;
            const int pa = atomicAdd(b.cnt + ea, 1); b.ltok[(size_t)ea * T + pa] = tok; b.lw[(size_t)ea * T + pa] = w0;
            const int pb = atomicAdd(b.cnt + eb, 1); b.ltok[(size_t)eb * T + pb] = tok | (1 << 30); b.lw[(size_t)eb * T + pb] = w1;
        }
        __syncthreads();
    }
}

__device__ __forceinline__ void phase_combine(const Frame& F, const Bufs& b) {
    const int gw = F.vcu * NWAVES + F.wave, NGW = F.G * NWAVES, lane = F.lane;
    for (int tok = gw; tok < T; tok += NGW) {
        float ss = 0.f;
#pragma unroll
        for (int j = 0; j < 4; ++j) { const size_t o = (size_t)tok * D + j * 512 + lane * 8;
            const half8 a = *(const half8*)(b.h1 + o), c0 = *(const half8*)(b.y + o), c1 = *(const half8*)(b.y + (size_t)T * D + o); half8 r;
#pragma unroll
            for (int e = 0; e < 8; ++e) { const float s = (float)a[e] + (float)c0[e] + (float)c1[e]; ss += s * s; r[e] = (h16)s; }
            *(half8*)(b.h2 + o) = r; }
        ss = wave_sum(ss); if (lane == 0) b.r3[tok] = 1.0f / sqrtf(ss * (1.0f / D) + EPS);
    }
}
__device__ __forceinline__ void phase_final(const Frame& F, const Bufs& b) {
    const int gw = F.vcu * NWAVES + F.wave, NGW = F.G * NWAVES, lane = F.lane;
    for (int tok = gw; tok < T; tok += NGW) {
        const float rs = 1.0f / sqrtf(b.ssq[tok] * (1.0f / D) + EPS);
#pragma unroll
        for (int j = 0; j < 8; ++j) { const size_t o = (size_t)tok * D + j * 256 + lane * 4; f32x4 v = *(f32x4*)(b.out + o); const f32x4 gg = *(const f32x4*)(b.g_final + j * 256 + lane * 4);
            v.x *= rs * gg.x; v.y *= rs * gg.y; v.z *= rs * gg.z; v.w *= rs * gg.w; *(f32x4*)(b.out + o) = v; }
    }
}
namespace at {
typedef short v4i16 __attribute__((ext_vector_type(4)));
struct Task {
    const h16* qbase;
    const h16* kbase;
    const h16* vbase;
    int dil, rho;
    int ql0;
    int maxdelta;
    float slope2d;
};
__device__ __forceinline__ half8 tr_pair(const LAS unsigned char* p) {
    const v4i16 lo = __builtin_amdgcn_ds_read_tr16_b64_v4i16((LAS v4i16*)p), hi = __builtin_amdgcn_ds_read_tr16_b64_v4i16((LAS v4i16*)(p + 512));
    typedef short s8 __attribute__((ext_vector_type(8)));
    const s8 r = {lo[0], lo[1], lo[2], lo[3], hi[0], hi[1], hi[2], hi[3]};
    return __builtin_bit_cast(half8, r);
}
template <int HD> __device__ __forceinline__ void run_task(const Task& t, LAS unsigned char* vbuf, int lane, float& m_out, float& l_out, f32x16 (&O)[HD / 32]) {
    constexpr int ND0 = HD / 16, NDB = HD / 32, NP = NDB * 2, VB = HD * 64;
    const int r32 = lane & 31, hi = lane >> 5;
    half8 qf[ND0];
    { const h16* qp = t.qbase + (size_t)(t.dil * (t.ql0 + r32) + t.rho) * NIN + hi * 8;
#pragma unroll
      for (int d0 = 0; d0 < ND0; ++d0) qf[d0] = *(const half8*)(qp + 16 * d0); }
    const int j1 = t.ql0 >> 5, j0 = (j1 - 4) > 0 ? (j1 - 4) : 0;
    const h16* kp = t.kbase + (size_t)(t.dil * (32 * j0 + r32) + t.rho) * NIN + hi * 8;
    const h16* vp = t.vbase + (size_t)(t.dil * (32 * j0 + (lane >> 2)) + t.rho) * NIN + (lane & 3) * 8;
    const size_t tile_step = (size_t)32 * t.dil * NIN, ks_step = (size_t)16 * t.dil * NIN;
    const int laneoff = ((lane >> 4) & 1) * 32 + (lane & 3) * 8 + (4 * hi + ((lane & 15) >> 2)) * 64;
#define AT_DMAV(jj, bufb) do { _Pragma("unroll") for (int _p = 0; _p < NP; ++_p) \
        __builtin_amdgcn_global_load_lds((const unsigned*)(vp + (size_t)((jj) - j0) * tile_step + (_p & 1) * ks_step + (_p >> 1) * 32), (LAS unsigned*)(vbuf + (bufb) + _p * 1024), 16, 0, 0); } while (0)
    float m = -1e30f, l = 0.f;
#pragma unroll
    for (int b = 0; b < NDB; ++b)
#pragma unroll
        for (int r = 0; r < 16; ++r) O[b][r] = 0.f;
    AT_DMAV(j0, 0);
    for (int j = j0; j <= j1; ++j) {
        const int bufb = ((j - j0) & 1) * VB;
        half8 kf[ND0];
#pragma unroll
        for (int d0 = 0; d0 < ND0; ++d0) kf[d0] = *(const half8*)(kp + (size_t)(j - j0) * tile_step + 16 * d0);
        f32x16 S;
#pragma unroll
        for (int r = 0; r < 16; ++r) S[r] = 0.f;
#pragma unroll
        for (int d0 = 0; d0 < ND0; ++d0) S = __builtin_amdgcn_mfma_f32_32x32x16_f16(kf[d0], qf[d0], S, 0, 0, 0);
        asm volatile("" ::: "memory");
        if (j < j1) AT_DMAV(j + 1, bufb ^ VB);
        asm volatile("" ::: "memory");
        const int dbase = t.ql0 + r32 - 32 * j - 4 * hi;
        float mx = -INFINITY;
#pragma unroll
        for (int r = 0; r < 16; ++r) { const int delta = dbase - ((r & 3) + 8 * (r >> 2)); float v = S[r] - t.slope2d * (float)delta;
            v = (delta >= 0 && delta <= t.maxdelta) ? v : -INFINITY; S[r] = v; mx = fmaxf(mx, v); }
        mx = fmaxf(mx, __shfl_xor(mx, 32));
        const float mn = fmaxf(m, mx), alpha = __builtin_amdgcn_exp2f(m - mn); m = mn;
        float ps = 0.f;
#pragma unroll
        for (int r = 0; r < 16; ++r) { S[r] = __builtin_amdgcn_exp2f(S[r] - mn); ps += S[r]; }
        l = l * alpha + ps;
#pragma unroll
        for (int b = 0; b < NDB; ++b)
#pragma unroll
            for (int r = 0; r < 16; ++r) O[b][r] *= alpha;
        half8 pf[2];
#pragma unroll
        for (int s = 0; s < 2; ++s) { u32x4 w; w.x = g8::pk_h2(S[8 * s + 0], S[8 * s + 1]); w.y = g8::pk_h2(S[8 * s + 2], S[8 * s + 3]); w.z = g8::pk_h2(S[8 * s + 4], S[8 * s + 5]); w.w = g8::pk_h2(S[8 * s + 6], S[8 * s + 7]); pf[s] = __builtin_bit_cast(half8, w); }
        if (j < j1) { if (NP == 8) asm volatile("s_waitcnt vmcnt(8)" ::: "memory"); else asm volatile("s_waitcnt vmcnt(4)" ::: "memory"); }
        else asm volatile("s_waitcnt vmcnt(0)" ::: "memory");
#pragma unroll
        for (int b = 0; b < NDB; ++b)
#pragma unroll
            for (int s = 0; s < 2; ++s) { const half8 vf = tr_pair(vbuf + bufb + b * 2048 + s * 1024 + laneoff); O[b] = __builtin_amdgcn_mfma_f32_32x32x16_f16(vf, pf[s], O[b], 0, 0, 0); }
        asm volatile("s_waitcnt lgkmcnt(0)" ::: "memory");
    }
#undef AT_DMAV
    l += __shfl_xor(l, 32);
    m_out = m; l_out = l;
}
template <int HD> __device__ __forceinline__ void store_rows(h16* rp, const f32x16 (&O)[HD / 32], float sc, int hi) {
#pragma unroll
    for (int b = 0; b < HD / 32; ++b)
#pragma unroll
        for (int g = 0; g < 4; ++g) { u32x2 w; w.x = g8::pk_h2(O[b][4 * g] * sc, O[b][4 * g + 1] * sc); w.y = g8::pk_h2(O[b][4 * g + 2] * sc, O[b][4 * g + 3] * sc);
            *(u32x2*)(rp + 32 * b + 8 * g + 4 * hi) = w; }
}
__device__ __forceinline__ f32x4 ld4h(const h16* p) { const h16x4 v = *(const h16x4*)p; return (f32x4){(float)v[0], (float)v[1], (float)v[2], (float)v[3]}; }

__device__ __forceinline__ void phase_attn(const Frame& F, const Bufs& b, h16* exo, float* exl) {
    const int lane = F.lane, w = F.wave, r32 = lane & 31, hi = lane >> 5;
    LAS unsigned char* vbuf = F.lds + RING_OFF + w * 16384;
    for (int u = F.vcu; u < BATCH * AH * 4; u += F.G) {
        const int c = u & 3, h = (u >> 2) & 7, bb = u >> 5;
        const h16* base = b.proj + (size_t)bb * SEQ * NIN;
        Task t; t.qbase = base + h * 128; t.kbase = base + 1024 + h * 128; t.vbase = base + 2048 + h * 128; t.maxdelta = 128;
        const float slope2 = exp2f(-(float)(h + 1)) * LOG2E;
        f32x16 O[4]; float m, l;
#pragma unroll 1
        for (int k = w; k < 32; k += 8) {
            const int br = k >> 4, kk = k & 15;
            if (br == 0) { t.dil = 1; t.rho = 0; t.ql0 = 512 * c + 32 * kk; } else { t.dil = 4; t.rho = kk >> 2; t.ql0 = 128 * c + 32 * (kk & 3); }
            t.slope2d = slope2 * (float)t.dil;
            run_task<128>(t, vbuf, lane, m, l, O);
            const int tok = bb * SEQ + t.dil * (t.ql0 + r32) + t.rho;
            store_rows<128>(exo + ((size_t)br * T + tok) * 1024 + h * 128, O, 1.f / l, hi);
            if (hi == 0) exl[((size_t)br * T + tok) * 8 + h] = m + __builtin_amdgcn_logf(l);
        }
        asm volatile("s_waitcnt vmcnt(0)" ::: "memory"); __syncthreads();
#pragma unroll 1
        for (int rho = w; rho < 16; rho += 8) {
            t.dil = 16; t.rho = rho; t.ql0 = 32 * c; t.slope2d = slope2 * 16.f;
            run_task<128>(t, vbuf, lane, m, l, O);
            const int tok = bb * SEQ + 16 * (t.ql0 + r32) + rho;
            const float l3 = m + __builtin_amdgcn_logf(l);
            const float l1 = exl[(size_t)tok * 8 + h], l2 = exl[((size_t)T + tok) * 8 + h];
            const float M = fmaxf(fmaxf(l1, l2), l3);
            const float w1 = __builtin_amdgcn_exp2f(l1 - M), w2 = __builtin_amdgcn_exp2f(l2 - M), w3 = __builtin_amdgcn_exp2f(l3 - M);
            const float inv = 1.f / (w1 + w2 + w3); const float s1 = w1 * inv, s2 = w2 * inv, s3 = w3 * inv / l;
            const h16* e1 = exo + (size_t)tok * 1024 + h * 128; const h16* e2 = exo + ((size_t)T + tok) * 1024 + h * 128;
            h16* op = b.mixed + (size_t)tok * D + h * 128;
#pragma unroll
            for (int bk = 0; bk < 4; ++bk)
#pragma unroll
                for (int g = 0; g < 4; ++g) { const int d = 32 * bk + 8 * g + 4 * hi; const f32x4 a1 = ld4h(e1 + d), a2 = ld4h(e2 + d);
                    u32x2 wv; wv.x = g8::pk_h2(O[bk][4 * g] * s3 + a1[0] * s1 + a2[0] * s2, O[bk][4 * g + 1] * s3 + a1[1] * s1 + a2[1] * s2);
                    wv.y = g8::pk_h2(O[bk][4 * g + 2] * s3 + a1[2] * s1 + a2[2] * s2, O[bk][4 * g + 3] * s3 + a1[3] * s1 + a2[3] * s2);
                    *(u32x2*)(op + d) = wv; }
        }
        asm volatile("s_waitcnt vmcnt(0)" ::: "memory"); __syncthreads();
    }
    for (int u = F.vcu; u < BATCH * BKV * 16; u += F.G) {
        const int qb = u & 15, kv = (u >> 4) & 1, bb = u >> 5; const int hq = kv * 8 + w;
        const h16* base = b.proj + (size_t)bb * SEQ * NIN;
        Task t; t.qbase = base + 3072 + hq * 64; t.kbase = base + 4096 + kv * 64; t.vbase = base + 4224 + kv * 64; t.maxdelta = 127; t.dil = 1; t.rho = 0;
        t.slope2d = exp2f(-0.5f * (float)(hq + 1)) * LOG2E;
        const float sink2 = b.sinks[hq] * LOG2E;
        f32x16 O[2]; float m, l;
#pragma unroll 1
        for (int i = 0; i < 4; ++i) {
            t.ql0 = 128 * qb + 32 * i;
            run_task<64>(t, vbuf, lane, m, l, O);
            const float mf = fmaxf(m, sink2); const float a = __builtin_amdgcn_exp2f(m - mf); const float den = l * a + __builtin_amdgcn_exp2f(sink2 - mf);
            const int tok = bb * SEQ + t.ql0 + r32;
            store_rows<64>(b.mixed + (size_t)tok * D + 1024 + hq * 64, O, a / den, hi);
        }
    }
}
}
constexpr int NPH = 10;
__global__ void __launch_bounds__(NWAVES * 64, 2) mega(Args args) {
    extern __shared__ __attribute__((aligned(16))) unsigned char lds[];
    const Bufs& b = args.b;
    Frame F;
    F.lds = (LAS unsigned char*)lds;
    F.tid = threadIdx.x; F.lane = F.tid & 63; F.wave = __builtin_amdgcn_readfirstlane(F.tid >> 6);
    F.G = gridDim.x; { const int bx = blockIdx.x; F.vcu = (F.G % 8 == 0) ? (bx % 8) * (F.G / 8) + bx / 8 : bx; }
    volatile LAS unsigned* MISC = (volatile LAS unsigned*)(F.lds + MISC_OFF);
    volatile LAS int* tab = (volatile LAS int*)(F.lds + TAB_OFF);
    for (int u = F.tid; u < (LDS_BYTES - LDSCTL_OFF) / 4; u += NWAVES * 64) ((LAS unsigned*)(F.lds + LDSCTL_OFF))[u] = 0u;
    __syncthreads();
    unsigned* ctl = (unsigned*)(b.ws + WS_CTL);
    XcdBarrier bar = xcd_barrier_post(ctl + CW_BAR + args.li * XCD_BAR_WORDS, MISC + 8);
    const int lo = args.ph_lo, hi = args.ph_hi;
#ifdef ONLY_PHASE
#define IN(k) ((k) == ONLY_PHASE && lo <= (k) && (k) < hi)
#else
#define IN(k) (lo <= (k) && (k) < hi)
#endif
#define SEAM(k) do { if (IN(k) && IN((k) + 1)) xcd_barrier(bar); } while (0)
    G8_LAS unsigned char* ring = F.lds + RING_OFF;

    if (IN(0)) { phase_prologue(F, b); } SEAM(0);
    if (IN(1)) {
        { g8::Gemm g{b.x16, b.WinT, D}; g8::StaticOrder S; S.init(T, NIN, F.G, (int)blockIdx.x); g8::EpiProj E{b.proj, b.r1}; g8::gemm_phase<g8::EpiProj, g8::StaticOrder>(ring, g, S, E); }
        { g8::Gemm g{b.p16, b.WpleT, PLE}; g8::StaticOrder S; S.init(T, D, F.G, (int)blockIdx.x); g8::EpiPlain E{b.pw16, D}; g8::gemm_phase<g8::EpiPlain, g8::StaticOrder>(ring, g, S, E); }
    } SEAM(1);
    if (IN(2)) { at::phase_attn(F, b, (h16*)(b.ws + WS_RD), (float*)(b.ws + WS_LTOK)); } SEAM(2);
    if (IN(3)) { g8::Gemm g{b.mixed, b.WoutT, D}; g8::StaticOrder S; S.init(T, D, F.G, (int)blockIdx.x); g8::EpiRes E{b.h1, b.x}; g8::gemm_phase<g8::EpiRes, g8::StaticOrder>(ring, g, S, E); } SEAM(3);
    if (IN(4)) { phase_route(F, b); } SEAM(4);
    if (IN(5)) { g8::moe_table(tab, b.cnt); LDS_WAIT(); __syncthreads();
        g8::Gemm g{b.h1, b.WguT, D}; g8::MoeUpOrder S{tab, b.ltok, F.G, F.vcu}; g8::EpiMoeUp E{b.hid, b.ltok, b.lw, b.r2}; g8::gemm_phase<g8::EpiMoeUp, g8::MoeUpOrder>(ring, g, S, E); } SEAM(5);
    if (IN(6)) { g8::moe_table(tab, b.cnt); LDS_WAIT(); __syncthreads();
        g8::Gemm g{b.hid, b.WdT, DE}; g8::MoeDownOrder S{tab, F.G, F.vcu}; g8::EpiMoeDown E{b.y, b.ltok}; g8::gemm_phase<g8::EpiMoeDown, g8::MoeDownOrder>(ring, g, S, E); } SEAM(6);
    if (IN(7)) { phase_combine(F, b); } SEAM(7);
    if (IN(8)) { g8::Gemm g{b.h2, b.WpgT, D}; g8::StaticOrder S; S.init(T, D, F.G, (int)blockIdx.x); g8::EpiPle E{b.out, b.h2, b.pw16, b.r3, b.ssq}; g8::gemm_phase<g8::EpiPle, g8::StaticOrder>(ring, g, S, E); } SEAM(8);
    if (IN(9)) { phase_final(F, b); }
#undef IN
#undef SEAM
}

static int g_grid = 0;
static bool mega_setup() {
    if (g_grid) return g_grid > 0;
    int dev = 0, cus = 0, per_cu = 0;
    if (hipGetDevice(&dev) != hipSuccess || hipDeviceGetAttribute(&cus, hipDeviceAttributeMultiprocessorCount, dev) != hipSuccess) { g_grid = -1; return false; }
    if (hipFuncSetAttribute((const void*)mega, hipFuncAttributeMaxDynamicSharedMemorySize, LDS_BYTES) != hipSuccess) { fprintf(stderr, "hipFuncSetAttribute failed\n"); g_grid = -1; return false; }
    if (hipOccupancyMaxActiveBlocksPerMultiprocessor(&per_cu, (const void*)mega, NWAVES * 64, LDS_BYTES) != hipSuccess || per_cu < 1) { fprintf(stderr, "occupancy query: %d\n", per_cu); (void)hipGetLastError(); g_grid = -1; return false; }
    g_grid = cus;
    return true;
}
static void mega_run(const Bufs& b, int lo, int hi, int li, hipStream_t s) {
    Args a{}; a.b = b; a.ph_lo = lo; a.ph_hi = hi; a.li = li; a.pad = 0;
    hipLaunchKernelGGL(mega, dim3(g_grid), dim3(NWAVES * 64), LDS_BYTES, s, a);
}
extern "C" void kernel_launch(void* const* d_in, const int* in_sizes, int n_in, void* d_out, int out_size, void* d_ws, size_t ws_size, hipStream_t stream) {
    if (n_in != 18 || out_size != T * D || ws_size < WS_END) { fprintf(stderr, "kernel_launch: unexpected shapes: n_in %d out %d ws %zu\n", n_in, out_size, ws_size); return; }
    if (!mega_setup()) return;
    Bufs b = make_bufs(d_in, d_out, d_ws);
    (void)hipMemsetAsync((char*)d_ws + WS_CTL, 0, CTL_ZERO_BYTES, stream);
    mega_run(b, 0, NPH, 0, stream);
}
```

```cpp
#include <hip/hip_runtime.h>
#include <cstdint>
#include <cstdio>
#include <cmath>

typedef _Float16 h16;
typedef _Float16 half8 __attribute__((ext_vector_type(8)));
typedef _Float16 h16x4 __attribute__((ext_vector_type(4)));
typedef _Float16 h16x2 __attribute__((ext_vector_type(2)));
typedef float f32x4 __attribute__((ext_vector_type(4)));
typedef float f32x2 __attribute__((ext_vector_type(2)));
typedef float f32x16 __attribute__((ext_vector_type(16)));
typedef unsigned u32x4 __attribute__((ext_vector_type(4)));
typedef unsigned u32x2 __attribute__((ext_vector_type(2)));
#define UNR _Pragma("unroll")

constexpr int BATCH = 8, SEQ = 2048, T = BATCH * SEQ, D = 2048, PLE = 256;
constexpr int AH = 8, AHD = 128, BH = 16, BHD = 64, BKV = 2, BG = 8;
constexpr int NIN = 4352;
constexpr int NE = 32, DE = 256;
constexpr float EPS = 1e-6f;
constexpr float LOG2E = 1.4426950408889634f;
constexpr float QSCALE_A = 0.08838834764831845f * LOG2E;
constexpr float QSCALE_B = 0.125f * LOG2E;

constexpr size_t MiB = 1u << 20;
constexpr size_t WS_CTL = 0, CTL_ZERO_BYTES = 1 * MiB;
constexpr size_t CTL_CNT = 256 * 1024, CTL_SSQ = 320 * 1024;
constexpr size_t WS_R1 = 1 * MiB, WS_R2 = WS_R1 + 64 * 1024, WS_R3 = WS_R2 + 64 * 1024;
constexpr size_t WS_LTOK = 2 * MiB, WS_LW = 4 * MiB, WS_WR = 6 * MiB, WS_WR16 = 7 * MiB;
constexpr size_t WS_WIN = 8 * MiB, WS_WOUT = 25 * MiB, WS_WGU = 33 * MiB, WS_WD = 97 * MiB, WS_WPLE = 129 * MiB, WS_WPG = 130 * MiB;
constexpr size_t WS_P16 = 138 * MiB, WS_PW16 = 146 * MiB;
constexpr size_t WS_RA = 210 * MiB;
constexpr size_t WS_RB = 274 * MiB;
constexpr size_t WS_RD = 410 * MiB;
constexpr size_t WS_END = 474 * MiB;

namespace nv {

__device__ __forceinline__ float wave_sum(float v) {
#pragma unroll
    for (int o = 1; o < 64; o <<= 1) v += __shfl_xor(v, o);
    return v;
}
__device__ __forceinline__ float wave_max(float v) {
#pragma unroll
    for (int o = 1; o < 64; o <<= 1) v = fmaxf(v, __shfl_xor(v, o));
    return v;
}

__global__ __launch_bounds__(256) void k_prep_x(const float* __restrict__ x, h16* __restrict__ x16, float* __restrict__ r1,
                                                const float* __restrict__ p, h16* __restrict__ p16) {
    const int wid = threadIdx.x >> 6, lane = threadIdx.x & 63;
    const int row = blockIdx.x * 4 + wid;
    if (row >= T) return;
    const float* xr = x + (size_t)row * D;
    float ss = 0.f;
    for (int j = 0; j < D / 256; ++j) {
        const f32x4 v = *(const f32x4*)(xr + j * 256 + lane * 4);
        ss += v.x * v.x + v.y * v.y + v.z * v.z + v.w * v.w;
        h16x4 o = {(h16)v.x, (h16)v.y, (h16)v.z, (h16)v.w};
        *(h16x4*)(x16 + (size_t)row * D + j * 256 + lane * 4) = o;
    }
    ss = wave_sum(ss);
    if (lane == 0) r1[row] = 1.0f / sqrtf(ss * (1.0f / D) + EPS);
    {
        const f32x4 v = *(const f32x4*)(p + (size_t)row * PLE + lane * 4);
        h16x4 o = {(h16)v.x, (h16)v.y, (h16)v.z, (h16)v.w};
        *(h16x4*)(p16 + (size_t)row * PLE + lane * 4) = o;
    }
}

struct TrJob { const float* src; const float* src2; h16* dst; const float* gain; int pitch, K, N, mode; long src_z, dst_z; };
__global__ __launch_bounds__(256) void k_transpose(TrJob j) {
    __shared__ float tile[64][65];
    const int z = blockIdx.z;
    const int k0 = blockIdx.y * 64, n0 = blockIdx.x * 64;
    const int tx = threadIdx.x & 63, ty = threadIdx.x >> 6;
    const float* src = j.src; const float* src2 = j.src2; h16* dst = j.dst + (size_t)z * j.dst_z;
    int pn = 0;
    if (j.mode == 2) { const int e = z >> 1; pn = z & 1; src += (size_t)e * j.src_z; src2 += (size_t)e * j.src_z; }
    else { src += (size_t)z * j.src_z; }
    {
        const int n = n0 + tx;
        const float* s = src; int col = n;
        if (j.mode == 2) { s = (n < 128) ? src : src2; col = 128 * pn + (n & 127); }
        float cs = 1.f;
        if (j.mode == 1) { if (n < 1024) cs = QSCALE_A; else if (n >= 3072 && n < 4096) cs = QSCALE_B; }
        for (int i = 0; i < 16; ++i) {
            const int k = k0 + ty + 4 * i;
            float v = s[(size_t)k * j.pitch + col] * cs;
            if (j.gain) v *= j.gain[k];
            tile[ty + 4 * i][tx] = v;
        }
    }
    __syncthreads();
    for (int i = 0; i < 16; ++i) {
        const int n = n0 + ty + 4 * i;
        dst[(size_t)n * j.K + k0 + tx] = (h16)tile[tx][ty + 4 * i];
    }
}
__global__ void k_router_w(const float* __restrict__ w_grp, const float* __restrict__ w_exp, const float* __restrict__ g, float* __restrict__ Wr) {
    const int idx = blockIdx.x * blockDim.x + threadIdx.x;
    if (idx >= 36 * D) return;
    const int c = idx / D, k = idx % D;
    const float v = (c < 4) ? w_grp[(size_t)k * 4 + c] : w_exp[(size_t)k * 32 + (c - 4)];
    Wr[idx] = v * g[k];
}

template <class Op> __global__ __launch_bounds__(256) void k_gemm(Op op) {
    const int z = blockIdx.z;
    const int M = op.mrows(z);
    const int row0 = blockIdx.y * 128; if (row0 >= M) return;
    const int col0 = blockIdx.x * 128;
    const int wid = threadIdx.x >> 6, lane = threadIdx.x & 63, wy = wid >> 1, wx = wid & 1, fr = lane & 15, fq = lane >> 4;
    f32x4 acc[4][4];
#pragma unroll
    for (int a = 0; a < 4; ++a)
#pragma unroll
        for (int b = 0; b < 4; ++b) acc[a][b] = (f32x4){0.f, 0.f, 0.f, 0.f};
    const h16* ap[4]; const h16* bp[4];
#pragma unroll
    for (int mi = 0; mi < 4; ++mi) ap[mi] = op.arow(z, row0 + wy * 64 + mi * 16 + fr) + fq * 8;
#pragma unroll
    for (int ni = 0; ni < 4; ++ni) bp[ni] = op.brow(z, col0 + wx * 64, ni, fr) + fq * 8;
    for (int k0 = 0; k0 < op.K; k0 += 32) {
        half8 a[4], b[4];
#pragma unroll
        for (int i = 0; i < 4; ++i) { a[i] = *(const half8*)(ap[i] + k0); b[i] = *(const half8*)(bp[i] + k0); }
#pragma unroll
        for (int mi = 0; mi < 4; ++mi)
#pragma unroll
            for (int ni = 0; ni < 4; ++ni) acc[mi][ni] = __builtin_amdgcn_mfma_f32_16x16x32_f16(a[mi], b[ni], acc[mi][ni], 0, 0, 0);
    }
    op.epi(z, row0 + wy * 64, col0 + wx * 64, acc, fr, fq);
}

struct OpBase { int K; };
struct OpG1 : OpBase {
    const h16* A; const h16* Bt; const float* r1; h16* out;
    __device__ int mrows(int) const { return T; }
    __device__ const h16* arow(int, int r) const { return A + (size_t)r * D; }
    __device__ const h16* brow(int, int cb, int ni, int fr) const { return Bt + (size_t)(cb + ni * 16 + fr) * D; }
    __device__ void epi(int, int rb, int cb, f32x4 (&acc)[4][4], int fr, int fq) const {
        UNR for (int mi = 0; mi < 4; ++mi) UNR for (int r = 0; r < 4; ++r) { const int row = rb + mi * 16 + fq * 4 + r; const float s = r1[row];
            UNR for (int ni = 0; ni < 4; ++ni) out[(size_t)row * NIN + cb + ni * 16 + fr] = (h16)(acc[mi][ni][r] * s); }
    }
};
struct OpG3 : OpBase {
    const h16* A; const h16* Bt; const float* x; h16* out;
    __device__ int mrows(int) const { return T; }
    __device__ const h16* arow(int, int r) const { return A + (size_t)r * D; }
    __device__ const h16* brow(int, int cb, int ni, int fr) const { return Bt + (size_t)(cb + ni * 16 + fr) * D; }
    __device__ void epi(int, int rb, int cb, f32x4 (&acc)[4][4], int fr, int fq) const {
        UNR for (int mi = 0; mi < 4; ++mi) UNR for (int r = 0; r < 4; ++r) { const int row = rb + mi * 16 + fq * 4 + r;
            UNR for (int ni = 0; ni < 4; ++ni) { const size_t o = (size_t)row * D + cb + ni * 16 + fr; out[o] = (h16)(x[o] + acc[mi][ni][r]); } }
    }
};
__device__ __forceinline__ void moe_offsets(const int* cnt, int e, int& off, int& n) {
    int o = 0; for (int i = 0; i < e; ++i) o += (cnt[i] + 255) & ~255; off = o; n = cnt[e];
}
struct OpMU : OpBase {
    const h16* A; const h16* Wgu; const int* cnt; const int* ltok; const float* lw; const float* r2; h16* hid;
    __device__ int mrows(int z) const { return cnt[z]; }
    __device__ const h16* arow(int z, int r) const { const int n = cnt[z]; const int tok = (r < n) ? (ltok[(size_t)z * T + r] & 0x3fff) : 0; return A + (size_t)tok * D; }
    __device__ const h16* brow(int z, int cb, int ni, int fr) const {
        const int hc = (cb >> 6) * 32 + (ni & 1) * 16 + fr; const int pn = hc >> 7, i = hc & 127;
        return Wgu + ((size_t)(z * 2 + pn) * 256 + (ni >> 1) * 128 + i) * D;
    }
    __device__ void epi(int z, int rb, int cb, f32x4 (&acc)[4][4], int fr, int fq) const {
        int off, n; moe_offsets(cnt, z, off, n);
        UNR for (int mi = 0; mi < 4; ++mi) UNR for (int r = 0; r < 4; ++r) { const int pos = rb + mi * 16 + fq * 4 + r; if (pos >= n) continue;
            const int tok = ltok[(size_t)z * T + pos] & 0x3fff; const float s = r2[tok], w = lw[(size_t)z * T + pos];
            UNR for (int ni = 0; ni < 2; ++ni) { const float g = acc[mi][ni][r] * s, u = acc[mi][ni + 2][r] * s;
                const float v = g / (1.f + __expf(-g)) * u * w; const int hc = (cb >> 6) * 32 + ni * 16 + fr;
                hid[(size_t)(off + pos) * DE + hc] = (h16)v; } }
    }
};
struct OpMD : OpBase {
    const h16* hid; const h16* Wd; const int* cnt; const int* ltok; h16* y;
    __device__ int mrows(int z) const { return cnt[z]; }
    __device__ const h16* arow(int z, int r) const { int off, n; moe_offsets(cnt, z, off, n); return hid + (size_t)(off + r) * DE; }
    __device__ const h16* brow(int z, int cb, int ni, int fr) const { return Wd + ((size_t)z * D + cb + ni * 16 + fr) * DE; }
    __device__ void epi(int z, int rb, int cb, f32x4 (&acc)[4][4], int fr, int fq) const {
        const int n = cnt[z];
        UNR for (int mi = 0; mi < 4; ++mi) UNR for (int r = 0; r < 4; ++r) { const int pos = rb + mi * 16 + fq * 4 + r; if (pos >= n) continue;
            const int lt = ltok[(size_t)z * T + pos]; const int tok = lt & 0x3fff, slot = (lt >> 30) & 1;
            UNR for (int ni = 0; ni < 4; ++ni) y[((size_t)slot * T + tok) * D + cb + ni * 16 + fr] = (h16)acc[mi][ni][r]; }
    }
};
struct OpPW : OpBase {
    const h16* A; const h16* Bt; h16* out;
    __device__ int mrows(int) const { return T; }
    __device__ const h16* arow(int, int r) const { return A + (size_t)r * PLE; }
    __device__ const h16* brow(int, int cb, int ni, int fr) const { return Bt + (size_t)(cb + ni * 16 + fr) * PLE; }
    __device__ void epi(int, int rb, int cb, f32x4 (&acc)[4][4], int fr, int fq) const {
        UNR for (int mi = 0; mi < 4; ++mi) UNR for (int r = 0; r < 4; ++r) { const int row = rb + mi * 16 + fq * 4 + r;
            UNR for (int ni = 0; ni < 4; ++ni) out[(size_t)row * D + cb + ni * 16 + fr] = (h16)acc[mi][ni][r]; }
    }
};
struct OpG5 : OpBase {
    const h16* A; const h16* Bt; const float* r3; const h16* pw; float* out; float* ssq;
    __device__ int mrows(int) const { return T; }
    __device__ const h16* arow(int, int r) const { return A + (size_t)r * D; }
    __device__ const h16* brow(int, int cb, int ni, int fr) const { return Bt + (size_t)(cb + ni * 16 + fr) * D; }
    __device__ void epi(int, int rb, int cb, f32x4 (&acc)[4][4], int fr, int fq) const {
        UNR for (int mi = 0; mi < 4; ++mi) UNR for (int r = 0; r < 4; ++r) { const int row = rb + mi * 16 + fq * 4 + r; const float s = r3[row]; float q = 0.f;
            UNR for (int ni = 0; ni < 4; ++ni) { const size_t o = (size_t)row * D + cb + ni * 16 + fr; const float g = 1.f / (1.f + __expf(-acc[mi][ni][r] * s));
                const float h3 = (float)A[o] + g * (float)pw[o]; out[o] = h3; q += h3 * h3; }
            q += __shfl_xor(q, 1); q += __shfl_xor(q, 2); q += __shfl_xor(q, 4); q += __shfl_xor(q, 8);
            if (fr == 0) atomicAdd(ssq + row, q); }
    }
};

template <int HD, int NBR, int NJ> __global__ __launch_bounds__(256) void k_attn(const h16* __restrict__ proj, h16* __restrict__ mixed, const float* __restrict__ sinks) {
    constexpr int NH = (NBR == 3) ? AH : BH;
    __shared__ float qs[4][HD];
    __shared__ float sc[4][NBR * NJ + 1];
    const int wid = threadIdx.x >> 6, lane = threadIdx.x & 63;
    const int id = blockIdx.x * 4 + wid;
    const int tok = id / NH, head = id % NH;
    const int b = tok / SEQ, tpos = tok % SEQ;
    int qcol, kcol, vcol, ocol; float slope2, sink2 = -INFINITY;
    if (NBR == 3) { qcol = head * 128; kcol = 1024 + head * 128; vcol = 2048 + head * 128; ocol = head * 128; slope2 = exp2f(-(float)(head + 1)) * LOG2E; }
    else { const int kv = head / BG; qcol = 3072 + head * 64; kcol = 4096 + kv * 64; vcol = 4224 + kv * 64; ocol = 1024 + head * 64;
           slope2 = exp2f(-0.5f * (float)(head + 1)) * LOG2E; sink2 = sinks[head] * LOG2E; }
    const h16* base = proj + (size_t)b * SEQ * NIN;
    for (int d = lane; d < HD; d += 64) qs[wid][d] = (float)base[(size_t)tpos * NIN + qcol + d];
    __syncthreads();
    float mx = -INFINITY;
    for (int i = lane; i < NBR * NJ; i += 64) {
        const int br = i / NJ, j = i % NJ; const int dil = (br == 0) ? 1 : (br == 1 ? 4 : 16);
        const int s = tpos - dil * j; float v = -INFINITY;
        if (s >= 0) { const h16* kr = base + (size_t)s * NIN + kcol; float a = 0.f;
            for (int d = 0; d < HD; d += 8) { const half8 kk = *(const half8*)(kr + d);
#pragma unroll
                for (int e = 0; e < 8; ++e) a += qs[wid][d + e] * (float)kk[e]; }
            v = a - slope2 * (float)(dil * j); }
        sc[wid][i] = v; mx = fmaxf(mx, v);
    }
    mx = wave_max(mx); mx = fmaxf(mx, sink2);
    __syncthreads();
    float sum = 0.f;
    for (int i = lane; i < NBR * NJ; i += 64) { const float pv = exp2f(sc[wid][i] - mx); sc[wid][i] = pv; sum += pv; }
    sum = wave_sum(sum); sum += exp2f(sink2 - mx);
    __syncthreads();
    constexpr int DPL = HD / 64;
    float o[DPL]; UNR for (int e = 0; e < DPL; ++e) o[e] = 0.f;
    for (int i = 0; i < NBR * NJ; ++i) {
        const float pv = sc[wid][i]; if (pv == 0.f) continue;
        const int br = i / NJ, j = i % NJ; const int dil = (br == 0) ? 1 : (br == 1 ? 4 : 16);
        const int s = tpos - dil * j; const h16* vr = base + (size_t)s * NIN + vcol + lane * DPL;
        UNR for (int e = 0; e < DPL; ++e) o[e] += pv * (float)vr[e];
    }
    const float inv = 1.f / sum;
    UNR for (int e = 0; e < DPL; ++e) mixed[(size_t)tok * D + ocol + lane * DPL + e] = (h16)(o[e] * inv);
}

__global__ __launch_bounds__(256) void k_route(const h16* __restrict__ h1, const float* __restrict__ Wr, const float* __restrict__ b_grp, const float* __restrict__ b_exp,
                                               float* __restrict__ r2, int* __restrict__ cnt, int* __restrict__ ltok, float* __restrict__ lw) {
    const int wid = threadIdx.x >> 6, lane = threadIdx.x & 63; const int tok = blockIdx.x * 4 + wid;
    float v[32];
    float ss = 0.f;
    UNR for (int j = 0; j < 4; ++j) { const half8 hv = *(const half8*)(h1 + (size_t)tok * D + j * 512 + lane * 8);
#pragma unroll
        for (int e = 0; e < 8; ++e) { v[j * 8 + e] = (float)hv[e]; ss += v[j * 8 + e] * v[j * 8 + e]; } }
    ss = wave_sum(ss); const float rs = 1.0f / sqrtf(ss * (1.0f / D) + EPS);
    __shared__ float slg[4][40];
    float* lg = slg[wid];
    for (int c = 0; c < 36; ++c) { float a = 0.f;
        UNR for (int j = 0; j < 4; ++j) { const float* w = Wr + (size_t)c * D + j * 512 + lane * 8;
#pragma unroll
            for (int e = 0; e < 8; ++e) a += v[j * 8 + e] * w[e]; }
        a = wave_sum(a); if (lane == 0) lg[c] = a * rs + (c < 4 ? b_grp[c] : b_exp[c - 4]); }
    __builtin_amdgcn_s_waitcnt(0);
    if (lane == 0) {
        r2[tok] = rs;
        int gi = 0; float gm = lg[0]; for (int g = 1; g < 4; ++g) if (lg[g] > gm) { gm = lg[g]; gi = g; }
        float gs = 0.f; for (int g = 0; g < 4; ++g) gs += __expf(lg[g] - gm);
        const float gw = 1.f / gs;
        int i0 = 0; float v0 = lg[4 + gi * 8]; for (int e = 1; e < 8; ++e) if (lg[4 + gi * 8 + e] > v0) { v0 = lg[4 + gi * 8 + e]; i0 = e; }
        int i1 = -1; float v1 = -INFINITY; for (int e = 0; e < 8; ++e) if (e != i0 && lg[4 + gi * 8 + e] > v1) { v1 = lg[4 + gi * 8 + e]; i1 = e; }
        const float e1 = __expf(v1 - v0); const float w0 = gw / (1.f + e1), w1 = gw * e1 / (1.f + e1);
        const int ea = gi * 8 + i0, eb = gi * 8 + i1;
        const int pa = atomicAdd(cnt + ea, 1); ltok[(size_t)ea * T + pa] = tok; lw[(size_t)ea * T + pa] = w0;
        const int pb = atomicAdd(cnt + eb, 1); ltok[(size_t)eb * T + pb] = tok | (1 << 30); lw[(size_t)eb * T + pb] = w1;
    }
}
__global__ __launch_bounds__(256) void k_combine(const h16* __restrict__ h1, const h16* __restrict__ y, h16* __restrict__ h2, float* __restrict__ r3) {
    const int wid = threadIdx.x >> 6, lane = threadIdx.x & 63; const int tok = blockIdx.x * 4 + wid;
    float ss = 0.f;
    UNR for (int j = 0; j < 4; ++j) { const size_t o = (size_t)tok * D + j * 512 + lane * 8;
        const half8 a = *(const half8*)(h1 + o), b = *(const half8*)(y + o), c = *(const half8*)(y + (size_t)T * D + o); half8 r;
#pragma unroll
        for (int e = 0; e < 8; ++e) { const float s = (float)a[e] + (float)b[e] + (float)c[e]; ss += s * s; r[e] = (h16)s; }
        *(half8*)(h2 + o) = r; }
    ss = wave_sum(ss); if (lane == 0) r3[tok] = 1.0f / sqrtf(ss * (1.0f / D) + EPS);
}
__global__ __launch_bounds__(256) void k_final(float* __restrict__ out, const float* __restrict__ ssq, const float* __restrict__ g) {
    const int wid = threadIdx.x >> 6, lane = threadIdx.x & 63; const int tok = blockIdx.x * 4 + wid;
    const float rs = 1.0f / sqrtf(ssq[tok] * (1.0f / D) + EPS);
    for (int j = 0; j < 8; ++j) { const size_t o = (size_t)tok * D + j * 256 + lane * 4; f32x4 v = *(f32x4*)(out + o); const f32x4 gg = *(const f32x4*)(g + j * 256 + lane * 4);
        v.x *= rs * gg.x; v.y *= rs * gg.y; v.z *= rs * gg.z; v.w *= rs * gg.w; *(f32x4*)(out + o) = v; }
}

}
struct Bufs {
    const float *x, *p, *w_in, *w_out, *sinks, *g_mix, *g_moe, *g_ple, *g_final, *w_grp, *b_grp, *w_exp, *b_exp, *w_gate, *w_up, *w_down, *w_ple, *w_pg;
    float* out; unsigned char* ws;
    float *r1, *r2, *r3, *ssq, *lw, *Wr; int *cnt, *ltok; h16* Wr16;
    h16 *WinT, *WoutT, *WguT, *WdT, *WpleT, *WpgT, *p16, *pw16, *x16, *mixed, *hid, *h2, *proj, *y, *h1;
};
static Bufs make_bufs(void* const* d_in, void* d_out, void* d_ws) {
    Bufs b{};
    const float** f = (const float**)d_in;
    b.x = f[0]; b.p = f[1]; b.w_in = f[2]; b.w_out = f[3]; b.sinks = f[4]; b.g_mix = f[5]; b.g_moe = f[6]; b.g_ple = f[7]; b.g_final = f[8];
    b.w_grp = f[9]; b.b_grp = f[10]; b.w_exp = f[11]; b.b_exp = f[12]; b.w_gate = f[13]; b.w_up = f[14]; b.w_down = f[15]; b.w_ple = f[16]; b.w_pg = f[17];
    b.out = (float*)d_out; b.ws = (unsigned char*)d_ws; unsigned char* w = b.ws;
    b.cnt = (int*)(w + WS_CTL + CTL_CNT); b.ssq = (float*)(w + WS_CTL + CTL_SSQ);
    b.r1 = (float*)(w + WS_R1); b.r2 = (float*)(w + WS_R2); b.r3 = (float*)(w + WS_R3);
    b.ltok = (int*)(w + WS_LTOK); b.lw = (float*)(w + WS_LW); b.Wr = (float*)(w + WS_WR); b.Wr16 = (h16*)(w + WS_WR16);
    b.WinT = (h16*)(w + WS_WIN); b.WoutT = (h16*)(w + WS_WOUT); b.WguT = (h16*)(w + WS_WGU); b.WdT = (h16*)(w + WS_WD); b.WpleT = (h16*)(w + WS_WPLE); b.WpgT = (h16*)(w + WS_WPG);
    b.p16 = (h16*)(w + WS_P16); b.pw16 = (h16*)(w + WS_PW16);
    b.x16 = (h16*)(w + WS_RA); b.mixed = b.x16; b.hid = b.x16; b.h2 = b.x16;
    b.proj = (h16*)(w + WS_RB); b.y = b.proj; b.h1 = (h16*)(w + WS_RD);
    return b;
}
static void naive_prep(const Bufs& b, hipStream_t s) {
    nv::k_prep_x<<<T / 4, 256, 0, s>>>(b.x, b.x16, b.r1, b.p, b.p16);
    { nv::TrJob j{b.w_in, nullptr, b.WinT, b.g_mix, NIN, D, NIN, 1, 0, 0}; nv::k_transpose<<<dim3(NIN / 64, D / 64, 1), 256, 0, s>>>(j); }
    { nv::TrJob j{b.w_out, nullptr, b.WoutT, nullptr, D, D, D, 0, 0, 0}; nv::k_transpose<<<dim3(D / 64, D / 64, 1), 256, 0, s>>>(j); }
    { nv::TrJob j{b.w_gate, b.w_up, b.WguT, b.g_moe, DE, D, 256, 2, (long)D * DE, (long)256 * D}; nv::k_transpose<<<dim3(256 / 64, D / 64, NE * 2), 256, 0, s>>>(j); }
    { nv::TrJob j{b.w_down, nullptr, b.WdT, nullptr, D, DE, D, 0, (long)DE * D, (long)D * DE}; nv::k_transpose<<<dim3(D / 64, DE / 64, NE), 256, 0, s>>>(j); }
    { nv::TrJob j{b.w_ple, nullptr, b.WpleT, nullptr, D, PLE, D, 0, 0, 0}; nv::k_transpose<<<dim3(D / 64, PLE / 64, 1), 256, 0, s>>>(j); }
    { nv::TrJob j{b.w_pg, nullptr, b.WpgT, b.g_ple, D, D, D, 0, 0, 0}; nv::k_transpose<<<dim3(D / 64, D / 64, 1), 256, 0, s>>>(j); }
    nv::k_router_w<<<(36 * D + 255) / 256, 256, 0, s>>>(b.w_grp, b.w_exp, b.g_moe, b.Wr);
}
static void naive_gemm1(const Bufs& b, hipStream_t s) { nv::OpG1 o; o.K = D; o.A = b.x16; o.Bt = b.WinT; o.r1 = b.r1; o.out = b.proj; nv::k_gemm<<<dim3(NIN / 128, T / 128, 1), 256, 0, s>>>(o); }
static void naive_pw(const Bufs& b, hipStream_t s) { nv::OpPW o; o.K = PLE; o.A = b.p16; o.Bt = b.WpleT; o.out = b.pw16; nv::k_gemm<<<dim3(D / 128, T / 128, 1), 256, 0, s>>>(o); }
static void naive_attn(const Bufs& b, hipStream_t s) {
    nv::k_attn<128, 3, 129><<<T * AH / 4, 256, 0, s>>>(b.proj, b.mixed, b.sinks);
    nv::k_attn<64, 1, 128><<<T * BH / 4, 256, 0, s>>>(b.proj, b.mixed, b.sinks);
}
static void naive_gemm3(const Bufs& b, hipStream_t s) { nv::OpG3 o; o.K = D; o.A = b.mixed; o.Bt = b.WoutT; o.x = b.x; o.out = b.h1; nv::k_gemm<<<dim3(D / 128, T / 128, 1), 256, 0, s>>>(o); }
static void naive_route(const Bufs& b, hipStream_t s) { nv::k_route<<<T / 4, 256, 0, s>>>(b.h1, b.Wr, b.b_grp, b.b_exp, b.r2, b.cnt, b.ltok, b.lw); }
static void naive_moe_up(const Bufs& b, hipStream_t s) { nv::OpMU o; o.K = D; o.A = b.h1; o.Wgu = b.WguT; o.cnt = b.cnt; o.ltok = b.ltok; o.lw = b.lw; o.r2 = b.r2; o.hid = b.hid;
    nv::k_gemm<<<dim3(512 / 128, T / 128, NE), 256, 0, s>>>(o); }
static void naive_moe_down(const Bufs& b, hipStream_t s) { nv::OpMD o; o.K = DE; o.hid = b.hid; o.Wd = b.WdT; o.cnt = b.cnt; o.ltok = b.ltok; o.y = b.y;
    nv::k_gemm<<<dim3(D / 128, T / 128, NE), 256, 0, s>>>(o); }
static void naive_combine(const Bufs& b, hipStream_t s) { nv::k_combine<<<T / 4, 256, 0, s>>>(b.h1, b.y, b.h2, b.r3); }
static void naive_gemm5(const Bufs& b, hipStream_t s) { nv::OpG5 o; o.K = D; o.A = b.h2; o.Bt = b.WpgT; o.r3 = b.r3; o.pw = b.pw16; o.out = b.out; o.ssq = b.ssq;
    nv::k_gemm<<<dim3(D / 128, T / 128, 1), 256, 0, s>>>(o); }
static void naive_final(const Bufs& b, hipStream_t s) { nv::k_final<<<T / 4, 256, 0, s>>>(b.out, b.ssq, b.g_final); }
namespace g8 {
#define G8_LAS __attribute__((address_space(3)))
constexpr int BM = 256, BK = 64, HALF = 128, HTB = HALF * BK * 2  , STAGE_BYTES = 8 * HTB, NXCD = 8, WGM = 8;

__host__ __device__ __forceinline__ int lds_byte(int r, int c) { const int st = (r >> 4) * 2 + (c >> 5), rr = r & 15, cc = c & 31, ob = rr * 64 + cc * 2; return st * 1024 + (ob ^ (((ob >> 9) & 1) << 5)); }
__host__ __device__ __forceinline__ void stage_rc(int b, int& R, int& C) { const int st = b / 1024, sb = b % 1024, swz = sb ^ (((sb >> 9) & 1) << 5); R = (st >> 1) * 16 + swz / 64; C = (st & 1) * 32 + (swz % 64) / 2; }
__host__ __device__ __forceinline__ int perm32(int rho) { const int n = rho >> 4, i = rho & 15; return 8 * (i >> 2) + 4 * n + (i & 3); }

struct Unit { int pm, pn, a0, a1, a2, a3; };
struct Gemm { const h16* A; const h16* Bt; int K; };

struct StaticOrder {
    int nM, nN, nwg, G, c;
    __device__ void init(int M, int N, int G_, int c_) { nM = M / BM; nN = N / BM; nwg = nM * nN; G = G_; c = c_; }
    __device__ bool next(int i, Unit& u) const {
        const long L = (long)i * G + c; if (L >= nwg) return false;
        int wgid = (int)L; { const int q = nwg / NXCD, r = nwg % NXCD, xcd = wgid % NXCD, off = wgid / NXCD; wgid = (xcd < r ? xcd * (q + 1) : r * (q + 1) + (xcd - r) * q) + off; }
        const int nig = WGM * nN, gid = wgid / nig, fm = gid * WGM, gsz = (nM - fm) < WGM ? (nM - fm) : WGM;
        u.pm = fm + ((wgid % nig) % gsz); u.pn = (wgid % nig) / gsz; u.a0 = u.a1 = u.a2 = u.a3 = 0; return true;
    }
    __device__ __forceinline__ unsigned arow(const Unit& u, int r) const { return (unsigned)(u.pm * BM + r); }
};

__device__ __forceinline__ unsigned pk_h2(float lo, float hi) { f32x2 v = {lo, hi}; return __builtin_bit_cast(unsigned, __builtin_convertvector(v, h16x2)); }

template <class Epi, class Sched, bool ALIGN_EPI = true>
__device__ __forceinline__ void gemm_phase(G8_LAS unsigned char* lds, const Gemm g, const Sched& S, const Epi& E) {
    const int tid = threadIdx.x, wid = __builtin_amdgcn_readfirstlane(tid >> 6), lane = tid & 63, wr = wid >> 2, wc = wid & 3, fr = lane & 15, fq = lane >> 4;
    const int K = g.K, nt = K / BK;
    unsigned voffB[2];
#pragma unroll
    for (int i = 0; i < 2; ++i) { int R, C; stage_rc(tid * 16 + i * 8192, R, C); const int Rb = Epi::PERM ? ((R & ~31) + perm32(R & 31)) : R; voffB[i] = (unsigned)(Rb * K + C) * 2u; }
    const unsigned pitch = (unsigned)K * 2u;
    const size_t kstep = (size_t)(BK * 2);
    const size_t hstep = (size_t)HALF * K * 2;
    const size_t tstep = 2 * hstep;
    const unsigned ldsw = (unsigned)wid * 1024u;
    const int aoff = lds_byte(wr * 64 + fr, fq * 8), boff = lds_byte(wc * 32 + fr, fq * 8);
#define G8_SA(b, h) (((b) * 2 + (h)) * HTB)
#define G8_SB(b, h) ((4 + (b) * 2 + (h)) * HTB)
#define G8_STAGE(bufoff, gbase, voff) do { _Pragma("unroll") for (int _i = 0; _i < 2; ++_i) \
        __builtin_amdgcn_global_load_lds((const unsigned*)((const char*)(gbase) + (voff)[_i]), (G8_LAS unsigned*)(lds + (bufoff) + ldsw + _i * 8192), 16, 0, 0); } while (0)
#define G8_LDA(dst, b, h) do { _Pragma("unroll") for (int m = 0; m < 4; ++m) _Pragma("unroll") for (int k = 0; k < 2; ++k) dst[m][k] = *(const G8_LAS half8*)(lds + G8_SA(b, h) + aoff + m * 2048 + k * 1024); } while (0)
#define G8_LDB(dst, b, h) do { _Pragma("unroll") for (int n = 0; n < 2; ++n) _Pragma("unroll") for (int k = 0; k < 2; ++k) dst[n][k] = *(const G8_LAS half8*)(lds + G8_SB(b, h) + boff + n * 2048 + k * 1024); } while (0)
#define G8_MMA(ai, bj, At, Bt) do { __builtin_amdgcn_s_setprio(1); _Pragma("unroll") for (int m = 0; m < 4; ++m) _Pragma("unroll") for (int n = 0; n < 2; ++n) _Pragma("unroll") for (int k = 0; k < 2; ++k) \
        acc[ai][bj][m][n] = __builtin_amdgcn_mfma_f32_16x16x32_f16(Bt[n][k], At[m][k], acc[ai][bj][m][n], 0, 0, 0); __builtin_amdgcn_s_setprio(0); } while (0)
#define G8_WAIT_V(n) asm volatile("s_waitcnt vmcnt(" #n ")" ::: "memory")
#define G8_WAIT_L(n) asm volatile("s_waitcnt lgkmcnt(" #n ")" ::: "memory")
#define G8_BAR __builtin_amdgcn_s_barrier()
#define G8_SCHED __builtin_amdgcn_sched_barrier(0)
#define G8_SETVO(dst, u) do { int _t = tid; asm volatile("" : "+v"(_t)); _Pragma("unroll") for (int _i = 0; _i < 2; ++_i) { int _R, _C; stage_rc(_t * 16 + _i * 8192, _R, _C); \
        _Pragma("unroll") for (int _h = 0; _h < 2; ++_h) dst[_h][_i] = S.arow(u, _h * HALF + _R) * pitch + (unsigned)_C * 2u; } } while (0)
    Unit cur, nxt; int ui = 0;
    if (!S.next(0, cur)) return;
    f32x4 acc[2][2][4][2];
#pragma unroll
    for (int a = 0; a < 2; ++a)
#pragma unroll
        for (int b = 0; b < 2; ++b)
#pragma unroll
            for (int m = 0; m < 4; ++m)
#pragma unroll
                for (int n = 0; n < 2; ++n) acc[a][b][m][n] = (f32x4){0.f, 0.f, 0.f, 0.f};
    half8 At[4][2], B0[2][2], B1[2][2];
    unsigned cv[2][2], nv[2][2];
    G8_SETVO(cv, cur);
    const char* const gA = (const char*)g.A;
    const char* cB = (const char*)g.Bt + (size_t)cur.pn * tstep;
    G8_STAGE(G8_SB(0, 0), cB, voffB); G8_STAGE(G8_SB(0, 1), cB + hstep, voffB); G8_STAGE(G8_SA(0, 0), gA, cv[0]); G8_STAGE(G8_SA(0, 1), gA, cv[1]);
    if (wr == 1) G8_BAR;
    G8_WAIT_V(2); G8_BAR;
    G8_STAGE(G8_SB(1, 0), cB + kstep, voffB); G8_STAGE(G8_SA(1, 0), gA + kstep, cv[0]); G8_STAGE(G8_SB(1, 1), cB + hstep + kstep, voffB);
    G8_WAIT_V(6); G8_BAR;
    for (;;) {
        const bool has_next = S.next(ui + 1, nxt);
        if (has_next) { G8_SETVO(nv, nxt); } else {
#pragma unroll
            for (int _h = 0; _h < 2; ++_h)
#pragma unroll
                for (int _i = 0; _i < 2; ++_i) nv[_h][_i] = cv[_h][_i]; }
        const char* nB = has_next ? (const char*)g.Bt + (size_t)nxt.pn * tstep : cB;
#pragma nounroll
        for (int t = 0; t < nt; t += 2) {
            const bool last = (t == nt - 2);
            const char* a1 = gA + (size_t)(t + 1) * kstep;
            const char* a2 = last ? gA : gA + (size_t)(t + 2) * kstep; const char* b2 = last ? nB : cB + (size_t)(t + 2) * kstep;
            const char* a3 = a2 + kstep; const char* b3 = b2 + kstep;
            unsigned v20[2], v21[2];
#pragma unroll
            for (int _i = 0; _i < 2; ++_i) { v20[_i] = last ? nv[0][_i] : cv[0][_i]; v21[_i] = last ? nv[1][_i] : cv[1][_i]; }
            G8_LDB(B0, 0, 0); G8_LDB(B1, 0, 1); G8_SCHED; G8_LDA(At, 0, 0); G8_STAGE(G8_SA(1, 1), a1, cv[1]);
            G8_WAIT_V(8); G8_WAIT_L(0); G8_BAR; G8_MMA(0, 0, At, B0); G8_MMA(0, 1, At, B1); G8_BAR; G8_SCHED;
            G8_LDA(At, 0, 1); G8_STAGE(G8_SB(0, 0), b2, voffB); G8_STAGE(G8_SB(0, 1), b2 + hstep, voffB); G8_STAGE(G8_SA(0, 0), a2, v20);
            G8_WAIT_V(8); G8_WAIT_L(0); G8_BAR; G8_MMA(1, 0, At, B0); G8_MMA(1, 1, At, B1); G8_BAR; G8_SCHED;
            G8_LDB(B0, 1, 0); G8_LDB(B1, 1, 1); G8_SCHED; G8_LDA(At, 1, 0); G8_STAGE(G8_SA(0, 1), a2, v21);
            G8_WAIT_V(8); G8_WAIT_L(0); G8_BAR; G8_MMA(0, 0, At, B0); G8_MMA(0, 1, At, B1); G8_BAR; G8_SCHED;
            G8_LDA(At, 1, 1); G8_STAGE(G8_SB(1, 0), b3, voffB); G8_STAGE(G8_SB(1, 1), b3 + hstep, voffB); G8_STAGE(G8_SA(1, 0), a3, v20);
            G8_WAIT_V(8); G8_WAIT_L(0); G8_BAR; G8_MMA(1, 0, At, B0); G8_MMA(1, 1, At, B1); G8_BAR; G8_SCHED;
        }
        if constexpr (ALIGN_EPI) { if (wr == 0) G8_BAR; }
        E(acc, cur, wr, wc, fr, fq);
        if (!has_next) break;
#pragma unroll
        for (int a = 0; a < 2; ++a)
#pragma unroll
            for (int b = 0; b < 2; ++b)
#pragma unroll
                for (int m = 0; m < 4; ++m)
#pragma unroll
                    for (int n = 0; n < 2; ++n) acc[a][b][m][n] = (f32x4){0.f, 0.f, 0.f, 0.f};
        cur = nxt; cB = nB; ++ui;
#pragma unroll
        for (int _h = 0; _h < 2; ++_h)
#pragma unroll
            for (int _i = 0; _i < 2; ++_i) cv[_h][_i] = nv[_h][_i];
        if constexpr (ALIGN_EPI) { if (wr == 1) G8_BAR; }
    }
    G8_WAIT_V(0);
    if constexpr (!ALIGN_EPI) { if (wr == 0) G8_BAR; }
    G8_BAR;
#undef G8_SA
#undef G8_SB
#undef G8_STAGE
#undef G8_LDA
#undef G8_LDB
#undef G8_MMA
#undef G8_WAIT_V
#undef G8_WAIT_L
#undef G8_BAR
#undef G8_SCHED
#undef G8_SETVO
}
}
namespace g8 {
#define EPI_ROWS UNR for (int ai = 0; ai < 2; ++ai) UNR for (int m = 0; m < 4; ++m)
#define EPI_FENCE asm volatile("" ::: "memory")
#define RFL(x) __builtin_amdgcn_readfirstlane(x)

struct EpiProj {
    static constexpr bool PERM = true;
    h16* out; const float* r1;
    __device__ __forceinline__ void operator()(const f32x4 (&acc)[2][2][4][2], const Unit& u, int wr, int wc, int fr, int fq) const {
        const int row0 = u.pm * BM + wr * 64 + fr, col0 = u.pn * BM + wc * 32 + 8 * fq;
        EPI_ROWS { const int row = row0 + ai * HALF + m * 16; const float s = r1[row]; h16* rp = out + (size_t)row * NIN + col0;
            UNR for (int bj = 0; bj < 2; ++bj) { const f32x4 v0 = acc[ai][bj][m][0] * s, v1 = acc[ai][bj][m][1] * s;
                u32x4 w; w.x = pk_h2(v0[0], v0[1]); w.y = pk_h2(v0[2], v0[3]); w.z = pk_h2(v1[0], v1[1]); w.w = pk_h2(v1[2], v1[3]); *(u32x4*)(rp + bj * HALF) = w; } EPI_FENCE; }
    }
};
struct EpiPlain {
    static constexpr bool PERM = true;
    h16* out; int ldc;
    __device__ __forceinline__ void operator()(const f32x4 (&acc)[2][2][4][2], const Unit& u, int wr, int wc, int fr, int fq) const {
        const int row0 = u.pm * BM + wr * 64 + fr, col0 = u.pn * BM + wc * 32 + 8 * fq;
        EPI_ROWS { const int row = row0 + ai * HALF + m * 16; h16* rp = out + (size_t)row * ldc + col0;
            UNR for (int bj = 0; bj < 2; ++bj) { const f32x4 v0 = acc[ai][bj][m][0], v1 = acc[ai][bj][m][1];
                u32x4 w; w.x = pk_h2(v0[0], v0[1]); w.y = pk_h2(v0[2], v0[3]); w.z = pk_h2(v1[0], v1[1]); w.w = pk_h2(v1[2], v1[3]); *(u32x4*)(rp + bj * HALF) = w; } EPI_FENCE; }
    }
};
struct EpiRes {
    static constexpr bool PERM = true;
    h16* out; const float* x;
    __device__ __forceinline__ void operator()(const f32x4 (&acc)[2][2][4][2], const Unit& u, int wr, int wc, int fr, int fq) const {
        const int row0 = u.pm * BM + wr * 64 + fr, col0 = u.pn * BM + wc * 32 + 8 * fq;
        EPI_ROWS { const int row = row0 + ai * HALF + m * 16; const size_t o = (size_t)row * D + col0;
            UNR for (int bj = 0; bj < 2; ++bj) { const f32x4 x0 = *(const f32x4*)(x + o + bj * HALF), x1 = *(const f32x4*)(x + o + bj * HALF + 4);
                const f32x4 v0 = acc[ai][bj][m][0] + x0, v1 = acc[ai][bj][m][1] + x1;
                u32x4 w; w.x = pk_h2(v0[0], v0[1]); w.y = pk_h2(v0[2], v0[3]); w.z = pk_h2(v1[0], v1[1]); w.w = pk_h2(v1[2], v1[3]); *(u32x4*)(out + o + bj * HALF) = w; } EPI_FENCE; }
    }
};
struct EpiMoeUp {
    static constexpr bool PERM = true;
    h16* hid; const int* ltok; const float* lw; const float* r2;
    __device__ __forceinline__ void operator()(const f32x4 (&acc)[2][2][4][2], const Unit& u, int wr, int wc, int fr, int fq) const {
        const int e = u.a0, hc0 = (u.pn & 1) * 128 + wc * 32 + 8 * fq;
        EPI_ROWS { const int rr = ai * HALF + wr * 64 + m * 16 + fr; if (rr < u.a1) {
            const size_t li = (size_t)e * T + u.a3 + rr; const int tok = ltok[li] & 0x3fff; const float s = r2[tok], w = lw[li];
            float hv[8];
            UNR for (int n = 0; n < 2; ++n) UNR for (int j = 0; j < 4; ++j) { const float gt = acc[ai][0][m][n][j] * s, up = acc[ai][1][m][n][j] * s;
                hv[n * 4 + j] = gt / (1.f + __expf(-gt)) * up * w; }
            u32x4 o; o.x = pk_h2(hv[0], hv[1]); o.y = pk_h2(hv[2], hv[3]); o.z = pk_h2(hv[4], hv[5]); o.w = pk_h2(hv[6], hv[7]);
            *(u32x4*)(hid + (size_t)(u.a2 + rr) * DE + hc0) = o; } EPI_FENCE; }
    }
};
struct EpiMoeDown {
    static constexpr bool PERM = true;
    h16* y; const int* ltok;
    __device__ __forceinline__ void operator()(const f32x4 (&acc)[2][2][4][2], const Unit& u, int wr, int wc, int fr, int fq) const {
        const int e = u.a0, col0 = u.a2 * BM + wc * 32 + 8 * fq;
        EPI_ROWS { const int rr = ai * HALF + wr * 64 + m * 16 + fr; if (rr < u.a1) {
            const int lt = ltok[(size_t)e * T + u.a3 + rr]; const int tok = lt & 0x3fff, slot = (lt >> 30) & 1; h16* rp = y + ((size_t)slot * T + tok) * D + col0;
            UNR for (int bj = 0; bj < 2; ++bj) { const f32x4 v0 = acc[ai][bj][m][0], v1 = acc[ai][bj][m][1];
                u32x4 w; w.x = pk_h2(v0[0], v0[1]); w.y = pk_h2(v0[2], v0[3]); w.z = pk_h2(v1[0], v1[1]); w.w = pk_h2(v1[2], v1[3]); *(u32x4*)(rp + bj * HALF) = w; } } EPI_FENCE; }
    }
};
struct EpiPle {
    static constexpr bool PERM = true;
    float* out; const h16* h2; const h16* pw; const float* r3; float* ssq;
    __device__ __forceinline__ void operator()(const f32x4 (&acc)[2][2][4][2], const Unit& u, int wr, int wc, int fr, int fq) const {
        const int row0 = u.pm * BM + wr * 64 + fr, col0 = u.pn * BM + wc * 32 + 8 * fq;
        EPI_ROWS { const int row = row0 + ai * HALF + m * 16; const float s = r3[row]; const size_t o = (size_t)row * D + col0; float q = 0.f;
            UNR for (int bj = 0; bj < 2; ++bj) { const half8 hh = *(const half8*)(h2 + o + bj * HALF), pp = *(const half8*)(pw + o + bj * HALF); f32x4 r0, r1v;
                UNR for (int j = 0; j < 4; ++j) { const float g0 = 1.f / (1.f + __expf(-acc[ai][bj][m][0][j] * s)), g1 = 1.f / (1.f + __expf(-acc[ai][bj][m][1][j] * s));
                    r0[j] = (float)hh[j] + g0 * (float)pp[j]; r1v[j] = (float)hh[4 + j] + g1 * (float)pp[4 + j]; q += r0[j] * r0[j] + r1v[j] * r1v[j]; }
                *(f32x4*)(out + o + bj * HALF) = r0; *(f32x4*)(out + o + bj * HALF + 4) = r1v; }
            q += __shfl_xor(q, 16); q += __shfl_xor(q, 32);
            if (fq == 0) atomicAdd(ssq + row, q); EPI_FENCE; }
    }
};

__device__ __forceinline__ void moe_table(volatile G8_LAS int* tab, const int* cnt) {
    if (threadIdx.x == 0) { int o = 0; for (int e = 0; e < NE; ++e) { tab[e] = o; tab[64 + e] = cnt[e]; o += (cnt[e] + 255) >> 8; } tab[32] = o; }
}
struct MoeUpOrder {
    const volatile G8_LAS int* tab; const int* ltok; int G, v;
    __device__ bool next(int i, Unit& u) const {
        const int L = i * G + v; const int total = RFL(tab[32]); if (L >= 2 * total) return false;
        int e = 0; UNR for (int k = 1; k < NE; ++k) e = (L >= 2 * tab[k]) ? k : e;
        const int base = tab[e], nte = tab[e + 1] - base, l = L - 2 * base, pn = l / nte, rt = l - pn * nte;
        u.pm = RFL(rt); u.pn = RFL(e * 2 + pn); u.a0 = RFL(e); u.a1 = RFL(tab[64 + e] - rt * 256); u.a2 = RFL((base + rt) * 256); u.a3 = RFL(rt * 256); return true;
    }
    __device__ __forceinline__ unsigned arow(const Unit& u, int r) const { return (r < u.a1) ? (unsigned)(ltok[(size_t)u.a0 * T + u.a3 + r] & 0x3fff) : 0u; }
};
struct MoeDownOrder {
    const volatile G8_LAS int* tab; int G, v;
    __device__ bool next(int i, Unit& u) const {
        const int L = i * G + v; const int total = RFL(tab[32]); if (L >= 8 * total) return false;
        const int gt = L >> 3, pn = L & 7;
        int e = 0; UNR for (int k = 1; k < NE; ++k) e = (gt >= tab[k]) ? k : e;
        const int rt = gt - tab[e];
        u.pm = RFL(gt); u.pn = RFL(e * 8 + pn); u.a0 = RFL(e); u.a1 = RFL(tab[64 + e] - rt * 256); u.a2 = RFL(pn); u.a3 = RFL(rt * 256); return true;
    }
    __device__ __forceinline__ unsigned arow(const Unit& u, int r) const { return (unsigned)(u.pm * BM + r); }
};
}
constexpr int NWAVES = 8;
constexpr int RING_OFF = 0, RING_BYTES = 131072;
constexpr int LDSCTL_OFF = RING_BYTES, MISC_OFF = LDSCTL_OFF, TAB_OFF = LDSCTL_OFF + 512;
constexpr int LDS_BYTES = 147456;
constexpr int CW_TMO = 0, CW_CODE = 1, CW_BAR = 4096;

#define GAS __attribute__((address_space(1)))
#define LAS __attribute__((address_space(3)))
typedef GAS unsigned gu32;
#define RLX_AGENT __ATOMIC_RELAXED, __HIP_MEMORY_SCOPE_AGENT
#define LDS_WAIT() asm volatile("s_waitcnt lgkmcnt(0)" ::: "memory")
#define VM_WAIT() asm volatile("s_waitcnt vmcnt(0)" ::: "memory")

#define XB_TMO      128
#define XB_XCNT(j)  (256  + 64 * (j))
#define XB_XSUB(j)  (1280 + 64 * (j))
#define XB_XGEN(j)  (2304 + 64 * (j))
#define XB_TOP      3328
#define XB_TOPGEN   3392
#define XCD_BAR_WORDS 3456
#define XB_SPIN_CAP (1u << 18)
__device__ __forceinline__ unsigned xb_ld(unsigned* p)              { return __hip_atomic_load(p, __ATOMIC_RELAXED, __HIP_MEMORY_SCOPE_AGENT); }
__device__ __forceinline__ unsigned xb_add(unsigned* p, unsigned v) { return __hip_atomic_fetch_add(p, v, __ATOMIC_RELAXED, __HIP_MEMORY_SCOPE_AGENT); }
__device__ __forceinline__ unsigned xb_xcc_id() { return (unsigned)__builtin_amdgcn_s_getreg((3 << 11) | 20) & 0xFu; }
#define XB_SPIN(cond, bar) do { unsigned _sp = 0; while (cond) { __builtin_amdgcn_s_sleep(1); \
    if ((++_sp & 255u) == 0u) { if (xb_ld(&(bar)[XB_TMO])) break; if (_sp > XB_SPIN_CAP) { atomicAdd(&(bar)[XB_TMO], 1u); break; } } } } while (0)
struct XcdBarrier { unsigned* bar; unsigned x; volatile LAS unsigned* st; };
__device__ __forceinline__ XcdBarrier xcd_barrier_post(unsigned* bar, volatile LAS unsigned* st) {
    XcdBarrier b; b.bar = bar; b.x = xb_xcc_id(); b.st = st;
    if (threadIdx.x == 0) (void)xb_add(&bar[XB_XCNT(b.x)], 1u);
    return b;
}
__device__ __forceinline__ void xcd_barrier_complete(unsigned* bar, unsigned x, unsigned& nloc, unsigned& nx) {
    const unsigned G = gridDim.x * gridDim.y * gridDim.z;
    unsigned sum, cnt, mine, sp = 0u;
    for (;;) {
        sum = 0u; cnt = 0u; mine = 0u;
#pragma unroll
        for (unsigned j = 0; j < 16; ++j) { const unsigned c = xb_ld(&bar[XB_XCNT(j)]); sum += c; cnt += (c > 0u) ? 1u : 0u; mine = (j == x) ? c : mine; }
        if (sum == G) break;
        __builtin_amdgcn_s_sleep(1);
        if ((++sp & 255u) == 0u) { if (xb_ld(&bar[XB_TMO])) break; if (sp > XB_SPIN_CAP) { atomicAdd(&bar[XB_TMO], 1u); break; } }
    }
    nloc = mine > 0u ? mine : 1u; nx = cnt > 0u ? cnt : 1u;
}
__device__ __forceinline__ void xcd_barrier(const XcdBarrier& b) {
    asm volatile("s_waitcnt vmcnt(0)" ::: "memory");
    __syncthreads();
    if (threadIdx.x == 0) {
        unsigned* bar = b.bar;
        __builtin_amdgcn_s_waitcnt(0);
        unsigned nloc = b.st[0], nx = b.st[1];
        if (nloc == 0u) { xcd_barrier_complete(bar, b.x, nloc, nx); b.st[0] = nloc; b.st[1] = nx; }
        const unsigned old = xb_add(&bar[XB_XSUB(b.x)], 1u);
        const unsigned gen = old / nloc;
        if (old + 1u == (gen + 1u) * nloc) {
            __builtin_amdgcn_fence(__ATOMIC_RELEASE, "agent");
            asm volatile("s_waitcnt vmcnt(0)" ::: "memory");
            const unsigned og = xb_add(&bar[XB_TOP], 1u);
            const unsigned tg = og / nx;
            if (og + 1u == (tg + 1u) * nx) xb_add(&bar[XB_TOPGEN], 1u);
            else XB_SPIN(xb_ld(&bar[XB_TOPGEN]) == tg, bar);
            __builtin_amdgcn_fence(__ATOMIC_ACQUIRE, "agent");
            xb_add(&bar[XB_XGEN(b.x)], 1u);
            asm volatile("s_waitcnt vmcnt(0)" ::: "memory");
        } else {
            XB_SPIN(xb_ld(&bar[XB_XGEN(b.x)]) == gen, bar);
            __builtin_amdgcn_fence(__ATOMIC_ACQUIRE, "agent");
            asm volatile("s_waitcnt vmcnt(0)" ::: "memory");
        }
    }
    __syncthreads();
}

struct Args { Bufs b; int ph_lo, ph_hi, li, pad; };

struct Frame {
    LAS unsigned char* lds;
    int tid, lane, wave, vcu, G;
};
__device__ __forceinline__ float wave_sum(float v) {
#pragma unroll
    for (int o = 1; o < 64; o <<= 1) v += __shfl_xor(v, o);
    return v;
}
__device__ __forceinline__ float wave_max(float v) {
#pragma unroll
    for (int o = 1; o < 64; o <<= 1) v = fmaxf(v, __shfl_xor(v, o));
    return v;
}

__device__ __forceinline__ void p0_item(const float* W, int pitch, int K, h16* WT, int scol0, int drow0, int k0, const float* gain, float cs, LAS float* scr, int lane) {
    const int kr = lane >> 3, nc = (lane & 7) * 4;
    f32x4 v[8]; float gn[8];
#pragma unroll
    for (int i = 0; i < 8; ++i) v[i] = *(const f32x4*)(W + (size_t)(k0 + kr + 8 * i) * pitch + scol0 + nc);
#pragma unroll
    for (int i = 0; i < 8; ++i) gn[i] = gain ? gain[k0 + kr + 8 * i] * cs : cs;
#pragma unroll
    for (int i = 0; i < 8; ++i) { LAS float* d = scr + (kr + 8 * i) * 33 + nc; d[0] = v[i].x * gn[i]; d[1] = v[i].y * gn[i]; d[2] = v[i].z * gn[i]; d[3] = v[i].w * gn[i]; }
    LDS_WAIT(); asm volatile("" ::: "memory");
    const int c = lane & 7;
#pragma unroll
    for (int j = 0; j < 4; ++j) { const int n = (lane >> 3) + 8 * j; const LAS float* s = scr + (8 * c) * 33 + n;
        u32x4 o; o.x = g8::pk_h2(s[0 * 33], s[1 * 33]); o.y = g8::pk_h2(s[2 * 33], s[3 * 33]); o.z = g8::pk_h2(s[4 * 33], s[5 * 33]); o.w = g8::pk_h2(s[6 * 33], s[7 * 33]);
        *(u32x4*)(WT + (size_t)(drow0 + n) * K + k0 + 8 * c) = o; }
    LDS_WAIT(); asm volatile("" ::: "memory");
}
__device__ __forceinline__ void phase_prologue(const Frame& F, const Bufs& b) {
    LAS float* scr = (LAS float*)(F.lds + RING_OFF + F.wave * 16384);
    const int gw = F.vcu * NWAVES + F.wave, NGW = F.G * NWAVES, lane = F.lane;
    constexpr int I0 = 32 * 136, I1 = 32 * 64, I2 = 64 * 256, I3 = 32 * 256, I4 = 4 * 64, I5 = 32 * 64, NITEMS = I0 + I1 + I2 + I3 + I4 + I5;
    for (int row = gw; row < T; row += NGW) {
        const float* xr = b.x + (size_t)row * D; float ss = 0.f;
#pragma unroll
        for (int j = 0; j < D / 256; ++j) { const f32x4 v = *(const f32x4*)(xr + j * 256 + lane * 4); ss += v.x * v.x + v.y * v.y + v.z * v.z + v.w * v.w;
            u32x2 o; o.x = g8::pk_h2(v.x, v.y); o.y = g8::pk_h2(v.z, v.w); *(u32x2*)(b.x16 + (size_t)row * D + j * 256 + lane * 4) = o; }
        ss = wave_sum(ss); if (lane == 0) b.r1[row] = 1.0f / sqrtf(ss * (1.0f / D) + EPS);
        { const f32x4 v = *(const f32x4*)(b.p + (size_t)row * PLE + lane * 4); u32x2 o; o.x = g8::pk_h2(v.x, v.y); o.y = g8::pk_h2(v.z, v.w); *(u32x2*)(b.p16 + (size_t)row * PLE + lane * 4) = o; }
    }
    for (int it = gw; it < NITEMS; it += NGW) {
        int r = it;
        if (r < I0) { const int kb = r / 136, nb = r % 136, n0 = 32 * nb; const float cs = (n0 < 1024) ? QSCALE_A : ((n0 >= 3072 && n0 < 4096) ? QSCALE_B : 1.f);
            p0_item(b.w_in, NIN, D, b.WinT, n0, n0, 64 * kb, b.g_mix, cs, scr, lane); continue; } r -= I0;
        if (r < I1) { const int kb = r / 64, nb = r % 64; p0_item(b.w_out, D, D, b.WoutT, 32 * nb, 32 * nb, 64 * kb, nullptr, 1.f, scr, lane); continue; } r -= I1;
        if (r < I2) { const int z = r / 256, q = r % 256, kb = q / 8, nb = q % 8, n0 = 32 * nb, e = z >> 1, pn = z & 1;
            const float* src = ((n0 < 128) ? b.w_gate : b.w_up) + (size_t)e * D * DE;
            p0_item(src, DE, D, b.WguT + (size_t)z * 256 * D, 128 * pn + (n0 & 127), n0, 64 * kb, b.g_moe, 1.f, scr, lane); continue; } r -= I2;
        if (r < I3) { const int e = r / 256, q = r % 256, kb = q / 64, nb = q % 64;
            p0_item(b.w_down + (size_t)e * DE * D, D, DE, b.WdT + (size_t)e * D * DE, 32 * nb, 32 * nb, 64 * kb, nullptr, 1.f, scr, lane); continue; } r -= I3;
        if (r < I4) { const int kb = r / 64, nb = r % 64; p0_item(b.w_ple, D, PLE, b.WpleT, 32 * nb, 32 * nb, 64 * kb, nullptr, 1.f, scr, lane); continue; } r -= I4;
        { const int kb = r / 64, nb = r % 64; p0_item(b.w_pg, D, D, b.WpgT, 32 * nb, 32 * nb, 64 * kb, b.g_ple, 1.f, scr, lane); }
    }
    for (int idx = (F.vcu * NWAVES * 64) + F.tid; idx < 80 * D; idx += F.G * NWAVES * 64) {
        const int c = idx / D, k = idx % D; h16 o = (h16)0.f;
        if (c < 72) { const int cc = (c < 36) ? c : c - 36; const float v = ((cc < 4) ? b.w_grp[(size_t)k * 4 + cc] : b.w_exp[(size_t)k * 32 + (cc - 4)]) * b.g_moe[k];
            const h16 hi = (h16)v; o = (c < 36) ? hi : (h16)(v - (float)hi); }
        b.Wr16[idx] = o;
    }
}

template <int HD, int NBR, int NJ> __device__ __forceinline__ void attn_wave_task(const Bufs& b, int id, LAS float* qs, LAS float* sc, int lane) {
    constexpr int NH = (NBR == 3) ? AH : BH;
    const int tok = id / NH, head = id % NH; const int bb = tok / SEQ, tpos = tok % SEQ;
    int qcol, kcol, vcol, ocol; float slope2, sink2 = -INFINITY;
    if (NBR == 3) { qcol = head * 128; kcol = 1024 + head * 128; vcol = 2048 + head * 128; ocol = head * 128; slope2 = exp2f(-(float)(head + 1)) * LOG2E; }
    else { const int kv = head / BG; qcol = 3072 + head * 64; kcol = 4096 + kv * 64; vcol = 4224 + kv * 64; ocol = 1024 + head * 64; slope2 = exp2f(-0.5f * (float)(head + 1)) * LOG2E; sink2 = b.sinks[head] * LOG2E; }
    const h16* base = b.proj + (size_t)bb * SEQ * NIN;
    for (int d = lane; d < HD; d += 64) qs[d] = (float)base[(size_t)tpos * NIN + qcol + d];
    LDS_WAIT();
    float mx = -INFINITY;
    for (int i = lane; i < NBR * NJ; i += 64) {
        const int br = i / NJ, j = i % NJ; const int dil = (br == 0) ? 1 : (br == 1 ? 4 : 16); const int s = tpos - dil * j; float v = -INFINITY;
        if (s >= 0) { const h16* kr = base + (size_t)s * NIN + kcol; float a = 0.f;
            for (int d = 0; d < HD; d += 8) { const half8 kk = *(const half8*)(kr + d);
#pragma unroll
                for (int e = 0; e < 8; ++e) a += qs[d + e] * (float)kk[e]; }
            v = a - slope2 * (float)(dil * j); }
        sc[i] = v; mx = fmaxf(mx, v);
    }
    mx = wave_max(mx); mx = fmaxf(mx, sink2);
    LDS_WAIT();
    float sum = 0.f;
    for (int i = lane; i < NBR * NJ; i += 64) { const float pv = exp2f(sc[i] - mx); sc[i] = pv; sum += pv; }
    sum = wave_sum(sum); sum += exp2f(sink2 - mx);
    LDS_WAIT();
    constexpr int DPL = HD / 64;
    float o[DPL];
#pragma unroll
    for (int e = 0; e < DPL; ++e) o[e] = 0.f;
    for (int i = 0; i < NBR * NJ; ++i) {
        const float pv = sc[i]; if (pv == 0.f) continue;
        const int br = i / NJ, j = i % NJ; const int dil = (br == 0) ? 1 : (br == 1 ? 4 : 16); const int s = tpos - dil * j; const h16* vr = base + (size_t)s * NIN + vcol + lane * DPL;
#pragma unroll
        for (int e = 0; e < DPL; ++e) o[e] += pv * (float)vr[e];
    }
    const float inv = 1.f / sum;
#pragma unroll
    for (int e = 0; e < DPL; ++e) b.mixed[(size_t)tok * D + ocol + lane * DPL + e] = (h16)(o[e] * inv);
    LDS_WAIT();
}
__device__ __forceinline__ void phase_attn_simple(const Frame& F, const Bufs& b) {
    LAS float* qs = (LAS float*)(F.lds + RING_OFF + F.wave * 4096); LAS float* sc = qs + 128;
    const int gw = F.vcu * NWAVES + F.wave, NGW = F.G * NWAVES;
    for (int id = gw; id < T * AH; id += NGW) attn_wave_task<128, 3, 129>(b, id, qs, sc, F.lane);
    for (int id = gw; id < T * BH; id += NGW) attn_wave_task<64, 1, 128>(b, id, qs, sc, F.lane);
}

__device__ __forceinline__ void phase_route(const Frame& F, const Bufs& b) {
    LAS float* lg = (LAS float*)(F.lds + RING_OFF);
    LAS float* sq = lg + 64 * 81;
    const int lane = F.lane, fr = lane & 15, fq = lane >> 4, w = F.wave;
    for (int tb = F.vcu; tb < T / 64; tb += F.G) {
        const int r0 = tb * 64;
        for (int i = F.tid; i < 64 * 81 + 64; i += NWAVES * 64) lg[i] = 0.f;
        const h16* ap = b.h1 + (size_t)(r0 + fr) * D + w * 256 + fq * 8;
        const h16* bp = b.Wr16 + (size_t)fr * D + w * 256 + fq * 8;
        f32x4 acc[4][5];
#pragma unroll
        for (int rt = 0; rt < 4; ++rt)
#pragma unroll
            for (int ct = 0; ct < 5; ++ct) acc[rt][ct] = (f32x4){0.f, 0.f, 0.f, 0.f};
        float ss[4] = {0.f, 0.f, 0.f, 0.f};
#pragma unroll 1
        for (int kb = 0; kb < 4; ++kb) {
            half8 a[2][4], bb[2][5];
#pragma unroll
            for (int k2 = 0; k2 < 2; ++k2) {
#pragma unroll
                for (int rt = 0; rt < 4; ++rt) a[k2][rt] = *(const half8*)(ap + (size_t)rt * 16 * D + (kb * 2 + k2) * 32);
#pragma unroll
                for (int ct = 0; ct < 5; ++ct) bb[k2][ct] = *(const half8*)(bp + (size_t)ct * 16 * D + (kb * 2 + k2) * 32);
            }
#pragma unroll
            for (int k2 = 0; k2 < 2; ++k2)
#pragma unroll
                for (int rt = 0; rt < 4; ++rt) {
#pragma unroll
                    for (int ct = 0; ct < 5; ++ct) acc[rt][ct] = __builtin_amdgcn_mfma_f32_16x16x32_f16(a[k2][rt], bb[k2][ct], acc[rt][ct], 0, 0, 0);
#pragma unroll
                    for (int j = 0; j < 8; ++j) { const float v = (float)a[k2][rt][j]; ss[rt] += v * v; }
                }
        }
        LDS_WAIT(); __syncthreads();
#pragma unroll
        for (int rt = 0; rt < 4; ++rt) {
#pragma unroll
            for (int ct = 0; ct < 5; ++ct)
#pragma unroll
                for (int r = 0; r < 4; ++r) atomicAdd((float*)(lg + (rt * 16 + 4 * fq + r) * 81 + ct * 16 + fr), acc[rt][ct][r]);
            float s2 = ss[rt]; s2 += __shfl_xor(s2, 16); s2 += __shfl_xor(s2, 32);
            if (fq == 0) atomicAdd((float*)(sq + rt * 16 + fr), s2);
        }
        LDS_WAIT(); __syncthreads();
        if (F.tid < 64) {
            const int tok = r0 + F.tid; const LAS float* L = lg + F.tid * 81;
            const float rs = 1.0f / sqrtf(sq[F.tid] * (1.0f / D) + EPS);
            float gl[4];
#pragma unroll
            for (int g = 0; g < 4; ++g) gl[g] = (L[g] + L[36 + g]) * rs + b.b_grp[g];
            int gi = 0; float gm = gl[0];
#pragma unroll
            for (int g = 1; g < 4; ++g) if (gl[g] > gm) { gm = gl[g]; gi = g; }
            float gs = 0.f;
#pragma unroll
            for (int g = 0; g < 4; ++g) gs += __expf(gl[g] - gm);
            const float gw = 1.f / gs;
            int i0 = 0, i1 = 0; float v0 = -INFINITY, v1 = -INFINITY;
            for (int e = 0; e < 8; ++e) { const float v = (L[4 + gi * 8 + e] + L[40 + gi * 8 + e]) * rs + b.b_exp[gi * 8 + e];
                if (v > v0) { v1 = v0; i1 = i0; v0 = v; i0 = e; } else if (v > v1) { v1 = v; i1 = e; } }
            const float e1 = __expf(v1 - v0); const float w0 = gw / (1.f + e1), w1 = gw * e1 / (1.f + e1);
            const int ea = gi * 8 + i0, eb = gi * 8 + i1;
            b.r2[tok] = rs;
            const int pa = atomicAdd(b.cnt + ea, 1); b.ltok[(size_t)ea * T + pa] = tok; b.lw[(size_t)ea * T + pa] = w0;
            const int pb = atomicAdd(b.cnt + eb, 1); b.ltok[(size_t)eb * T + pb] = tok | (1 << 30); b.lw[(size_t)eb * T + pb] = w1;
        }
        __syncthreads();
    }
}

__device__ __forceinline__ void phase_combine(const Frame& F, const Bufs& b) {
    const int gw = F.vcu * NWAVES + F.wave, NGW = F.G * NWAVES, lane = F.lane;
    for (int tok = gw; tok < T; tok += NGW) {
        float ss = 0.f;
#pragma unroll
        for (int j = 0; j < 4; ++j) { const size_t o = (size_t)tok * D + j * 512 + lane * 8;
            const half8 a = *(const half8*)(b.h1 + o), c0 = *(const half8*)(b.y + o), c1 = *(const half8*)(b.y + (size_t)T * D + o); half8 r;
#pragma unroll
            for (int e = 0; e < 8; ++e) { const float s = (float)a[e] + (float)c0[e] + (float)c1[e]; ss += s * s; r[e] = (h16)s; }
            *(half8*)(b.h2 + o) = r; }
        ss = wave_sum(ss); if (lane == 0) b.r3[tok] = 1.0f / sqrtf(ss * (1.0f / D) + EPS);
    }
}
__device__ __forceinline__ void phase_final(const Frame& F, const Bufs& b) {
    const int gw = F.vcu * NWAVES + F.wave, NGW = F.G * NWAVES, lane = F.lane;
    for (int tok = gw; tok < T; tok += NGW) {
        const float rs = 1.0f / sqrtf(b.ssq[tok] * (1.0f / D) + EPS);
#pragma unroll
        for (int j = 0; j < 8; ++j) { const size_t o = (size_t)tok * D + j * 256 + lane * 4; f32x4 v = *(f32x4*)(b.out + o); const f32x4 gg = *(const f32x4*)(b.g_final + j * 256 + lane * 4);
            v.x *= rs * gg.x; v.y *= rs * gg.y; v.z *= rs * gg.z; v.w *= rs * gg.w; *(f32x4*)(b.out + o) = v; }
    }
}
namespace at {
typedef short v4i16 __attribute__((ext_vector_type(4)));
struct Task {
    const h16* qbase;
    const h16* kbase;
    const h16* vbase;
    int dil, rho;
    int ql0;
    int maxdelta;
    float slope2d;
};
__device__ __forceinline__ half8 tr_pair(const LAS unsigned char* p) {
    const v4i16 lo = __builtin_amdgcn_ds_read_tr16_b64_v4i16((LAS v4i16*)p), hi = __builtin_amdgcn_ds_read_tr16_b64_v4i16((LAS v4i16*)(p + 512));
    typedef short s8 __attribute__((ext_vector_type(8)));
    const s8 r = {lo[0], lo[1], lo[2], lo[3], hi[0], hi[1], hi[2], hi[3]};
    return __builtin_bit_cast(half8, r);
}
template <int HD> __device__ __forceinline__ void run_task(const Task& t, LAS unsigned char* vbuf, int lane, float& m_out, float& l_out, f32x16 (&O)[HD / 32]) {
    constexpr int ND0 = HD / 16, NDB = HD / 32, NP = NDB * 2, VB = HD * 64;
    const int r32 = lane & 31, hi = lane >> 5;
    half8 qf[ND0];
    { const h16* qp = t.qbase + (size_t)(t.dil * (t.ql0 + r32) + t.rho) * NIN + hi * 8;
#pragma unroll
      for (int d0 = 0; d0 < ND0; ++d0) qf[d0] = *(const half8*)(qp + 16 * d0); }
    const int j1 = t.ql0 >> 5, j0 = (j1 - 4) > 0 ? (j1 - 4) : 0;
    const h16* kp = t.kbase + (size_t)(t.dil * (32 * j0 + r32) + t.rho) * NIN + hi * 8;
    const h16* vp = t.vbase + (size_t)(t.dil * (32 * j0 + (lane >> 2)) + t.rho) * NIN + (lane & 3) * 8;
    const size_t tile_step = (size_t)32 * t.dil * NIN, ks_step = (size_t)16 * t.dil * NIN;
    const int laneoff = ((lane >> 4) & 1) * 32 + (lane & 3) * 8 + (4 * hi + ((lane & 15) >> 2)) * 64;
#define AT_DMAV(jj, bufb) do { _Pragma("unroll") for (int _p = 0; _p < NP; ++_p) \
        __builtin_amdgcn_global_load_lds((const unsigned*)(vp + (size_t)((jj) - j0) * tile_step + (_p & 1) * ks_step + (_p >> 1) * 32), (LAS unsigned*)(vbuf + (bufb) + _p * 1024), 16, 0, 0); } while (0)
    float m = -1e30f, l = 0.f;
#pragma unroll
    for (int b = 0; b < NDB; ++b)
#pragma unroll
        for (int r = 0; r < 16; ++r) O[b][r] = 0.f;
    half8 kf[ND0];
#pragma unroll
    for (int d0 = 0; d0 < ND0; ++d0) kf[d0] = *(const half8*)(kp + 16 * d0);
    AT_DMAV(j0, 0);
    for (int j = j0; j <= j1; ++j) {
        const int bufb = ((j - j0) & 1) * VB;
        f32x16 S;
#pragma unroll
        for (int r = 0; r < 16; ++r) S[r] = 0.f;
#pragma unroll
        for (int d0 = 0; d0 < ND0; ++d0) S = __builtin_amdgcn_mfma_f32_32x32x16_f16(kf[d0], qf[d0], S, 0, 0, 0);
        asm volatile("" ::: "memory");
        half8 kn[ND0];
        if (j < j1) {
#pragma unroll
            for (int d0 = 0; d0 < ND0; ++d0) kn[d0] = *(const half8*)(kp + (size_t)(j + 1 - j0) * tile_step + 16 * d0);
            AT_DMAV(j + 1, bufb ^ VB);
        } else {
#pragma unroll
            for (int d0 = 0; d0 < ND0; ++d0) kn[d0] = kf[d0];
        }
        asm volatile("" ::: "memory");
        const int dbase = t.ql0 + r32 - 32 * j - 4 * hi;
        float mx = -INFINITY;
#pragma unroll
        for (int r = 0; r < 16; ++r) { const int delta = dbase - ((r & 3) + 8 * (r >> 2)); float v = S[r] - t.slope2d * (float)delta;
            v = (delta >= 0 && delta <= t.maxdelta) ? v : -INFINITY; S[r] = v; mx = fmaxf(mx, v); }
        mx = fmaxf(mx, __shfl_xor(mx, 32));
        const float mn = fmaxf(m, mx), alpha = __builtin_amdgcn_exp2f(m - mn); m = mn;
        float ps = 0.f;
#pragma unroll
        for (int r = 0; r < 16; ++r) { S[r] = __builtin_amdgcn_exp2f(S[r] - mn); ps += S[r]; }
        l = l * alpha + ps;
#pragma unroll
        for (int b = 0; b < NDB; ++b)
#pragma unroll
            for (int r = 0; r < 16; ++r) O[b][r] *= alpha;
        half8 pf[2];
#pragma unroll
        for (int s = 0; s < 2; ++s) { u32x4 w; w.x = g8::pk_h2(S[8 * s + 0], S[8 * s + 1]); w.y = g8::pk_h2(S[8 * s + 2], S[8 * s + 3]); w.z = g8::pk_h2(S[8 * s + 4], S[8 * s + 5]); w.w = g8::pk_h2(S[8 * s + 6], S[8 * s + 7]); pf[s] = __builtin_bit_cast(half8, w); }
        if (j < j1) { if (NP == 8) asm volatile("s_waitcnt vmcnt(16)" ::: "memory"); else asm volatile("s_waitcnt vmcnt(8)" ::: "memory"); }
        else asm volatile("s_waitcnt vmcnt(0)" ::: "memory");
#pragma unroll
        for (int b = 0; b < NDB; ++b)
#pragma unroll
            for (int s = 0; s < 2; ++s) { const half8 vf = tr_pair(vbuf + bufb + b * 2048 + s * 1024 + laneoff); O[b] = __builtin_amdgcn_mfma_f32_32x32x16_f16(vf, pf[s], O[b], 0, 0, 0); }
        asm volatile("s_waitcnt lgkmcnt(0)" ::: "memory");
#pragma unroll
        for (int d0 = 0; d0 < ND0; ++d0) kf[d0] = kn[d0];
    }
#undef AT_DMAV
    l += __shfl_xor(l, 32);
    m_out = m; l_out = l;
}
template <int HD> __device__ __forceinline__ void store_rows(h16* rp, const f32x16 (&O)[HD / 32], float sc, int hi) {
#pragma unroll
    for (int b = 0; b < HD / 32; ++b)
#pragma unroll
        for (int g = 0; g < 4; ++g) { u32x2 w; w.x = g8::pk_h2(O[b][4 * g] * sc, O[b][4 * g + 1] * sc); w.y = g8::pk_h2(O[b][4 * g + 2] * sc, O[b][4 * g + 3] * sc);
            *(u32x2*)(rp + 32 * b + 8 * g + 4 * hi) = w; }
}
__device__ __forceinline__ f32x4 ld4h(const h16* p) { const h16x4 v = *(const h16x4*)p; return (f32x4){(float)v[0], (float)v[1], (float)v[2], (float)v[3]}; }

__device__ __forceinline__ void phase_attn(const Frame& F, const Bufs& b, h16* exo, float* exl) {
    const int lane = F.lane, w = F.wave, r32 = lane & 31, hi = lane >> 5;
    LAS unsigned char* vbuf = F.lds + RING_OFF + w * 16384;
    for (int u = F.vcu; u < BATCH * AH * 4; u += F.G) {
        const int c = u & 3, h = (u >> 2) & 7, bb = u >> 5;
        const h16* base = b.proj + (size_t)bb * SEQ * NIN;
        Task t; t.qbase = base + h * 128; t.kbase = base + 1024 + h * 128; t.vbase = base + 2048 + h * 128; t.maxdelta = 128;
        const float slope2 = exp2f(-(float)(h + 1)) * LOG2E;
        f32x16 O[4]; float m, l;
#pragma unroll 1
        for (int k = w; k < 32; k += 8) {
            const int br = k >> 4, kk = k & 15;
            if (br == 0) { t.dil = 1; t.rho = 0; t.ql0 = 512 * c + 32 * kk; } else { t.dil = 4; t.rho = kk >> 2; t.ql0 = 128 * c + 32 * (kk & 3); }
            t.slope2d = slope2 * (float)t.dil;
            run_task<128>(t, vbuf, lane, m, l, O);
            const int tok = bb * SEQ + t.dil * (t.ql0 + r32) + t.rho;
            store_rows<128>(exo + ((size_t)br * T + tok) * 1024 + h * 128, O, 1.f / l, hi);
            if (hi == 0) exl[((size_t)br * T + tok) * 8 + h] = m + __builtin_amdgcn_logf(l);
        }
        asm volatile("s_waitcnt vmcnt(0)" ::: "memory"); __syncthreads();
#pragma unroll 1
        for (int rho = w; rho < 16; rho += 8) {
            t.dil = 16; t.rho = rho; t.ql0 = 32 * c; t.slope2d = slope2 * 16.f;
            run_task<128>(t, vbuf, lane, m, l, O);
            const int tok = bb * SEQ + 16 * (t.ql0 + r32) + rho;
            const float l3 = m + __builtin_amdgcn_logf(l);
            const float l1 = exl[(size_t)tok * 8 + h], l2 = exl[((size_t)T + tok) * 8 + h];
            const float M = fmaxf(fmaxf(l1, l2), l3);
            const float w1 = __builtin_amdgcn_exp2f(l1 - M), w2 = __builtin_amdgcn_exp2f(l2 - M), w3 = __builtin_amdgcn_exp2f(l3 - M);
            const float inv = 1.f / (w1 + w2 + w3); const float s1 = w1 * inv, s2 = w2 * inv, s3 = w3 * inv / l;
            const h16* e1 = exo + (size_t)tok * 1024 + h * 128; const h16* e2 = exo + ((size_t)T + tok) * 1024 + h * 128;
            h16* op = b.mixed + (size_t)tok * D + h * 128;
#pragma unroll
            for (int bk = 0; bk < 4; ++bk)
#pragma unroll
                for (int g = 0; g < 4; ++g) { const int d = 32 * bk + 8 * g + 4 * hi; const f32x4 a1 = ld4h(e1 + d), a2 = ld4h(e2 + d);
                    u32x2 wv; wv.x = g8::pk_h2(O[bk][4 * g] * s3 + a1[0] * s1 + a2[0] * s2, O[bk][4 * g + 1] * s3 + a1[1] * s1 + a2[1] * s2);
                    wv.y = g8::pk_h2(O[bk][4 * g + 2] * s3 + a1[2] * s1 + a2[2] * s2, O[bk][4 * g + 3] * s3 + a1[3] * s1 + a2[3] * s2);
                    *(u32x2*)(op + d) = wv; }
        }
        asm volatile("s_waitcnt vmcnt(0)" ::: "memory"); __syncthreads();
    }
    for (int u = F.vcu; u < BATCH * BKV * 16; u += F.G) {
        const int qb = u & 15, kv = (u >> 4) & 1, bb = u >> 5; const int hq = kv * 8 + w;
        const h16* base = b.proj + (size_t)bb * SEQ * NIN;
        Task t; t.qbase = base + 3072 + hq * 64; t.kbase = base + 4096 + kv * 64; t.vbase = base + 4224 + kv * 64; t.maxdelta = 127; t.dil = 1; t.rho = 0;
        t.slope2d = exp2f(-0.5f * (float)(hq + 1)) * LOG2E;
        const float sink2 = b.sinks[hq] * LOG2E;
        f32x16 O[2]; float m, l;
#pragma unroll 1
        for (int i = 0; i < 4; ++i) {
            t.ql0 = 128 * qb + 32 * i;
            run_task<64>(t, vbuf, lane, m, l, O);
            const float mf = fmaxf(m, sink2); const float a = __builtin_amdgcn_exp2f(m - mf); const float den = l * a + __builtin_amdgcn_exp2f(sink2 - mf);
            const int tok = bb * SEQ + t.ql0 + r32;
            store_rows<64>(b.mixed + (size_t)tok * D + 1024 + hq * 64, O, a / den, hi);
        }
    }
}
}
constexpr int NPH = 10;
__global__ void __launch_bounds__(NWAVES * 64, 2) mega(Args args) {
    extern __shared__ __attribute__((aligned(16))) unsigned char lds[];
    const Bufs& b = args.b;
    Frame F;
    F.lds = (LAS unsigned char*)lds;
    F.tid = threadIdx.x; F.lane = F.tid & 63; F.wave = __builtin_amdgcn_readfirstlane(F.tid >> 6);
    F.G = gridDim.x; { const int bx = blockIdx.x; F.vcu = (F.G % 8 == 0) ? (bx % 8) * (F.G / 8) + bx / 8 : bx; }
    volatile LAS unsigned* MISC = (volatile LAS unsigned*)(F.lds + MISC_OFF);
    volatile LAS int* tab = (volatile LAS int*)(F.lds + TAB_OFF);
    for (int u = F.tid; u < (LDS_BYTES - LDSCTL_OFF) / 4; u += NWAVES * 64) ((LAS unsigned*)(F.lds + LDSCTL_OFF))[u] = 0u;
    __syncthreads();
    unsigned* ctl = (unsigned*)(b.ws + WS_CTL);
    XcdBarrier bar = xcd_barrier_post(ctl + CW_BAR + args.li * XCD_BAR_WORDS, MISC + 8);
    const int lo = args.ph_lo, hi = args.ph_hi;
#ifdef ONLY_PHASE
#define IN(k) ((k) == ONLY_PHASE && lo <= (k) && (k) < hi)
#else
#define IN(k) (lo <= (k) && (k) < hi)
#endif
#define SEAM(k) do { if (IN(k) && IN((k) + 1)) xcd_barrier(bar); } while (0)
#ifdef PROBE_PHASE
#define PH(k, ...) do { if (IN(k)) { __VA_ARGS__ if ((k) == PROBE_PHASE) { xcd_barrier(bar); __VA_ARGS__ } } SEAM(k); } while (0)
#else
#define PH(k, ...) do { if (IN(k)) { __VA_ARGS__ } SEAM(k); } while (0)
#endif
    G8_LAS unsigned char* ring = F.lds + RING_OFF;

    PH(0, phase_prologue(F, b););
    PH(1,
        { g8::Gemm g{b.x16, b.WinT, D}; g8::StaticOrder S; S.init(T, NIN, F.G, (int)blockIdx.x); g8::EpiProj E{b.proj, b.r1}; g8::gemm_phase<g8::EpiProj, g8::StaticOrder>(ring, g, S, E); }
        { g8::Gemm g{b.p16, b.WpleT, PLE}; g8::StaticOrder S; S.init(T, D, F.G, (int)blockIdx.x); g8::EpiPlain E{b.pw16, D}; g8::gemm_phase<g8::EpiPlain, g8::StaticOrder>(ring, g, S, E); });
    PH(2, at::phase_attn(F, b, (h16*)(b.ws + WS_RD), (float*)(b.ws + WS_LTOK)););
    PH(3, { g8::Gemm g{b.mixed, b.WoutT, D}; g8::StaticOrder S; S.init(T, D, F.G, (int)blockIdx.x); g8::EpiRes E{b.h1, b.x}; g8::gemm_phase<g8::EpiRes, g8::StaticOrder>(ring, g, S, E); });
#if defined(PROBE_PHASE) && PROBE_PHASE == 4
    if (IN(4)) { phase_route(F, b); xcd_barrier(bar); if (blockIdx.x == 0 && F.tid < 32) b.cnt[F.tid] = 0; xcd_barrier(bar); phase_route(F, b); } SEAM(4);
#else
    PH(4, phase_route(F, b););
#endif
    PH(5, { g8::moe_table(tab, b.cnt); LDS_WAIT(); __syncthreads();
        g8::Gemm g{b.h1, b.WguT, D}; g8::MoeUpOrder S{tab, b.ltok, F.G, F.vcu}; g8::EpiMoeUp E{b.hid, b.ltok, b.lw, b.r2}; g8::gemm_phase<g8::EpiMoeUp, g8::MoeUpOrder>(ring, g, S, E); });
    PH(6, { g8::moe_table(tab, b.cnt); LDS_WAIT(); __syncthreads();
        g8::Gemm g{b.hid, b.WdT, DE}; g8::MoeDownOrder S{tab, F.G, F.vcu}; g8::EpiMoeDown E{b.y, b.ltok}; g8::gemm_phase<g8::EpiMoeDown, g8::MoeDownOrder>(ring, g, S, E); });
    PH(7, phase_combine(F, b););
#if defined(PROBE_PHASE) && PROBE_PHASE == 8
    if (IN(8)) { g8::Gemm g{b.h2, b.WpgT, D}; g8::StaticOrder S; S.init(T, D, F.G, (int)blockIdx.x); g8::EpiPle E{b.out, b.h2, b.pw16, b.r3, (float*)(b.ws + WS_R1)}; g8::gemm_phase<g8::EpiPle, g8::StaticOrder>(ring, g, S, E); xcd_barrier(bar); }
#endif
    PH(8, { g8::Gemm g{b.h2, b.WpgT, D}; g8::StaticOrder S; S.init(T, D, F.G, (int)blockIdx.x); g8::EpiPle E{b.out, b.h2, b.pw16, b.r3, b.ssq}; g8::gemm_phase<g8::EpiPle, g8::StaticOrder>(ring, g, S, E); });
    PH(9, phase_final(F, b););
#undef IN
#undef SEAM
#undef PH
}

static int g_grid = 0;
static bool mega_setup() {
    if (g_grid) return g_grid > 0;
    int dev = 0, cus = 0, per_cu = 0;
    if (hipGetDevice(&dev) != hipSuccess || hipDeviceGetAttribute(&cus, hipDeviceAttributeMultiprocessorCount, dev) != hipSuccess) { g_grid = -1; return false; }
    if (hipFuncSetAttribute((const void*)mega, hipFuncAttributeMaxDynamicSharedMemorySize, LDS_BYTES) != hipSuccess) { fprintf(stderr, "hipFuncSetAttribute failed\n"); g_grid = -1; return false; }
    if (hipOccupancyMaxActiveBlocksPerMultiprocessor(&per_cu, (const void*)mega, NWAVES * 64, LDS_BYTES) != hipSuccess || per_cu < 1) { fprintf(stderr, "occupancy query: %d\n", per_cu); (void)hipGetLastError(); g_grid = -1; return false; }
    g_grid = cus;
    return true;
}
static void mega_run(const Bufs& b, int lo, int hi, int li, hipStream_t s) {
    Args a{}; a.b = b; a.ph_lo = lo; a.ph_hi = hi; a.li = li; a.pad = 0;
    hipLaunchKernelGGL(mega, dim3(g_grid), dim3(NWAVES * 64), LDS_BYTES, s, a);
}
extern "C" void kernel_launch(void* const* d_in, const int* in_sizes, int n_in, void* d_out, int out_size, void* d_ws, size_t ws_size, hipStream_t stream) {
    if (n_in != 18 || out_size != T * D || ws_size < WS_END) { fprintf(stderr, "kernel_launch: unexpected shapes: n_in %d out %d ws %zu\n", n_in, out_size, ws_size); return; }
    if (!mega_setup()) return;
    Bufs b = make_bufs(d_in, d_out, d_ws);
    (void)hipMemsetAsync((char*)d_ws + WS_CTL, 0, CTL_ZERO_BYTES, stream);
    mega_run(b, 0, NPH, 0, stream);
}
```

```cpp
#include <hip/hip_runtime.h>
#include <cstdint>
#include <cstdio>
#include <cmath>

typedef _Float16 h16;
typedef _Float16 half8 __attribute__((ext_vector_type(8)));
typedef _Float16 h16x4 __attribute__((ext_vector_type(4)));
typedef _Float16 h16x2 __attribute__((ext_vector_type(2)));
typedef float f32x4 __attribute__((ext_vector_type(4)));
typedef float f32x2 __attribute__((ext_vector_type(2)));
typedef float f32x16 __attribute__((ext_vector_type(16)));
typedef unsigned u32x4 __attribute__((ext_vector_type(4)));
typedef unsigned u32x2 __attribute__((ext_vector_type(2)));
#define UNR _Pragma("unroll")

constexpr int BATCH = 8, SEQ = 2048, T = BATCH * SEQ, D = 2048, PLE = 256;
constexpr int AH = 8, AHD = 128, BH = 16, BHD = 64, BKV = 2, BG = 8;
constexpr int NIN = 4352;
constexpr int NE = 32, DE = 256;
constexpr float EPS = 1e-6f;
constexpr float LOG2E = 1.4426950408889634f;
constexpr float QSCALE_A = 0.08838834764831845f * LOG2E;
constexpr float QSCALE_B = 0.125f * LOG2E;

constexpr size_t MiB = 1u << 20;
constexpr size_t WS_CTL = 0, CTL_ZERO_BYTES = 1 * MiB;
constexpr size_t CTL_CNT = 256 * 1024, CTL_SSQ = 320 * 1024;
constexpr size_t WS_R1 = 1 * MiB, WS_R2 = WS_R1 + 64 * 1024, WS_R3 = WS_R2 + 64 * 1024;
constexpr size_t WS_LTOK = 2 * MiB, WS_LW = 4 * MiB, WS_WR = 6 * MiB, WS_WR16 = 7 * MiB;
constexpr size_t WS_WIN = 8 * MiB, WS_WOUT = 25 * MiB, WS_WGU = 33 * MiB, WS_WD = 97 * MiB, WS_WPLE = 129 * MiB, WS_WPG = 130 * MiB;
constexpr size_t WS_P16 = 138 * MiB, WS_PW16 = 146 * MiB;
constexpr size_t WS_RA = 210 * MiB;
constexpr size_t WS_RB = 274 * MiB;
constexpr size_t WS_RD = 410 * MiB;
constexpr size_t WS_END = 474 * MiB;

namespace nv {

__device__ __forceinline__ float wave_sum(float v) {
#pragma unroll
    for (int o = 1; o < 64; o <<= 1) v += __shfl_xor(v, o);
    return v;
}
__device__ __forceinline__ float wave_max(float v) {
#pragma unroll
    for (int o = 1; o < 64; o <<= 1) v = fmaxf(v, __shfl_xor(v, o));
    return v;
}

__global__ __launch_bounds__(256) void k_prep_x(const float* __restrict__ x, h16* __restrict__ x16, float* __restrict__ r1,
                                                const float* __restrict__ p, h16* __restrict__ p16) {
    const int wid = threadIdx.x >> 6, lane = threadIdx.x & 63;
    const int row = blockIdx.x * 4 + wid;
    if (row >= T) return;
    const float* xr = x + (size_t)row * D;
    float ss = 0.f;
    for (int j = 0; j < D / 256; ++j) {
        const f32x4 v = *(const f32x4*)(xr + j * 256 + lane * 4);
        ss += v.x * v.x + v.y * v.y + v.z * v.z + v.w * v.w;
        h16x4 o = {(h16)v.x, (h16)v.y, (h16)v.z, (h16)v.w};
        *(h16x4*)(x16 + (size_t)row * D + j * 256 + lane * 4) = o;
    }
    ss = wave_sum(ss);
    if (lane == 0) r1[row] = 1.0f / sqrtf(ss * (1.0f / D) + EPS);
    {
        const f32x4 v = *(const f32x4*)(p + (size_t)row * PLE + lane * 4);
        h16x4 o = {(h16)v.x, (h16)v.y, (h16)v.z, (h16)v.w};
        *(h16x4*)(p16 + (size_t)row * PLE + lane * 4) = o;
    }
}

struct TrJob { const float* src; const float* src2; h16* dst; const float* gain; int pitch, K, N, mode; long src_z, dst_z; };
__global__ __launch_bounds__(256) void k_transpose(TrJob j) {
    __shared__ float tile[64][65];
    const int z = blockIdx.z;
    const int k0 = blockIdx.y * 64, n0 = blockIdx.x * 64;
    const int tx = threadIdx.x & 63, ty = threadIdx.x >> 6;
    const float* src = j.src; const float* src2 = j.src2; h16* dst = j.dst + (size_t)z * j.dst_z;
    int pn = 0;
    if (j.mode == 2) { const int e = z >> 1; pn = z & 1; src += (size_t)e * j.src_z; src2 += (size_t)e * j.src_z; }
    else { src += (size_t)z * j.src_z; }
    {
        const int n = n0 + tx;
        const float* s = src; int col = n;
        if (j.mode == 2) { s = (n < 128) ? src : src2; col = 128 * pn + (n & 127); }
        float cs = 1.f;
        if (j.mode == 1) { if (n < 1024) cs = QSCALE_A; else if (n >= 3072 && n < 4096) cs = QSCALE_B; }
        for (int i = 0; i < 16; ++i) {
            const int k = k0 + ty + 4 * i;
            float v = s[(size_t)k * j.pitch + col] * cs;
            if (j.gain) v *= j.gain[k];
            tile[ty + 4 * i][tx] = v;
        }
    }
    __syncthreads();
    for (int i = 0; i < 16; ++i) {
        const int n = n0 + ty + 4 * i;
        dst[(size_t)n * j.K + k0 + tx] = (h16)tile[tx][ty + 4 * i];
    }
}
__global__ void k_router_w(const float* __restrict__ w_grp, const float* __restrict__ w_exp, const float* __restrict__ g, float* __restrict__ Wr) {
    const int idx = blockIdx.x * blockDim.x + threadIdx.x;
    if (idx >= 36 * D) return;
    const int c = idx / D, k = idx % D;
    const float v = (c < 4) ? w_grp[(size_t)k * 4 + c] : w_exp[(size_t)k * 32 + (c - 4)];
    Wr[idx] = v * g[k];
}

template <class Op> __global__ __launch_bounds__(256) void k_gemm(Op op) {
    const int z = blockIdx.z;
    const int M = op.mrows(z);
    const int row0 = blockIdx.y * 128; if (row0 >= M) return;
    const int col0 = blockIdx.x * 128;
    const int wid = threadIdx.x >> 6, lane = threadIdx.x & 63, wy = wid >> 1, wx = wid & 1, fr = lane & 15, fq = lane >> 4;
    f32x4 acc[4][4];
#pragma unroll
    for (int a = 0; a < 4; ++a)
#pragma unroll
        for (int b = 0; b < 4; ++b) acc[a][b] = (f32x4){0.f, 0.f, 0.f, 0.f};
    const h16* ap[4]; const h16* bp[4];
#pragma unroll
    for (int mi = 0; mi < 4; ++mi) ap[mi] = op.arow(z, row0 + wy * 64 + mi * 16 + fr) + fq * 8;
#pragma unroll
    for (int ni = 0; ni < 4; ++ni) bp[ni] = op.brow(z, col0 + wx * 64, ni, fr) + fq * 8;
    for (int k0 = 0; k0 < op.K; k0 += 32) {
        half8 a[4], b[4];
#pragma unroll
        for (int i = 0; i < 4; ++i) { a[i] = *(const half8*)(ap[i] + k0); b[i] = *(const half8*)(bp[i] + k0); }
#pragma unroll
        for (int mi = 0; mi < 4; ++mi)
#pragma unroll
            for (int ni = 0; ni < 4; ++ni) acc[mi][ni] = __builtin_amdgcn_mfma_f32_16x16x32_f16(a[mi], b[ni], acc[mi][ni], 0, 0, 0);
    }
    op.epi(z, row0 + wy * 64, col0 + wx * 64, acc, fr, fq);
}

struct OpBase { int K; };
struct OpG1 : OpBase {
    const h16* A; const h16* Bt; const float* r1; h16* out;
    __device__ int mrows(int) const { return T; }
    __device__ const h16* arow(int, int r) const { return A + (size_t)r * D; }
    __device__ const h16* brow(int, int cb, int ni, int fr) const { return Bt + (size_t)(cb + ni * 16 + fr) * D; }
    __device__ void epi(int, int rb, int cb, f32x4 (&acc)[4][4], int fr, int fq) const {
        UNR for (int mi = 0; mi < 4; ++mi) UNR for (int r = 0; r < 4; ++r) { const int row = rb + mi * 16 + fq * 4 + r; const float s = r1[row];
            UNR for (int ni = 0; ni < 4; ++ni) out[(size_t)row * NIN + cb + ni * 16 + fr] = (h16)(acc[mi][ni][r] * s); }
    }
};
struct OpG3 : OpBase {
    const h16* A; const h16* Bt; const float* x; h16* out;
    __device__ int mrows(int) const { return T; }
    __device__ const h16* arow(int, int r) const { return A + (size_t)r * D; }
    __device__ const h16* brow(int, int cb, int ni, int fr) const { return Bt + (size_t)(cb + ni * 16 + fr) * D; }
    __device__ void epi(int, int rb, int cb, f32x4 (&acc)[4][4], int fr, int fq) const {
        UNR for (int mi = 0; mi < 4; ++mi) UNR for (int r = 0; r < 4; ++r) { const int row = rb + mi * 16 + fq * 4 + r;
            UNR for (int ni = 0; ni < 4; ++ni) { const size_t o = (size_t)row * D + cb + ni * 16 + fr; out[o] = (h16)(x[o] + acc[mi][ni][r]); } }
    }
};
__device__ __forceinline__ void moe_offsets(const int* cnt, int e, int& off, int& n) {
    int o = 0; for (int i = 0; i < e; ++i) o += (cnt[i] + 255) & ~255; off = o; n = cnt[e];
}
struct OpMU : OpBase {
    const h16* A; const h16* Wgu; const int* cnt; const int* ltok; const float* lw; const float* r2; h16* hid;
    __device__ int mrows(int z) const { return cnt[z]; }
    __device__ const h16* arow(int z, int r) const { const int n = cnt[z]; const int tok = (r < n) ? (ltok[(size_t)z * T + r] & 0x3fff) : 0; return A + (size_t)tok * D; }
    __device__ const h16* brow(int z, int cb, int ni, int fr) const {
        const int hc = (cb >> 6) * 32 + (ni & 1) * 16 + fr; const int pn = hc >> 7, i = hc & 127;
        return Wgu + ((size_t)(z * 2 + pn) * 256 + (ni >> 1) * 128 + i) * D;
    }
    __device__ void epi(int z, int rb, int cb, f32x4 (&acc)[4][4], int fr, int fq) const {
        int off, n; moe_offsets(cnt, z, off, n);
        UNR for (int mi = 0; mi < 4; ++mi) UNR for (int r = 0; r < 4; ++r) { const int pos = rb + mi * 16 + fq * 4 + r; if (pos >= n) continue;
            const int tok = ltok[(size_t)z * T + pos] & 0x3fff; const float s = r2[tok], w = lw[(size_t)z * T + pos];
            UNR for (int ni = 0; ni < 2; ++ni) { const float g = acc[mi][ni][r] * s, u = acc[mi][ni + 2][r] * s;
                const float v = g / (1.f + __expf(-g)) * u * w; const int hc = (cb >> 6) * 32 + ni * 16 + fr;
                hid[(size_t)(off + pos) * DE + hc] = (h16)v; } }
    }
};
struct OpMD : OpBase {
    const h16* hid; const h16* Wd; const int* cnt; const int* ltok; h16* y;
    __device__ int mrows(int z) const { return cnt[z]; }
    __device__ const h16* arow(int z, int r) const { int off, n; moe_offsets(cnt, z, off, n); return hid + (size_t)(off + r) * DE; }
    __device__ const h16* brow(int z, int cb, int ni, int fr) const { return Wd + ((size_t)z * D + cb + ni * 16 + fr) * DE; }
    __device__ void epi(int z, int rb, int cb, f32x4 (&acc)[4][4], int fr, int fq) const {
        const int n = cnt[z];
        UNR for (int mi = 0; mi < 4; ++mi) UNR for (int r = 0; r < 4; ++r) { const int pos = rb + mi * 16 + fq * 4 + r; if (pos >= n) continue;
            const int lt = ltok[(size_t)z * T + pos]; const int tok = lt & 0x3fff, slot = (lt >> 30) & 1;
            UNR for (int ni = 0; ni < 4; ++ni) y[((size_t)slot * T + tok) * D + cb + ni * 16 + fr] = (h16)acc[mi][ni][r]; }
    }
};
struct OpPW : OpBase {
    const h16* A; const h16* Bt; h16* out;
    __device__ int mrows(int) const { return T; }
    __device__ const h16* arow(int, int r) const { return A + (size_t)r * PLE; }
    __device__ const h16* brow(int, int cb, int ni, int fr) const { return Bt + (size_t)(cb + ni * 16 + fr) * PLE; }
    __device__ void epi(int, int rb, int cb, f32x4 (&acc)[4][4], int fr, int fq) const {
        UNR for (int mi = 0; mi < 4; ++mi) UNR for (int r = 0; r < 4; ++r) { const int row = rb + mi * 16 + fq * 4 + r;
            UNR for (int ni = 0; ni < 4; ++ni) out[(size_t)row * D + cb + ni * 16 + fr] = (h16)acc[mi][ni][r]; }
    }
};
struct OpG5 : OpBase {
    const h16* A; const h16* Bt; const float* r3; const h16* pw; float* out; float* ssq;
    __device__ int mrows(int) const { return T; }
    __device__ const h16* arow(int, int r) const { return A + (size_t)r * D; }
    __device__ const h16* brow(int, int cb, int ni, int fr) const { return Bt + (size_t)(cb + ni * 16 + fr) * D; }
    __device__ void epi(int, int rb, int cb, f32x4 (&acc)[4][4], int fr, int fq) const {
        UNR for (int mi = 0; mi < 4; ++mi) UNR for (int r = 0; r < 4; ++r) { const int row = rb + mi * 16 + fq * 4 + r; const float s = r3[row]; float q = 0.f;
            UNR for (int ni = 0; ni < 4; ++ni) { const size_t o = (size_t)row * D + cb + ni * 16 + fr; const float g = 1.f / (1.f + __expf(-acc[mi][ni][r] * s));
                const float h3 = (float)A[o] + g * (float)pw[o]; out[o] = h3; q += h3 * h3; }
            q += __shfl_xor(q, 1); q += __shfl_xor(q, 2); q += __shfl_xor(q, 4); q += __shfl_xor(q, 8);
            if (fr == 0) atomicAdd(ssq + row, q); }
    }
};

template <int HD, int NBR, int NJ> __global__ __launch_bounds__(256) void k_attn(const h16* __restrict__ proj, h16* __restrict__ mixed, const float* __restrict__ sinks) {
    constexpr int NH = (NBR == 3) ? AH : BH;
    __shared__ float qs[4][HD];
    __shared__ float sc[4][NBR * NJ + 1];
    const int wid = threadIdx.x >> 6, lane = threadIdx.x & 63;
    const int id = blockIdx.x * 4 + wid;
    const int tok = id / NH, head = id % NH;
    const int b = tok / SEQ, tpos = tok % SEQ;
    int qcol, kcol, vcol, ocol; float slope2, sink2 = -INFINITY;
    if (NBR == 3) { qcol = head * 128; kcol = 1024 + head * 128; vcol = 2048 + head * 128; ocol = head * 128; slope2 = exp2f(-(float)(head + 1)) * LOG2E; }
    else { const int kv = head / BG; qcol = 3072 + head * 64; kcol = 4096 + kv * 64; vcol = 4224 + kv * 64; ocol = 1024 + head * 64;
           slope2 = exp2f(-0.5f * (float)(head + 1)) * LOG2E; sink2 = sinks[head] * LOG2E; }
    const h16* base = proj + (size_t)b * SEQ * NIN;
    for (int d = lane; d < HD; d += 64) qs[wid][d] = (float)base[(size_t)tpos * NIN + qcol + d];
    __syncthreads();
    float mx = -INFINITY;
    for (int i = lane; i < NBR * NJ; i += 64) {
        const int br = i / NJ, j = i % NJ; const int dil = (br == 0) ? 1 : (br == 1 ? 4 : 16);
        const int s = tpos - dil * j; float v = -INFINITY;
        if (s >= 0) { const h16* kr = base + (size_t)s * NIN + kcol; float a = 0.f;
            for (int d = 0; d < HD; d += 8) { const half8 kk = *(const half8*)(kr + d);
#pragma unroll
                for (int e = 0; e < 8; ++e) a += qs[wid][d + e] * (float)kk[e]; }
            v = a - slope2 * (float)(dil * j); }
        sc[wid][i] = v; mx = fmaxf(mx, v);
    }
    mx = wave_max(mx); mx = fmaxf(mx, sink2);
    __syncthreads();
    float sum = 0.f;
    for (int i = lane; i < NBR * NJ; i += 64) { const float pv = exp2f(sc[wid][i] - mx); sc[wid][i] = pv; sum += pv; }
    sum = wave_sum(sum); sum += exp2f(sink2 - mx);
    __syncthreads();
    constexpr int DPL = HD / 64;
    float o[DPL]; UNR for (int e = 0; e < DPL; ++e) o[e] = 0.f;
    for (int i = 0; i < NBR * NJ; ++i) {
        const float pv = sc[wid][i]; if (pv == 0.f) continue;
        const int br = i / NJ, j = i % NJ; const int dil = (br == 0) ? 1 : (br == 1 ? 4 : 16);
        const int s = tpos - dil * j; const h16* vr = base + (size_t)s * NIN + vcol + lane * DPL;
        UNR for (int e = 0; e < DPL; ++e) o[e] += pv * (float)vr[e];
    }
    const float inv = 1.f / sum;
    UNR for (int e = 0; e < DPL; ++e) mixed[(size_t)tok * D + ocol + lane * DPL + e] = (h16)(o[e] * inv);
}

__global__ __launch_bounds__(256) void k_route(const h16* __restrict__ h1, const float* __restrict__ Wr, const float* __restrict__ b_grp, const float* __restrict__ b_exp,
                                               float* __restrict__ r2, int* __restrict__ cnt, int* __restrict__ ltok, float* __restrict__ lw) {
    const int wid = threadIdx.x >> 6, lane = threadIdx.x & 63; const int tok = blockIdx.x * 4 + wid;
    float v[32];
    float ss = 0.f;
    UNR for (int j = 0; j < 4; ++j) { const half8 hv = *(const half8*)(h1 + (size_t)tok * D + j * 512 + lane * 8);
#pragma unroll
        for (int e = 0; e < 8; ++e) { v[j * 8 + e] = (float)hv[e]; ss += v[j * 8 + e] * v[j * 8 + e]; } }
    ss = wave_sum(ss); const float rs = 1.0f / sqrtf(ss * (1.0f / D) + EPS);
    __shared__ float slg[4][40];
    float* lg = slg[wid];
    for (int c = 0; c < 36; ++c) { float a = 0.f;
        UNR for (int j = 0; j < 4; ++j) { const float* w = Wr + (size_t)c * D + j * 512 + lane * 8;
#pragma unroll
            for (int e = 0; e < 8; ++e) a += v[j * 8 + e] * w[e]; }
        a = wave_sum(a); if (lane == 0) lg[c] = a * rs + (c < 4 ? b_grp[c] : b_exp[c - 4]); }
    __builtin_amdgcn_s_waitcnt(0);
    if (lane == 0) {
        r2[tok] = rs;
        int gi = 0; float gm = lg[0]; for (int g = 1; g < 4; ++g) if (lg[g] > gm) { gm = lg[g]; gi = g; }
        float gs = 0.f; for (int g = 0; g < 4; ++g) gs += __expf(lg[g] - gm);
        const float gw = 1.f / gs;
        int i0 = 0; float v0 = lg[4 + gi * 8]; for (int e = 1; e < 8; ++e) if (lg[4 + gi * 8 + e] > v0) { v0 = lg[4 + gi * 8 + e]; i0 = e; }
        int i1 = -1; float v1 = -INFINITY; for (int e = 0; e < 8; ++e) if (e != i0 && lg[4 + gi * 8 + e] > v1) { v1 = lg[4 + gi * 8 + e]; i1 = e; }
        const float e1 = __expf(v1 - v0); const float w0 = gw / (1.f + e1), w1 = gw * e1 / (1.f + e1);
        const int ea = gi * 8 + i0, eb = gi * 8 + i1;
        const int pa = atomicAdd(cnt + ea, 1); ltok[(size_t)ea * T + pa] = tok; lw[(size_t)ea * T + pa] = w0;
        const int pb = atomicAdd(cnt + eb, 1); ltok[(size_t)eb * T + pb] = tok | (1 << 30); lw[(size_t)eb * T + pb] = w1;
    }
}
__global__ __launch_bounds__(256) void k_combine(const h16* __restrict__ h1, const h16* __restrict__ y, h16* __restrict__ h2, float* __restrict__ r3) {
    const int wid = threadIdx.x >> 6, lane = threadIdx.x & 63; const int tok = blockIdx.x * 4 + wid;
    float ss = 0.f;
    UNR for (int j = 0; j < 4; ++j) { const size_t o = (size_t)tok * D + j * 512 + lane * 8;
        const half8 a = *(const half8*)(h1 + o), b = *(const half8*)(y + o), c = *(const half8*)(y + (size_t)T * D + o); half8 r;
#pragma unroll
        for (int e = 0; e < 8; ++e) { const float s = (float)a[e] + (float)b[e] + (float)c[e]; ss += s * s; r[e] = (h16)s; }
        *(half8*)(h2 + o) = r; }
    ss = wave_sum(ss); if (lane == 0) r3[tok] = 1.0f / sqrtf(ss * (1.0f / D) + EPS);
}
__global__ __launch_bounds__(256) void k_final(float* __restrict__ out, const float* __restrict__ ssq, const float* __restrict__ g) {
    const int wid = threadIdx.x >> 6, lane = threadIdx.x & 63; const int tok = blockIdx.x * 4 + wid;
    const float rs = 1.0f / sqrtf(ssq[tok] * (1.0f / D) + EPS);
    for (int j = 0; j < 8; ++j) { const size_t o = (size_t)tok * D + j * 256 + lane * 4; f32x4 v = *(f32x4*)(out + o); const f32x4 gg = *(const f32x4*)(g + j * 256 + lane * 4);
        v.x *= rs * gg.x; v.y *= rs * gg.y; v.z *= rs * gg.z; v.w *= rs * gg.w; *(f32x4*)(out + o) = v; }
}

}
struct Bufs {
    const float *x, *p, *w_in, *w_out, *sinks, *g_mix, *g_moe, *g_ple, *g_final, *w_grp, *b_grp, *w_exp, *b_exp, *w_gate, *w_up, *w_down, *w_ple, *w_pg;
    float* out; unsigned char* ws;
    float *r1, *r2, *r3, *ssq, *lw, *Wr; int *cnt, *ltok; h16* Wr16;
    h16 *WinT, *WoutT, *WguT, *WdT, *WpleT, *WpgT, *p16, *pw16, *x16, *mixed, *hid, *h2, *proj, *y, *h1;
};
static Bufs make_bufs(void* const* d_in, void* d_out, void* d_ws) {
    Bufs b{};
    const float** f = (const float**)d_in;
    b.x = f[0]; b.p = f[1]; b.w_in = f[2]; b.w_out = f[3]; b.sinks = f[4]; b.g_mix = f[5]; b.g_moe = f[6]; b.g_ple = f[7]; b.g_final = f[8];
    b.w_grp = f[9]; b.b_grp = f[10]; b.w_exp = f[11]; b.b_exp = f[12]; b.w_gate = f[13]; b.w_up = f[14]; b.w_down = f[15]; b.w_ple = f[16]; b.w_pg = f[17];
    b.out = (float*)d_out; b.ws = (unsigned char*)d_ws; unsigned char* w = b.ws;
    b.cnt = (int*)(w + WS_CTL + CTL_CNT); b.ssq = (float*)(w + WS_CTL + CTL_SSQ);
    b.r1 = (float*)(w + WS_R1); b.r2 = (float*)(w + WS_R2); b.r3 = (float*)(w + WS_R3);
    b.ltok = (int*)(w + WS_LTOK); b.lw = (float*)(w + WS_LW); b.Wr = (float*)(w + WS_WR); b.Wr16 = (h16*)(w + WS_WR16);
    b.WinT = (h16*)(w + WS_WIN); b.WoutT = (h16*)(w + WS_WOUT); b.WguT = (h16*)(w + WS_WGU); b.WdT = (h16*)(w + WS_WD); b.WpleT = (h16*)(w + WS_WPLE); b.WpgT = (h16*)(w + WS_WPG);
    b.p16 = (h16*)(w + WS_P16); b.pw16 = (h16*)(w + WS_PW16);
    b.x16 = (h16*)(w + WS_RA); b.mixed = b.x16; b.hid = b.x16; b.h2 = b.x16;
    b.proj = (h16*)(w + WS_RB); b.y = b.proj; b.h1 = (h16*)(w + WS_RD);
    return b;
}
static void naive_prep(const Bufs& b, hipStream_t s) {
    nv::k_prep_x<<<T / 4, 256, 0, s>>>(b.x, b.x16, b.r1, b.p, b.p16);
    { nv::TrJob j{b.w_in, nullptr, b.WinT, b.g_mix, NIN, D, NIN, 1, 0, 0}; nv::k_transpose<<<dim3(NIN / 64, D / 64, 1), 256, 0, s>>>(j); }
    { nv::TrJob j{b.w_out, nullptr, b.WoutT, nullptr, D, D, D, 0, 0, 0}; nv::k_transpose<<<dim3(D / 64, D / 64, 1), 256, 0, s>>>(j); }
    { nv::TrJob j{b.w_gate, b.w_up, b.WguT, b.g_moe, DE, D, 256, 2, (long)D * DE, (long)256 * D}; nv::k_transpose<<<dim3(256 / 64, D / 64, NE * 2), 256, 0, s>>>(j); }
    { nv::TrJob j{b.w_down, nullptr, b.WdT, nullptr, D, DE, D, 0, (long)DE * D, (long)D * DE}; nv::k_transpose<<<dim3(D / 64, DE / 64, NE), 256, 0, s>>>(j); }
    { nv::TrJob j{b.w_ple, nullptr, b.WpleT, nullptr, D, PLE, D, 0, 0, 0}; nv::k_transpose<<<dim3(D / 64, PLE / 64, 1), 256, 0, s>>>(j); }
    { nv::TrJob j{b.w_pg, nullptr, b.WpgT, b.g_ple, D, D, D, 0, 0, 0}; nv::k_transpose<<<dim3(D / 64, D / 64, 1), 256, 0, s>>>(j); }
    nv::k_router_w<<<(36 * D + 255) / 256, 256, 0, s>>>(b.w_grp, b.w_exp, b.g_moe, b.Wr);
}
static void naive_gemm1(const Bufs& b, hipStream_t s) { nv::OpG1 o; o.K = D; o.A = b.x16; o.Bt = b.WinT; o.r1 = b.r1; o.out = b.proj; nv::k_gemm<<<dim3(NIN / 128, T / 128, 1), 256, 0, s>>>(o); }
static void naive_pw(const Bufs& b, hipStream_t s) { nv::OpPW o; o.K = PLE; o.A = b.p16; o.Bt = b.WpleT; o.out = b.pw16; nv::k_gemm<<<dim3(D / 128, T / 128, 1), 256, 0, s>>>(o); }
static void naive_attn(const Bufs& b, hipStream_t s) {
    nv::k_attn<128, 3, 129><<<T * AH / 4, 256, 0, s>>>(b.proj, b.mixed, b.sinks);
    nv::k_attn<64, 1, 128><<<T * BH / 4, 256, 0, s>>>(b.proj, b.mixed, b.sinks);
}
static void naive_gemm3(const Bufs& b, hipStream_t s) { nv::OpG3 o; o.K = D; o.A = b.mixed; o.Bt = b.WoutT; o.x = b.x; o.out = b.h1; nv::k_gemm<<<dim3(D / 128, T / 128, 1), 256, 0, s>>>(o); }
static void naive_route(const Bufs& b, hipStream_t s) { nv::k_route<<<T / 4, 256, 0, s>>>(b.h1, b.Wr, b.b_grp, b.b_exp, b.r2, b.cnt, b.ltok, b.lw); }
static void naive_moe_up(const Bufs& b, hipStream_t s) { nv::OpMU o; o.K = D; o.A = b.h1; o.Wgu = b.WguT; o.cnt = b.cnt; o.ltok = b.ltok; o.lw = b.lw; o.r2 = b.r2; o.hid = b.hid;
    nv::k_gemm<<<dim3(512 / 128, T / 128, NE), 256, 0, s>>>(o); }
static void naive_moe_down(const Bufs& b, hipStream_t s) { nv::OpMD o; o.K = DE; o.hid = b.hid; o.Wd = b.WdT; o.cnt = b.cnt; o.ltok = b.ltok; o.y = b.y;
    nv::k_gemm<<<dim3(D / 128, T / 128, NE), 256, 0, s>>>(o); }
static void naive_combine(const Bufs& b, hipStream_t s) { nv::k_combine<<<T / 4, 256, 0, s>>>(b.h1, b.y, b.h2, b.r3); }
static void naive_gemm5(const Bufs& b, hipStream_t s) { nv::OpG5 o; o.K = D; o.A = b.h2; o.Bt = b.WpgT; o.r3 = b.r3; o.pw = b.pw16; o.out = b.out; o.ssq = b.ssq;
    nv::k_gemm<<<dim3(D / 128, T / 128, 1), 256, 0, s>>>(o); }
static void naive_final(const Bufs& b, hipStream_t s) { nv::k_final<<<T / 4, 256, 0, s>>>(b.out, b.ssq, b.g_final); }
namespace g8 {
#define G8_LAS __attribute__((address_space(3)))
constexpr int BM = 256, BK = 64, HALF = 128, HTB = HALF * BK * 2  , STAGE_BYTES = 8 * HTB, NXCD = 8, WGM = 8;

__host__ __device__ __forceinline__ int lds_byte(int r, int c) { const int st = (r >> 4) * 2 + (c >> 5), rr = r & 15, cc = c & 31, ob = rr * 64 + cc * 2; return st * 1024 + (ob ^ (((ob >> 9) & 1) << 5)); }
__host__ __device__ __forceinline__ void stage_rc(int b, int& R, int& C) { const int st = b / 1024, sb = b % 1024, swz = sb ^ (((sb >> 9) & 1) << 5); R = (st >> 1) * 16 + swz / 64; C = (st & 1) * 32 + (swz % 64) / 2; }
__host__ __device__ __forceinline__ int perm32(int rho) { const int n = rho >> 4, i = rho & 15; return 8 * (i >> 2) + 4 * n + (i & 3); }

struct Unit { int pm, pn, a0, a1, a2, a3; };
struct Gemm { const h16* A; const h16* Bt; int K; };

struct StaticOrder {
    int nM, nN, nwg, G, c;
    __device__ void init(int M, int N, int G_, int c_) { nM = M / BM; nN = N / BM; nwg = nM * nN; G = G_; c = c_; }
    __device__ bool next(int i, Unit& u) const {
        const long L = (long)i * G + c; if (L >= nwg) return false;
        int wgid = (int)L; { const int q = nwg / NXCD, r = nwg % NXCD, xcd = wgid % NXCD, off = wgid / NXCD; wgid = (xcd < r ? xcd * (q + 1) : r * (q + 1) + (xcd - r) * q) + off; }
        const int nig = WGM * nN, gid = wgid / nig, fm = gid * WGM, gsz = (nM - fm) < WGM ? (nM - fm) : WGM;
        u.pm = fm + ((wgid % nig) % gsz); u.pn = (wgid % nig) / gsz; u.a0 = u.a1 = u.a2 = u.a3 = 0; return true;
    }
    __device__ __forceinline__ unsigned arow(const Unit& u, int r) const { return (unsigned)(u.pm * BM + r); }
};

__device__ __forceinline__ unsigned pk_h2(float lo, float hi) { f32x2 v = {lo, hi}; return __builtin_bit_cast(unsigned, __builtin_convertvector(v, h16x2)); }

template <class Epi, class Sched, bool ALIGN_EPI = true>
__device__ __forceinline__ void gemm_phase(G8_LAS unsigned char* lds, const Gemm g, const Sched& S, const Epi& E) {
    const int tid = threadIdx.x, wid = __builtin_amdgcn_readfirstlane(tid >> 6), lane = tid & 63, wr = wid >> 2, wc = wid & 3, fr = lane & 15, fq = lane >> 4;
    const int K = g.K, nt = K / BK;
    unsigned voffB[2];
#pragma unroll
    for (int i = 0; i < 2; ++i) { int R, C; stage_rc(tid * 16 + i * 8192, R, C); const int Rb = Epi::PERM ? ((R & ~31) + perm32(R & 31)) : R; voffB[i] = (unsigned)(Rb * K + C) * 2u; }
    const unsigned pitch = (unsigned)K * 2u;
    const size_t kstep = (size_t)(BK * 2);
    const size_t hstep = (size_t)HALF * K * 2;
    const size_t tstep = 2 * hstep;
    const unsigned ldsw = (unsigned)wid * 1024u;
    const int aoff = lds_byte(wr * 64 + fr, fq * 8), boff = lds_byte(wc * 32 + fr, fq * 8);
#define G8_SA(b, h) (((b) * 2 + (h)) * HTB)
#define G8_SB(b, h) ((4 + (b) * 2 + (h)) * HTB)
#define G8_STAGE(bufoff, gbase, voff) do { _Pragma("unroll") for (int _i = 0; _i < 2; ++_i) \
        __builtin_amdgcn_global_load_lds((const unsigned*)((const char*)(gbase) + (voff)[_i]), (G8_LAS unsigned*)(lds + (bufoff) + ldsw + _i * 8192), 16, 0, 0); } while (0)
#define G8_LDA(dst, b, h) do { _Pragma("unroll") for (int m = 0; m < 4; ++m) _Pragma("unroll") for (int k = 0; k < 2; ++k) dst[m][k] = *(const G8_LAS half8*)(lds + G8_SA(b, h) + aoff + m * 2048 + k * 1024); } while (0)
#define G8_LDB(dst, b, h) do { _Pragma("unroll") for (int n = 0; n < 2; ++n) _Pragma("unroll") for (int k = 0; k < 2; ++k) dst[n][k] = *(const G8_LAS half8*)(lds + G8_SB(b, h) + boff + n * 2048 + k * 1024); } while (0)
#define G8_MMA(ai, bj, At, Bt) do { __builtin_amdgcn_s_setprio(1); _Pragma("unroll") for (int m = 0; m < 4; ++m) _Pragma("unroll") for (int n = 0; n < 2; ++n) _Pragma("unroll") for (int k = 0; k < 2; ++k) \
        acc[ai][bj][m][n] = __builtin_amdgcn_mfma_f32_16x16x32_f16(Bt[n][k], At[m][k], acc[ai][bj][m][n], 0, 0, 0); __builtin_amdgcn_s_setprio(0); } while (0)
#define G8_WAIT_V(n) asm volatile("s_waitcnt vmcnt(" #n ")" ::: "memory")
#define G8_WAIT_L(n) asm volatile("s_waitcnt lgkmcnt(" #n ")" ::: "memory")
#define G8_BAR __builtin_amdgcn_s_barrier()
#define G8_SCHED __builtin_amdgcn_sched_barrier(0)
#define G8_SETVO(dst, u) do { int _t = tid; asm volatile("" : "+v"(_t)); _Pragma("unroll") for (int _i = 0; _i < 2; ++_i) { int _R, _C; stage_rc(_t * 16 + _i * 8192, _R, _C); \
        _Pragma("unroll") for (int _h = 0; _h < 2; ++_h) dst[_h][_i] = S.arow(u, _h * HALF + _R) * pitch + (unsigned)_C * 2u; } } while (0)
    Unit cur, nxt; int ui = 0;
    if (!S.next(0, cur)) return;
    f32x4 acc[2][2][4][2];
#pragma unroll
    for (int a = 0; a < 2; ++a)
#pragma unroll
        for (int b = 0; b < 2; ++b)
#pragma unroll
            for (int m = 0; m < 4; ++m)
#pragma unroll
                for (int n = 0; n < 2; ++n) acc[a][b][m][n] = (f32x4){0.f, 0.f, 0.f, 0.f};
    half8 At[4][2], B0[2][2], B1[2][2];
    unsigned cv[2][2], nv[2][2];
    G8_SETVO(cv, cur);
    const char* const gA = (const char*)g.A;
    const char* cB = (const char*)g.Bt + (size_t)cur.pn * tstep;
    G8_STAGE(G8_SB(0, 0), cB, voffB); G8_STAGE(G8_SB(0, 1), cB + hstep, voffB); G8_STAGE(G8_SA(0, 0), gA, cv[0]); G8_STAGE(G8_SA(0, 1), gA, cv[1]);
    if (wr == 1) G8_BAR;
    G8_WAIT_V(2); G8_BAR;
    G8_STAGE(G8_SB(1, 0), cB + kstep, voffB); G8_STAGE(G8_SA(1, 0), gA + kstep, cv[0]); G8_STAGE(G8_SB(1, 1), cB + hstep + kstep, voffB);
    G8_WAIT_V(6); G8_BAR;
    for (;;) {
        const bool has_next = S.next(ui + 1, nxt);
        if (has_next) { G8_SETVO(nv, nxt); } else {
#pragma unroll
            for (int _h = 0; _h < 2; ++_h)
#pragma unroll
                for (int _i = 0; _i < 2; ++_i) nv[_h][_i] = cv[_h][_i]; }
        const char* nB = has_next ? (const char*)g.Bt + (size_t)nxt.pn * tstep : cB;
#pragma nounroll
        for (int t = 0; t < nt; t += 2) {
            const bool last = (t == nt - 2);
            const char* a1 = gA + (size_t)(t + 1) * kstep;
            const char* a2 = last ? gA : gA + (size_t)(t + 2) * kstep; const char* b2 = last ? nB : cB + (size_t)(t + 2) * kstep;
            const char* a3 = a2 + kstep; const char* b3 = b2 + kstep;
            unsigned v20[2], v21[2];
#pragma unroll
            for (int _i = 0; _i < 2; ++_i) { v20[_i] = last ? nv[0][_i] : cv[0][_i]; v21[_i] = last ? nv[1][_i] : cv[1][_i]; }
            G8_LDB(B0, 0, 0); G8_LDB(B1, 0, 1); G8_SCHED; G8_LDA(At, 0, 0); G8_STAGE(G8_SA(1, 1), a1, cv[1]);
            G8_WAIT_V(8); G8_WAIT_L(0); G8_BAR; G8_MMA(0, 0, At, B0); G8_MMA(0, 1, At, B1); G8_BAR; G8_SCHED;
            G8_LDA(At, 0, 1); G8_STAGE(G8_SB(0, 0), b2, voffB); G8_STAGE(G8_SB(0, 1), b2 + hstep, voffB); G8_STAGE(G8_SA(0, 0), a2, v20);
            G8_WAIT_V(8); G8_WAIT_L(0); G8_BAR; G8_MMA(1, 0, At, B0); G8_MMA(1, 1, At, B1); G8_BAR; G8_SCHED;
            G8_LDB(B0, 1, 0); G8_LDB(B1, 1, 1); G8_SCHED; G8_LDA(At, 1, 0); G8_STAGE(G8_SA(0, 1), a2, v21);
            G8_WAIT_V(8); G8_WAIT_L(0); G8_BAR; G8_MMA(0, 0, At, B0); G8_MMA(0, 1, At, B1); G8_BAR; G8_SCHED;
            G8_LDA(At, 1, 1); G8_STAGE(G8_SB(1, 0), b3, voffB); G8_STAGE(G8_SB(1, 1), b3 + hstep, voffB); G8_STAGE(G8_SA(1, 0), a3, v20);
            G8_WAIT_V(8); G8_WAIT_L(0); G8_BAR; G8_MMA(1, 0, At, B0); G8_MMA(1, 1, At, B1); G8_BAR; G8_SCHED;
        }
        if constexpr (ALIGN_EPI) { if (wr == 0) G8_BAR; }
        E(acc, cur, wr, wc, fr, fq);
        if (!has_next) break;
#pragma unroll
        for (int a = 0; a < 2; ++a)
#pragma unroll
            for (int b = 0; b < 2; ++b)
#pragma unroll
                for (int m = 0; m < 4; ++m)
#pragma unroll
                    for (int n = 0; n < 2; ++n) acc[a][b][m][n] = (f32x4){0.f, 0.f, 0.f, 0.f};
        cur = nxt; cB = nB; ++ui;
#pragma unroll
        for (int _h = 0; _h < 2; ++_h)
#pragma unroll
            for (int _i = 0; _i < 2; ++_i) cv[_h][_i] = nv[_h][_i];
        if constexpr (ALIGN_EPI) { if (wr == 1) G8_BAR; }
    }
    G8_WAIT_V(0);
    if constexpr (!ALIGN_EPI) { if (wr == 0) G8_BAR; }
    G8_BAR;
#undef G8_SA
#undef G8_SB
#undef G8_STAGE
#undef G8_LDA
#undef G8_LDB
#undef G8_MMA
#undef G8_WAIT_V
#undef G8_WAIT_L
#undef G8_BAR
#undef G8_SCHED
#undef G8_SETVO
}
}
namespace g8 {
#define EPI_ROWS UNR for (int ai = 0; ai < 2; ++ai) UNR for (int m = 0; m < 4; ++m)
#define EPI_FENCE asm volatile("" ::: "memory")
#define RFL(x) __builtin_amdgcn_readfirstlane(x)

struct EpiProj {
    static constexpr bool PERM = true;
    h16* out; const float* r1;
    __device__ __forceinline__ void operator()(const f32x4 (&acc)[2][2][4][2], const Unit& u, int wr, int wc, int fr, int fq) const {
        const int row0 = u.pm * BM + wr * 64 + fr, col0 = u.pn * BM + wc * 32 + 8 * fq;
        EPI_ROWS { const int row = row0 + ai * HALF + m * 16; const float s = r1[row]; h16* rp = out + (size_t)row * NIN + col0;
            UNR for (int bj = 0; bj < 2; ++bj) { const f32x4 v0 = acc[ai][bj][m][0] * s, v1 = acc[ai][bj][m][1] * s;
                u32x4 w; w.x = pk_h2(v0[0], v0[1]); w.y = pk_h2(v0[2], v0[3]); w.z = pk_h2(v1[0], v1[1]); w.w = pk_h2(v1[2], v1[3]); *(u32x4*)(rp + bj * HALF) = w; } EPI_FENCE; }
    }
};
struct EpiPlain {
    static constexpr bool PERM = true;
    h16* out; int ldc;
    __device__ __forceinline__ void operator()(const f32x4 (&acc)[2][2][4][2], const Unit& u, int wr, int wc, int fr, int fq) const {
        const int row0 = u.pm * BM + wr * 64 + fr, col0 = u.pn * BM + wc * 32 + 8 * fq;
        EPI_ROWS { const int row = row0 + ai * HALF + m * 16; h16* rp = out + (size_t)row * ldc + col0;
            UNR for (int bj = 0; bj < 2; ++bj) { const f32x4 v0 = acc[ai][bj][m][0], v1 = acc[ai][bj][m][1];
                u32x4 w; w.x = pk_h2(v0[0], v0[1]); w.y = pk_h2(v0[2], v0[3]); w.z = pk_h2(v1[0], v1[1]); w.w = pk_h2(v1[2], v1[3]); *(u32x4*)(rp + bj * HALF) = w; } EPI_FENCE; }
    }
};
struct EpiRes {
    static constexpr bool PERM = true;
    h16* out; const float* x;
    __device__ __forceinline__ void operator()(const f32x4 (&acc)[2][2][4][2], const Unit& u, int wr, int wc, int fr, int fq) const {
        const int row0 = u.pm * BM + wr * 64 + fr, col0 = u.pn * BM + wc * 32 + 8 * fq;
        EPI_ROWS { const int row = row0 + ai * HALF + m * 16; const size_t o = (size_t)row * D + col0;
            UNR for (int bj = 0; bj < 2; ++bj) { const f32x4 x0 = *(const f32x4*)(x + o + bj * HALF), x1 = *(const f32x4*)(x + o + bj * HALF + 4);
                const f32x4 v0 = acc[ai][bj][m][0] + x0, v1 = acc[ai][bj][m][1] + x1;
                u32x4 w; w.x = pk_h2(v0[0], v0[1]); w.y = pk_h2(v0[2], v0[3]); w.z = pk_h2(v1[0], v1[1]); w.w = pk_h2(v1[2], v1[3]); *(u32x4*)(out + o + bj * HALF) = w; } EPI_FENCE; }
    }
};
struct EpiMoeUp {
    static constexpr bool PERM = true;
    h16* hid; const int* ltok; const float* lw; const float* r2;
    __device__ __forceinline__ void operator()(const f32x4 (&acc)[2][2][4][2], const Unit& u, int wr, int wc, int fr, int fq) const {
        const int e = u.a0, hc0 = (u.pn & 1) * 128 + wc * 32 + 8 * fq;
        EPI_ROWS { const int rr = ai * HALF + wr * 64 + m * 16 + fr; if (rr < u.a1) {
            const size_t li = (size_t)e * T + u.a3 + rr; const int tok = ltok[li] & 0x3fff; const float s = r2[tok], w = lw[li];
            float hv[8];
            UNR for (int n = 0; n < 2; ++n) UNR for (int j = 0; j < 4; ++j) { const float gt = acc[ai][0][m][n][j] * s, up = acc[ai][1][m][n][j] * s;
                hv[n * 4 + j] = gt / (1.f + __expf(-gt)) * up * w; }
            u32x4 o; o.x = pk_h2(hv[0], hv[1]); o.y = pk_h2(hv[2], hv[3]); o.z = pk_h2(hv[4], hv[5]); o.w = pk_h2(hv[6], hv[7]);
            *(u32x4*)(hid + (size_t)(u.a2 + rr) * DE + hc0) = o; } EPI_FENCE; }
    }
};
struct EpiMoeDown {
    static constexpr bool PERM = true;
    h16* y; const int* ltok;
    __device__ __forceinline__ void operator()(const f32x4 (&acc)[2][2][4][2], const Unit& u, int wr, int wc, int fr, int fq) const {
        const int e = u.a0, col0 = u.a2 * BM + wc * 32 + 8 * fq;
        EPI_ROWS { const int rr = ai * HALF + wr * 64 + m * 16 + fr; if (rr < u.a1) {
            const int lt = ltok[(size_t)e * T + u.a3 + rr]; const int tok = lt & 0x3fff, slot = (lt >> 30) & 1; h16* rp = y + ((size_t)slot * T + tok) * D + col0;
            UNR for (int bj = 0; bj < 2; ++bj) { const f32x4 v0 = acc[ai][bj][m][0], v1 = acc[ai][bj][m][1];
                u32x4 w; w.x = pk_h2(v0[0], v0[1]); w.y = pk_h2(v0[2], v0[3]); w.z = pk_h2(v1[0], v1[1]); w.w = pk_h2(v1[2], v1[3]); *(u32x4*)(rp + bj * HALF) = w; } } EPI_FENCE; }
    }
};
struct EpiPle {
    static constexpr bool PERM = true;
    float* out; const h16* h2; const h16* pw; const float* r3; float* ssq;
    __device__ __forceinline__ void operator()(const f32x4 (&acc)[2][2][4][2], const Unit& u, int wr, int wc, int fr, int fq) const {
        const int row0 = u.pm * BM + wr * 64 + fr, col0 = u.pn * BM + wc * 32 + 8 * fq;
        EPI_ROWS { const int row = row0 + ai * HALF + m * 16; const float s = r3[row]; const size_t o = (size_t)row * D + col0; float q = 0.f;
            UNR for (int bj = 0; bj < 2; ++bj) { const half8 hh = *(const half8*)(h2 + o + bj * HALF), pp = *(const half8*)(pw + o + bj * HALF); f32x4 r0, r1v;
                UNR for (int j = 0; j < 4; ++j) { const float g0 = 1.f / (1.f + __expf(-acc[ai][bj][m][0][j] * s)), g1 = 1.f / (1.f + __expf(-acc[ai][bj][m][1][j] * s));
                    r0[j] = (float)hh[j] + g0 * (float)pp[j]; r1v[j] = (float)hh[4 + j] + g1 * (float)pp[4 + j]; q += r0[j] * r0[j] + r1v[j] * r1v[j]; }
                *(f32x4*)(out + o + bj * HALF) = r0; *(f32x4*)(out + o + bj * HALF + 4) = r1v; }
            q += __shfl_xor(q, 16); q += __shfl_xor(q, 32);
            if (fq == 0) atomicAdd(ssq + row, q); EPI_FENCE; }
    }
};

__device__ __forceinline__ void moe_table(volatile G8_LAS int* tab, const int* cnt) {
    if (threadIdx.x == 0) { int o = 0; for (int e = 0; e < NE; ++e) { tab[e] = o; tab[64 + e] = cnt[e]; o += (cnt[e] + 255) >> 8; } tab[32] = o; }
}
struct MoeUpOrder {
    const volatile G8_LAS int* tab; const int* ltok; int G, v;
    __device__ bool next(int i, Unit& u) const {
        const int L = i * G + v; const int total = RFL(tab[32]); if (L >= 2 * total) return false;
        int e = 0; UNR for (int k = 1; k < NE; ++k) e = (L >= 2 * tab[k]) ? k : e;
        const int base = tab[e], nte = tab[e + 1] - base, l = L - 2 * base, pn = l / nte, rt = l - pn * nte;
        u.pm = RFL(rt); u.pn = RFL(e * 2 + pn); u.a0 = RFL(e); u.a1 = RFL(tab[64 + e] - rt * 256); u.a2 = RFL((base + rt) * 256); u.a3 = RFL(rt * 256); return true;
    }
    __device__ __forceinline__ unsigned arow(const Unit& u, int r) const { return (r < u.a1) ? (unsigned)(ltok[(size_t)u.a0 * T + u.a3 + r] & 0x3fff) : 0u; }
};
struct MoeDownOrder {
    const volatile G8_LAS int* tab; int G, v;
    __device__ bool next(int i, Unit& u) const {
        const int L = i * G + v; const int total = RFL(tab[32]); if (L >= 8 * total) return false;
        const int gt = L >> 3, pn = L & 7;
        int e = 0; UNR for (int k = 1; k < NE; ++k) e = (gt >= tab[k]) ? k : e;
        const int rt = gt - tab[e];
        u.pm = RFL(gt); u.pn = RFL(e * 8 + pn); u.a0 = RFL(e); u.a1 = RFL(tab[64 + e] - rt * 256); u.a2 = RFL(pn); u.a3 = RFL(rt * 256); return true;
    }
    __device__ __forceinline__ unsigned arow(const Unit& u, int r) const { return (unsigned)(u.pm * BM + r); }
};
}
constexpr int NWAVES = 8;
constexpr int RING_OFF = 0, RING_BYTES = 131072;
constexpr int LDSCTL_OFF = RING_BYTES, MISC_OFF = LDSCTL_OFF, TAB_OFF = LDSCTL_OFF + 512;
constexpr int LDS_BYTES = 147456;
constexpr int CW_TMO = 0, CW_CODE = 1, CW_BAR = 4096;

#define GAS __attribute__((address_space(1)))
#define LAS __attribute__((address_space(3)))
typedef GAS unsigned gu32;
#define RLX_AGENT __ATOMIC_RELAXED, __HIP_MEMORY_SCOPE_AGENT
#define LDS_WAIT() asm volatile("s_waitcnt lgkmcnt(0)" ::: "memory")
#define VM_WAIT() asm volatile("s_waitcnt vmcnt(0)" ::: "memory")

#define XB_TMO      128
#define XB_XCNT(j)  (256  + 64 * (j))
#define XB_XSUB(j)  (1280 + 64 * (j))
#define XB_XGEN(j)  (2304 + 64 * (j))
#define XB_TOP      3328
#define XB_TOPGEN   3392
#define XCD_BAR_WORDS 3456
#define XB_SPIN_CAP (1u << 18)
__device__ __forceinline__ unsigned xb_ld(unsigned* p)              { return __hip_atomic_load(p, __ATOMIC_RELAXED, __HIP_MEMORY_SCOPE_AGENT); }
__device__ __forceinline__ unsigned xb_add(unsigned* p, unsigned v) { return __hip_atomic_fetch_add(p, v, __ATOMIC_RELAXED, __HIP_MEMORY_SCOPE_AGENT); }
__device__ __forceinline__ unsigned xb_xcc_id() { return (unsigned)__builtin_amdgcn_s_getreg((3 << 11) | 20) & 0xFu; }
#define XB_SPIN(cond, bar) do { unsigned _sp = 0; while (cond) { __builtin_amdgcn_s_sleep(1); \
    if ((++_sp & 255u) == 0u) { if (xb_ld(&(bar)[XB_TMO])) break; if (_sp > XB_SPIN_CAP) { atomicAdd(&(bar)[XB_TMO], 1u); break; } } } } while (0)
struct XcdBarrier { unsigned* bar; unsigned x; volatile LAS unsigned* st; };
__device__ __forceinline__ XcdBarrier xcd_barrier_post(unsigned* bar, volatile LAS unsigned* st) {
    XcdBarrier b; b.bar = bar; b.x = xb_xcc_id(); b.st = st;
    if (threadIdx.x == 0) (void)xb_add(&bar[XB_XCNT(b.x)], 1u);
    return b;
}
__device__ __forceinline__ void xcd_barrier_complete(unsigned* bar, unsigned x, unsigned& nloc, unsigned& nx) {
    const unsigned G = gridDim.x * gridDim.y * gridDim.z;
    unsigned sum, cnt, mine, sp = 0u;
    for (;;) {
        sum = 0u; cnt = 0u; mine = 0u;
#pragma unroll
        for (unsigned j = 0; j < 16; ++j) { const unsigned c = xb_ld(&bar[XB_XCNT(j)]); sum += c; cnt += (c > 0u) ? 1u : 0u; mine = (j == x) ? c : mine; }
        if (sum == G) break;
        __builtin_amdgcn_s_sleep(1);
        if ((++sp & 255u) == 0u) { if (xb_ld(&bar[XB_TMO])) break; if (sp > XB_SPIN_CAP) { atomicAdd(&bar[XB_TMO], 1u); break; } }
    }
    nloc = mine > 0u ? mine : 1u; nx = cnt > 0u ? cnt : 1u;
}
__device__ __forceinline__ void xcd_barrier(const XcdBarrier& b) {
    asm volatile("s_waitcnt vmcnt(0)" ::: "memory");
    __syncthreads();
    if (threadIdx.x == 0) {
        unsigned* bar = b.bar;
        __builtin_amdgcn_s_waitcnt(0);
        unsigned nloc = b.st[0], nx = b.st[1];
        if (nloc == 0u) { xcd_barrier_complete(bar, b.x, nloc, nx); b.st[0] = nloc; b.st[1] = nx; }
        const unsigned old = xb_add(&bar[XB_XSUB(b.x)], 1u);
        const unsigned gen = old / nloc;
        if (old + 1u == (gen + 1u) * nloc) {
            __builtin_amdgcn_fence(__ATOMIC_RELEASE, "agent");
            asm volatile("s_waitcnt vmcnt(0)" ::: "memory");
            const unsigned og = xb_add(&bar[XB_TOP], 1u);
            const unsigned tg = og / nx;
            if (og + 1u == (tg + 1u) * nx) xb_add(&bar[XB_TOPGEN], 1u);
            else XB_SPIN(xb_ld(&bar[XB_TOPGEN]) == tg, bar);
            __builtin_amdgcn_fence(__ATOMIC_ACQUIRE, "agent");
            xb_add(&bar[XB_XGEN(b.x)], 1u);
            asm volatile("s_waitcnt vmcnt(0)" ::: "memory");
        } else {
            XB_SPIN(xb_ld(&bar[XB_XGEN(b.x)]) == gen, bar);
            __builtin_amdgcn_fence(__ATOMIC_ACQUIRE, "agent");
            asm volatile("s_waitcnt vmcnt(0)" ::: "memory");
        }
    }
    __syncthreads();
}

struct Args { Bufs b; int ph_lo, ph_hi, li, pad; };

struct Frame {
    LAS unsigned char* lds;
    int tid, lane, wave, vcu, G;
};
__device__ __forceinline__ float wave_sum(float v) {
#pragma unroll
    for (int o = 1; o < 64; o <<= 1) v += __shfl_xor(v, o);
    return v;
}
__device__ __forceinline__ float wave_max(float v) {
#pragma unroll
    for (int o = 1; o < 64; o <<= 1) v = fmaxf(v, __shfl_xor(v, o));
    return v;
}

__device__ __forceinline__ void p0_item(const float* W, int pitch, int K, h16* WT, int scol0, int drow0, int k0, const float* gain, float cs, LAS float* scr, int lane) {
    const int kr = lane >> 3, nc = (lane & 7) * 4;
    f32x4 v[8]; float gn[8];
#pragma unroll
    for (int i = 0; i < 8; ++i) v[i] = *(const f32x4*)(W + (size_t)(k0 + kr + 8 * i) * pitch + scol0 + nc);
#pragma unroll
    for (int i = 0; i < 8; ++i) gn[i] = gain ? gain[k0 + kr + 8 * i] * cs : cs;
#pragma unroll
    for (int i = 0; i < 8; ++i) { LAS float* d = scr + (kr + 8 * i) * 33 + nc; d[0] = v[i].x * gn[i]; d[1] = v[i].y * gn[i]; d[2] = v[i].z * gn[i]; d[3] = v[i].w * gn[i]; }
    LDS_WAIT(); asm volatile("" ::: "memory");
    const int c = lane & 7;
#pragma unroll
    for (int j = 0; j < 4; ++j) { const int n = (lane >> 3) + 8 * j; const LAS float* s = scr + (8 * c) * 33 + n;
        u32x4 o; o.x = g8::pk_h2(s[0 * 33], s[1 * 33]); o.y = g8::pk_h2(s[2 * 33], s[3 * 33]); o.z = g8::pk_h2(s[4 * 33], s[5 * 33]); o.w = g8::pk_h2(s[6 * 33], s[7 * 33]);
        *(u32x4*)(WT + (size_t)(drow0 + n) * K + k0 + 8 * c) = o; }
    LDS_WAIT(); asm volatile("" ::: "memory");
}
__device__ __forceinline__ void phase_prologue(const Frame& F, const Bufs& b) {
    LAS float* scr = (LAS float*)(F.lds + RING_OFF + F.wave * 16384);
    const int gw = F.vcu * NWAVES + F.wave, NGW = F.G * NWAVES, lane = F.lane;
    constexpr int I0 = 32 * 136, I1 = 32 * 64, I2 = 64 * 256, I3 = 32 * 256, I4 = 4 * 64, I5 = 32 * 64, NITEMS = I0 + I1 + I2 + I3 + I4 + I5;
    for (int row = gw; row < T; row += NGW) {
        const float* xr = b.x + (size_t)row * D; float ss = 0.f;
#pragma unroll
        for (int j = 0; j < D / 256; ++j) { const f32x4 v = *(const f32x4*)(xr + j * 256 + lane * 4); ss += v.x * v.x + v.y * v.y + v.z * v.z + v.w * v.w;
            u32x2 o; o.x = g8::pk_h2(v.x, v.y); o.y = g8::pk_h2(v.z, v.w); *(u32x2*)(b.x16 + (size_t)row * D + j * 256 + lane * 4) = o; }
        ss = wave_sum(ss); if (lane == 0) b.r1[row] = 1.0f / sqrtf(ss * (1.0f / D) + EPS);
        { const f32x4 v = *(const f32x4*)(b.p + (size_t)row * PLE + lane * 4); u32x2 o; o.x = g8::pk_h2(v.x, v.y); o.y = g8::pk_h2(v.z, v.w); *(u32x2*)(b.p16 + (size_t)row * PLE + lane * 4) = o; }
    }
    for (int it = gw; it < NITEMS; it += NGW) {
        int r = it;
        if (r < I0) { const int kb = r / 136, nb = r % 136, n0 = 32 * nb; const float cs = (n0 < 1024) ? QSCALE_A : ((n0 >= 3072 && n0 < 4096) ? QSCALE_B : 1.f);
            p0_item(b.w_in, NIN, D, b.WinT, n0, n0, 64 * kb, b.g_mix, cs, scr, lane); continue; } r -= I0;
        if (r < I1) { const int kb = r / 64, nb = r % 64; p0_item(b.w_out, D, D, b.WoutT, 32 * nb, 32 * nb, 64 * kb, nullptr, 1.f, scr, lane); continue; } r -= I1;
        if (r < I2) { const int z = r / 256, q = r % 256, kb = q / 8, nb = q % 8, n0 = 32 * nb, e = z >> 1, pn = z & 1;
            const float* src = ((n0 < 128) ? b.w_gate : b.w_up) + (size_t)e * D * DE;
            p0_item(src, DE, D, b.WguT + (size_t)z * 256 * D, 128 * pn + (n0 & 127), n0, 64 * kb, b.g_moe, 1.f, scr, lane); continue; } r -= I2;
        if (r < I3) { const int e = r / 256, q = r % 256, kb = q / 64, nb = q % 64;
            p0_item(b.w_down + (size_t)e * DE * D, D, DE, b.WdT + (size_t)e * D * DE, 32 * nb, 32 * nb, 64 * kb, nullptr, 1.f, scr, lane); continue; } r -= I3;
        if (r < I4) { const int kb = r / 64, nb = r % 64; p0_item(b.w_ple, D, PLE, b.WpleT, 32 * nb, 32 * nb, 64 * kb, nullptr, 1.f, scr, lane); continue; } r -= I4;
        { const int kb = r / 64, nb = r % 64; p0_item(b.w_pg, D, D, b.WpgT, 32 * nb, 32 * nb, 64 * kb, b.g_ple, 1.f, scr, lane); }
    }
    for (int idx = (F.vcu * NWAVES * 64) + F.tid; idx < 80 * D; idx += F.G * NWAVES * 64) {
        const int c = idx / D, k = idx % D; h16 o = (h16)0.f;
        if (c < 72) { const int cc = (c < 36) ? c : c - 36; const float v = ((cc < 4) ? b.w_grp[(size_t)k * 4 + cc] : b.w_exp[(size_t)k * 32 + (cc - 4)]) * b.g_moe[k];
            const h16 hi = (h16)v; o = (c < 36) ? hi : (h16)(v - (float)hi); }
        b.Wr16[idx] = o;
    }
}

template <int HD, int NBR, int NJ> __device__ __forceinline__ void attn_wave_task(const Bufs& b, int id, LAS float* qs, LAS float* sc, int lane) {
    constexpr int NH = (NBR == 3) ? AH : BH;
    const int tok = id / NH, head = id % NH; const int bb = tok / SEQ, tpos = tok % SEQ;
    int qcol, kcol, vcol, ocol; float slope2, sink2 = -INFINITY;
    if (NBR == 3) { qcol = head * 128; kcol = 1024 + head * 128; vcol = 2048 + head * 128; ocol = head * 128; slope2 = exp2f(-(float)(head + 1)) * LOG2E; }
    else { const int kv = head / BG; qcol = 3072 + head * 64; kcol = 4096 + kv * 64; vcol = 4224 + kv * 64; ocol = 1024 + head * 64; slope2 = exp2f(-0.5f * (float)(head + 1)) * LOG2E; sink2 = b.sinks[head] * LOG2E; }
    const h16* base = b.proj + (size_t)bb * SEQ * NIN;
    for (int d = lane; d < HD; d += 64) qs[d] = (float)base[(size_t)tpos * NIN + qcol + d];
    LDS_WAIT();
    float mx = -INFINITY;
    for (int i = lane; i < NBR * NJ; i += 64) {
        const int br = i / NJ, j = i % NJ; const int dil = (br == 0) ? 1 : (br == 1 ? 4 : 16); const int s = tpos - dil * j; float v = -INFINITY;
        if (s >= 0) { const h16* kr = base + (size_t)s * NIN + kcol; float a = 0.f;
            for (int d = 0; d < HD; d += 8) { const half8 kk = *(const half8*)(kr + d);
#pragma unroll
                for (int e = 0; e < 8; ++e) a += qs[d + e] * (float)kk[e]; }
            v = a - slope2 * (float)(dil * j); }
        sc[i] = v; mx = fmaxf(mx, v);
    }
    mx = wave_max(mx); mx = fmaxf(mx, sink2);
    LDS_WAIT();
    float sum = 0.f;
    for (int i = lane; i < NBR * NJ; i += 64) { const float pv = exp2f(sc[i] - mx); sc[i] = pv; sum += pv; }
    sum = wave_sum(sum); sum += exp2f(sink2 - mx);
    LDS_WAIT();
    constexpr int DPL = HD / 64;
    float o[DPL];
#pragma unroll
    for (int e = 0; e < DPL; ++e) o[e] = 0.f;
    for (int i = 0; i < NBR * NJ; ++i) {
        const float pv = sc[i]; if (pv == 0.f) continue;
        const int br = i / NJ, j = i % NJ; const int dil = (br == 0) ? 1 : (br == 1 ? 4 : 16); const int s = tpos - dil * j; const h16* vr = base + (size_t)s * NIN + vcol + lane * DPL;
#pragma unroll
        for (int e = 0; e < DPL; ++e) o[e] += pv * (float)vr[e];
    }
    const float inv = 1.f / sum;
#pragma unroll
    for (int e = 0; e < DPL; ++e) b.mixed[(size_t)tok * D + ocol + lane * DPL + e] = (h16)(o[e] * inv);
    LDS_WAIT();
}
__device__ __forceinline__ void phase_attn_simple(const Frame& F, const Bufs& b) {
    LAS float* qs = (LAS float*)(F.lds + RING_OFF + F.wave * 4096); LAS float* sc = qs + 128;
    const int gw = F.vcu * NWAVES + F.wave, NGW = F.G * NWAVES;
    for (int id = gw; id < T * AH; id += NGW) attn_wave_task<128, 3, 129>(b, id, qs, sc, F.lane);
    for (int id = gw; id < T * BH; id += NGW) attn_wave_task<64, 1, 128>(b, id, qs, sc, F.lane);
}

__device__ __forceinline__ void phase_route(const Frame& F, const Bufs& b) {
    constexpr int SLOT = 18432, NSLOT = 6, NCH = D / 64, AHEAD = 5;
    const int lane = F.lane, fr = lane & 15, fq = lane >> 4, w = F.wave, rt = w & 3, cg = w >> 2;
    LAS unsigned char* ring = F.lds + RING_OFF;
    LAS float* lg = (LAS float*)ring;
    LAS float* sq = lg + 64 * 81;
    LAS int* lcnt = (LAS int*)(sq + 64);
    LAS int* lbase = lcnt + 32;
    const int prow = lane >> 3, pch = (lane & 7) ^ (prow & 7);
    for (int tb = F.vcu; tb < T / 64; tb += F.G) {
        const int r0 = tb * 64;
        const h16* asrc = b.h1 + (size_t)(r0 + 8 * w + prow) * D + pch * 8;
        const h16* bsrc0 = b.Wr16 + (size_t)(8 * w + prow) * D + pch * 8;
        const h16* bsrc1 = b.Wr16 + (size_t)(64 + 8 * w + prow) * D + pch * 8;
#define RT_ISSUE(c) do { const int _sl = ((c) % NSLOT) * SLOT; \
        __builtin_amdgcn_global_load_lds((const unsigned*)(asrc + (c) * 64), (LAS unsigned*)(ring + _sl + w * 1024), 16, 0, 0); \
        __builtin_amdgcn_global_load_lds((const unsigned*)(bsrc0 + (c) * 64), (LAS unsigned*)(ring + _sl + 8192 + w * 1024), 16, 0, 0); \
        if (w < 2) __builtin_amdgcn_global_load_lds((const unsigned*)(bsrc1 + (c) * 64), (LAS unsigned*)(ring + _sl + 8192 + 8192 + w * 1024), 16, 0, 0); } while (0)
        for (int c = 0; c < AHEAD; ++c) RT_ISSUE(c);
        f32x4 acc0 = {0.f, 0.f, 0.f, 0.f}, acc1 = acc0, acc2 = acc0; float ss = 0.f;
        const int arow = rt * 16 + fr, brow = cg * 48 + fr;
#pragma unroll 1
        for (int c = 0; c < NCH; ++c) {
            if (c + AHEAD <= NCH) { if (w < 2) asm volatile("s_waitcnt vmcnt(12)" ::: "memory"); else asm volatile("s_waitcnt vmcnt(8)" ::: "memory"); }
            else asm volatile("s_waitcnt vmcnt(0)" ::: "memory");
            __builtin_amdgcn_s_barrier();
            asm volatile("" ::: "memory");
            if (c + AHEAD < NCH) RT_ISSUE(c + AHEAD);
            asm volatile("" ::: "memory");
            const LAS unsigned char* sl = ring + (c % NSLOT) * SLOT;
#pragma unroll
            for (int ks = 0; ks < 2; ++ks) {
                const half8 a = *(const LAS half8*)(sl + arow * 128 + (((ks * 4 + fq) ^ (arow & 7)) << 4));
                const half8 b0 = *(const LAS half8*)(sl + 8192 + brow * 128 + (((ks * 4 + fq) ^ (brow & 7)) << 4));
                const half8 b1 = *(const LAS half8*)(sl + 8192 + (brow + 16) * 128 + (((ks * 4 + fq) ^ (brow & 7)) << 4));
                acc0 = __builtin_amdgcn_mfma_f32_16x16x32_f16(a, b0, acc0, 0, 0, 0);
                acc1 = __builtin_amdgcn_mfma_f32_16x16x32_f16(a, b1, acc1, 0, 0, 0);
                if (cg == 0) { const half8 b2 = *(const LAS half8*)(sl + 8192 + (brow + 32) * 128 + (((ks * 4 + fq) ^ (brow & 7)) << 4));
                    acc2 = __builtin_amdgcn_mfma_f32_16x16x32_f16(a, b2, acc2, 0, 0, 0);
#pragma unroll
                    for (int j = 0; j < 8; ++j) { const float v = (float)a[j]; ss += v * v; } }
            }
        }
#undef RT_ISSUE
        LDS_WAIT(); __syncthreads();
#pragma unroll
        for (int r = 0; r < 4; ++r) { const int row = rt * 16 + 4 * fq + r; lg[row * 81 + cg * 48 + fr] = acc0[r]; lg[row * 81 + cg * 48 + 16 + fr] = acc1[r]; if (cg == 0) lg[row * 81 + 32 + fr] = acc2[r]; }
        if (cg == 0) { ss += __shfl_xor(ss, 16); ss += __shfl_xor(ss, 32); if (fq == 0) sq[rt * 16 + fr] = ss; }
        if (F.tid < 32) lcnt[F.tid] = 0;
        LDS_WAIT(); __syncthreads();
        int ea = 0, eb = 0, ra = 0, rb = 0; float w0 = 0.f, w1 = 0.f;
        if (F.tid < 64) {
            const LAS float* L = lg + F.tid * 81;
            const float rs = 1.0f / sqrtf(sq[F.tid] * (1.0f / D) + EPS);
            float gl[4];
#pragma unroll
            for (int g = 0; g < 4; ++g) gl[g] = (L[g] + L[36 + g]) * rs + b.b_grp[g];
            int gi = 0; float gm = gl[0];
#pragma unroll
            for (int g = 1; g < 4; ++g) if (gl[g] > gm) { gm = gl[g]; gi = g; }
            float gs = 0.f;
#pragma unroll
            for (int g = 0; g < 4; ++g) gs += __expf(gl[g] - gm);
            const float gw = 1.f / gs;
            int i0 = 0, i1 = 0; float v0 = -INFINITY, v1 = -INFINITY;
            for (int e = 0; e < 8; ++e) { const float v = (L[4 + gi * 8 + e] + L[40 + gi * 8 + e]) * rs + b.b_exp[gi * 8 + e];
                if (v > v0) { v1 = v0; i1 = i0; v0 = v; i0 = e; } else if (v > v1) { v1 = v; i1 = e; } }
            const float e1 = __expf(v1 - v0); w0 = gw / (1.f + e1); w1 = gw * e1 / (1.f + e1);
            ea = gi * 8 + i0; eb = gi * 8 + i1;
            b.r2[r0 + F.tid] = rs;
            ra = atomicAdd((int*)(lcnt + ea), 1); rb = atomicAdd((int*)(lcnt + eb), 1);
        }
        LDS_WAIT(); __syncthreads();
        if (F.tid < 32) { const int n = lcnt[F.tid]; lbase[F.tid] = n ? atomicAdd(b.cnt + F.tid, n) : 0; }
        LDS_WAIT(); __syncthreads();
        if (F.tid < 64) {
            const int tok = r0 + F.tid; const int pa = lbase[ea] + ra, pb = lbase[eb] + rb;
            b.ltok[(size_t)ea * T + pa] = tok; b.lw[(size_t)ea * T + pa] = w0;
            b.ltok[(size_t)eb * T + pb] = tok | (1 << 30); b.lw[(size_t)eb * T + pb] = w1;
        }
        __syncthreads();
    }
}

__device__ __forceinline__ void phase_combine(const Frame& F, const Bufs& b) {
    const int gw = F.vcu * NWAVES + F.wave, NGW = F.G * NWAVES, lane = F.lane;
    for (int tok = gw; tok < T; tok += NGW) {
        float ss = 0.f;
#pragma unroll
        for (int j = 0; j < 4; ++j) { const size_t o = (size_t)tok * D + j * 512 + lane * 8;
            const half8 a = *(const half8*)(b.h1 + o), c0 = *(const half8*)(b.y + o), c1 = *(const half8*)(b.y + (size_t)T * D + o); half8 r;
#pragma unroll
            for (int e = 0; e < 8; ++e) { const float s = (float)a[e] + (float)c0[e] + (float)c1[e]; ss += s * s; r[e] = (h16)s; }
            *(half8*)(b.h2 + o) = r; }
        ss = wave_sum(ss); if (lane == 0) b.r3[tok] = 1.0f / sqrtf(ss * (1.0f / D) + EPS);
    }
}
__device__ __forceinline__ void phase_final(const Frame& F, const Bufs& b) {
    const int gw = F.vcu * NWAVES + F.wave, NGW = F.G * NWAVES, lane = F.lane;
    for (int tok = gw; tok < T; tok += NGW) {
        const float rs = 1.0f / sqrtf(b.ssq[tok] * (1.0f / D) + EPS);
#pragma unroll
        for (int j = 0; j < 8; ++j) { const size_t o = (size_t)tok * D + j * 256 + lane * 4; f32x4 v = *(f32x4*)(b.out + o); const f32x4 gg = *(const f32x4*)(b.g_final + j * 256 + lane * 4);
            v.x *= rs * gg.x; v.y *= rs * gg.y; v.z *= rs * gg.z; v.w *= rs * gg.w; *(f32x4*)(b.out + o) = v; }
    }
}
namespace at {
typedef short v4i16 __attribute__((ext_vector_type(4)));
struct Task {
    const h16* qbase;
    const h16* kbase;
    const h16* vbase;
    int dil, rho;
    int ql0;
    int maxdelta;
    float slope2d;
};
__device__ __forceinline__ half8 tr_pair(const LAS unsigned char* p) {
    const v4i16 lo = __builtin_amdgcn_ds_read_tr16_b64_v4i16((LAS v4i16*)p), hi = __builtin_amdgcn_ds_read_tr16_b64_v4i16((LAS v4i16*)(p + 512));
    typedef short s8 __attribute__((ext_vector_type(8)));
    const s8 r = {lo[0], lo[1], lo[2], lo[3], hi[0], hi[1], hi[2], hi[3]};
    return __builtin_bit_cast(half8, r);
}
template <int HD> __device__ __forceinline__ void run_task(const Task& t, LAS unsigned char* vbuf, int lane, float& m_out, float& l_out, f32x16 (&O)[HD / 32]) {
    constexpr int ND0 = HD / 16, NDB = HD / 32, NP = NDB * 2, VB = HD * 64;
    const int r32 = lane & 31, hi = lane >> 5;
    half8 qf[ND0];
    { const h16* qp = t.qbase + (size_t)(t.dil * (t.ql0 + r32) + t.rho) * NIN + hi * 8;
#pragma unroll
      for (int d0 = 0; d0 < ND0; ++d0) qf[d0] = *(const half8*)(qp + 16 * d0); }
    const int j1 = t.ql0 >> 5, j0 = (j1 - 4) > 0 ? (j1 - 4) : 0;
    const h16* kp = t.kbase + (size_t)(t.dil * (32 * j0 + r32) + t.rho) * NIN + hi * 8;
    const h16* vp = t.vbase + (size_t)(t.dil * (32 * j0 + (lane >> 2)) + t.rho) * NIN + (lane & 3) * 8;
    const size_t tile_step = (size_t)32 * t.dil * NIN, ks_step = (size_t)16 * t.dil * NIN;
    const int laneoff = ((lane >> 4) & 1) * 32 + (lane & 3) * 8 + (4 * hi + ((lane & 15) >> 2)) * 64;
#define AT_DMAV(jj, bufb) do { _Pragma("unroll") for (int _p = 0; _p < NP; ++_p) \
        __builtin_amdgcn_global_load_lds((const unsigned*)(vp + (size_t)((jj) - j0) * tile_step + (_p & 1) * ks_step + (_p >> 1) * 32), (LAS unsigned*)(vbuf + (bufb) + _p * 1024), 16, 0, 0); } while (0)
    float m = -1e30f, l = 0.f;
#pragma unroll
    for (int b = 0; b < NDB; ++b)
#pragma unroll
        for (int r = 0; r < 16; ++r) O[b][r] = 0.f;
    half8 kf[ND0];
#pragma unroll
    for (int d0 = 0; d0 < ND0; ++d0) kf[d0] = *(const half8*)(kp + 16 * d0);
    AT_DMAV(j0, 0);
    for (int j = j0; j <= j1; ++j) {
        const int bufb = ((j - j0) & 1) * VB;
        f32x16 S;
#pragma unroll
        for (int r = 0; r < 16; ++r) S[r] = 0.f;
#pragma unroll
        for (int d0 = 0; d0 < ND0; ++d0) S = __builtin_amdgcn_mfma_f32_32x32x16_f16(kf[d0], qf[d0], S, 0, 0, 0);
        asm volatile("" ::: "memory");
        half8 kn[ND0];
        if (j < j1) {
#pragma unroll
            for (int d0 = 0; d0 < ND0; ++d0) kn[d0] = *(const half8*)(kp + (size_t)(j + 1 - j0) * tile_step + 16 * d0);
            AT_DMAV(j + 1, bufb ^ VB);
        } else {
#pragma unroll
            for (int d0 = 0; d0 < ND0; ++d0) kn[d0] = kf[d0];
        }
        asm volatile("" ::: "memory");
        const int dbase = t.ql0 + r32 - 32 * j - 4 * hi;
        float mx = -INFINITY;
#pragma unroll
        for (int r = 0; r < 16; ++r) { const int delta = dbase - ((r & 3) + 8 * (r >> 2)); float v = S[r] - t.slope2d * (float)delta;
            v = (delta >= 0 && delta <= t.maxdelta) ? v : -INFINITY; S[r] = v; mx = fmaxf(mx, v); }
        mx = fmaxf(mx, __shfl_xor(mx, 32));
        const float mn = fmaxf(m, mx), alpha = __builtin_amdgcn_exp2f(m - mn); m = mn;
        float ps = 0.f;
#pragma unroll
        for (int r = 0; r < 16; ++r) { S[r] = __builtin_amdgcn_exp2f(S[r] - mn); ps += S[r]; }
        l = l * alpha + ps;
#pragma unroll
        for (int b = 0; b < NDB; ++b)
#pragma unroll
            for (int r = 0; r < 16; ++r) O[b][r] *= alpha;
        half8 pf[2];
#pragma unroll
        for (int s = 0; s < 2; ++s) { u32x4 w; w.x = g8::pk_h2(S[8 * s + 0], S[8 * s + 1]); w.y = g8::pk_h2(S[8 * s + 2], S[8 * s + 3]); w.z = g8::pk_h2(S[8 * s + 4], S[8 * s + 5]); w.w = g8::pk_h2(S[8 * s + 6], S[8 * s + 7]); pf[s] = __builtin_bit_cast(half8, w); }
        if (j < j1) { if (NP == 8) asm volatile("s_waitcnt vmcnt(16)" ::: "memory"); else asm volatile("s_waitcnt vmcnt(8)" ::: "memory"); }
        else asm volatile("s_waitcnt vmcnt(0)" ::: "memory");
#pragma unroll
        for (int b = 0; b < NDB; ++b)
#pragma unroll
            for (int s = 0; s < 2; ++s) { const half8 vf = tr_pair(vbuf + bufb + b * 2048 + s * 1024 + laneoff); O[b] = __builtin_amdgcn_mfma_f32_32x32x16_f16(vf, pf[s], O[b], 0, 0, 0); }
        asm volatile("s_waitcnt lgkmcnt(0)" ::: "memory");
#pragma unroll
        for (int d0 = 0; d0 < ND0; ++d0) kf[d0] = kn[d0];
    }
#undef AT_DMAV
    l += __shfl_xor(l, 32);
    m_out = m; l_out = l;
}
template <int HD> __device__ __forceinline__ void store_rows(h16* rp, const f32x16 (&O)[HD / 32], float sc, int hi) {
#pragma unroll
    for (int b = 0; b < HD / 32; ++b)
#pragma unroll
        for (int g = 0; g < 4; ++g) { u32x2 w; w.x = g8::pk_h2(O[b][4 * g] * sc, O[b][4 * g + 1] * sc); w.y = g8::pk_h2(O[b][4 * g + 2] * sc, O[b][4 * g + 3] * sc);
            *(u32x2*)(rp + 32 * b + 8 * g + 4 * hi) = w; }
}
__device__ __forceinline__ f32x4 ld4h(const h16* p) { const h16x4 v = *(const h16x4*)p; return (f32x4){(float)v[0], (float)v[1], (float)v[2], (float)v[3]}; }

__device__ __forceinline__ void phase_attn(const Frame& F, const Bufs& b, h16* exo, float* exl) {
    const int lane = F.lane, w = F.wave, r32 = lane & 31, hi = lane >> 5;
    LAS unsigned char* vbuf = F.lds + RING_OFF + w * 16384;
    for (int u = F.vcu; u < BATCH * AH * 4; u += F.G) {
        const int c = u & 3, h = (u >> 2) & 7, bb = u >> 5;
        const h16* base = b.proj + (size_t)bb * SEQ * NIN;
        Task t; t.qbase = base + h * 128; t.kbase = base + 1024 + h * 128; t.vbase = base + 2048 + h * 128; t.maxdelta = 128;
        const float slope2 = exp2f(-(float)(h + 1)) * LOG2E;
        f32x16 O[4]; float m, l;
#pragma unroll 1
        for (int k = w; k < 32; k += 8) {
            const int br = k >> 4, kk = k & 15;
            if (br == 0) { t.dil = 1; t.rho = 0; t.ql0 = 512 * c + 32 * kk; } else { t.dil = 4; t.rho = kk >> 2; t.ql0 = 128 * c + 32 * (kk & 3); }
            t.slope2d = slope2 * (float)t.dil;
            run_task<128>(t, vbuf, lane, m, l, O);
            const int tok = bb * SEQ + t.dil * (t.ql0 + r32) + t.rho;
            store_rows<128>(exo + ((size_t)br * T + tok) * 1024 + h * 128, O, 1.f / l, hi);
            if (hi == 0) exl[((size_t)br * T + tok) * 8 + h] = m + __builtin_amdgcn_logf(l);
        }
        asm volatile("s_waitcnt vmcnt(0)" ::: "memory"); __syncthreads();
#pragma unroll 1
        for (int rho = w; rho < 16; rho += 8) {
            t.dil = 16; t.rho = rho; t.ql0 = 32 * c; t.slope2d = slope2 * 16.f;
            run_task<128>(t, vbuf, lane, m, l, O);
            const int tok = bb * SEQ + 16 * (t.ql0 + r32) + rho;
            const float l3 = m + __builtin_amdgcn_logf(l);
            const float l1 = exl[(size_t)tok * 8 + h], l2 = exl[((size_t)T + tok) * 8 + h];
            const float M = fmaxf(fmaxf(l1, l2), l3);
            const float w1 = __builtin_amdgcn_exp2f(l1 - M), w2 = __builtin_amdgcn_exp2f(l2 - M), w3 = __builtin_amdgcn_exp2f(l3 - M);
            const float inv = 1.f / (w1 + w2 + w3); const float s1 = w1 * inv, s2 = w2 * inv, s3 = w3 * inv / l;
            const h16* e1 = exo + (size_t)tok * 1024 + h * 128; const h16* e2 = exo + ((size_t)T + tok) * 1024 + h * 128;
            h16* op = b.mixed + (size_t)tok * D + h * 128;
#pragma unroll
            for (int bk = 0; bk < 4; ++bk)
#pragma unroll
                for (int g = 0; g < 4; ++g) { const int d = 32 * bk + 8 * g + 4 * hi; const f32x4 a1 = ld4h(e1 + d), a2 = ld4h(e2 + d);
                    u32x2 wv; wv.x = g8::pk_h2(O[bk][4 * g] * s3 + a1[0] * s1 + a2[0] * s2, O[bk][4 * g + 1] * s3 + a1[1] * s1 + a2[1] * s2);
                    wv.y = g8::pk_h2(O[bk][4 * g + 2] * s3 + a1[2] * s1 + a2[2] * s2, O[bk][4 * g + 3] * s3 + a1[3] * s1 + a2[3] * s2);
                    *(u32x2*)(op + d) = wv; }
        }
        asm volatile("s_waitcnt vmcnt(0)" ::: "memory"); __syncthreads();
    }
    for (int u = F.vcu; u < BATCH * BKV * 16; u += F.G) {
        const int qb = u & 15, kv = (u >> 4) & 1, bb = u >> 5; const int hq = kv * 8 + w;
        const h16* base = b.proj + (size_t)bb * SEQ * NIN;
        Task t; t.qbase = base + 3072 + hq * 64; t.kbase = base + 4096 + kv * 64; t.vbase = base + 4224 + kv * 64; t.maxdelta = 127; t.dil = 1; t.rho = 0;
        t.slope2d = exp2f(-0.5f * (float)(hq + 1)) * LOG2E;
        const float sink2 = b.sinks[hq] * LOG2E;
        f32x16 O[2]; float m, l;
#pragma unroll 1
        for (int i = 0; i < 4; ++i) {
            t.ql0 = 128 * qb + 32 * i;
            run_task<64>(t, vbuf, lane, m, l, O);
            const float mf = fmaxf(m, sink2); const float a = __builtin_amdgcn_exp2f(m - mf); const float den = l * a + __builtin_amdgcn_exp2f(sink2 - mf);
            const int tok = bb * SEQ + t.ql0 + r32;
            store_rows<64>(b.mixed + (size_t)tok * D + 1024 + hq * 64, O, a / den, hi);
        }
    }
}
}
constexpr int NPH = 10;
__global__ void __launch_bounds__(NWAVES * 64, 2) mega(Args args) {
    extern __shared__ __attribute__((aligned(16))) unsigned char lds[];
    const Bufs& b = args.b;
    Frame F;
    F.lds = (LAS unsigned char*)lds;
    F.tid = threadIdx.x; F.lane = F.tid & 63; F.wave = __builtin_amdgcn_readfirstlane(F.tid >> 6);
    F.G = gridDim.x; { const int bx = blockIdx.x; F.vcu = (F.G % 8 == 0) ? (bx % 8) * (F.G / 8) + bx / 8 : bx; }
    volatile LAS unsigned* MISC = (volatile LAS unsigned*)(F.lds + MISC_OFF);
    volatile LAS int* tab = (volatile LAS int*)(F.lds + TAB_OFF);
    for (int u = F.tid; u < (LDS_BYTES - LDSCTL_OFF) / 4; u += NWAVES * 64) ((LAS unsigned*)(F.lds + LDSCTL_OFF))[u] = 0u;
    __syncthreads();
    unsigned* ctl = (unsigned*)(b.ws + WS_CTL);
    XcdBarrier bar = xcd_barrier_post(ctl + CW_BAR + args.li * XCD_BAR_WORDS, MISC + 8);
    const int lo = args.ph_lo, hi = args.ph_hi;
#ifdef ONLY_PHASE
#define IN(k) ((k) == ONLY_PHASE && lo <= (k) && (k) < hi)
#else
#define IN(k) (lo <= (k) && (k) < hi)
#endif
#define SEAM(k) do { if (IN(k) && IN((k) + 1)) xcd_barrier(bar); } while (0)
#ifdef PROBE_PHASE
#define PH(k, ...) do { if (IN(k)) { __VA_ARGS__ if ((k) == PROBE_PHASE) { xcd_barrier(bar); __VA_ARGS__ } } SEAM(k); } while (0)
#else
#define PH(k, ...) do { if (IN(k)) { __VA_ARGS__ } SEAM(k); } while (0)
#endif
    G8_LAS unsigned char* ring = F.lds + RING_OFF;

    PH(0, phase_prologue(F, b););
    PH(1,
        { g8::Gemm g{b.x16, b.WinT, D}; g8::StaticOrder S; S.init(T, NIN, F.G, (int)blockIdx.x); g8::EpiProj E{b.proj, b.r1}; g8::gemm_phase<g8::EpiProj, g8::StaticOrder>(ring, g, S, E); }
        { g8::Gemm g{b.p16, b.WpleT, PLE}; g8::StaticOrder S; S.init(T, D, F.G, (int)blockIdx.x); g8::EpiPlain E{b.pw16, D}; g8::gemm_phase<g8::EpiPlain, g8::StaticOrder>(ring, g, S, E); });
    PH(2, at::phase_attn(F, b, (h16*)(b.ws + WS_RD), (float*)(b.ws + WS_LTOK)););
    PH(3, { g8::Gemm g{b.mixed, b.WoutT, D}; g8::StaticOrder S; S.init(T, D, F.G, (int)blockIdx.x); g8::EpiRes E{b.h1, b.x}; g8::gemm_phase<g8::EpiRes, g8::StaticOrder>(ring, g, S, E); });
#if defined(PROBE_PHASE) && PROBE_PHASE == 4
    if (IN(4)) { phase_route(F, b); xcd_barrier(bar); if (blockIdx.x == 0 && F.tid < 32) b.cnt[F.tid] = 0; xcd_barrier(bar); phase_route(F, b); } SEAM(4);
#else
    PH(4, phase_route(F, b););
#endif
    PH(5, { g8::moe_table(tab, b.cnt); LDS_WAIT(); __syncthreads();
        g8::Gemm g{b.h1, b.WguT, D}; g8::MoeUpOrder S{tab, b.ltok, F.G, F.vcu}; g8::EpiMoeUp E{b.hid, b.ltok, b.lw, b.r2}; g8::gemm_phase<g8::EpiMoeUp, g8::MoeUpOrder>(ring, g, S, E); });
    PH(6, { g8::moe_table(tab, b.cnt); LDS_WAIT(); __syncthreads();
        g8::Gemm g{b.hid, b.WdT, DE}; g8::MoeDownOrder S{tab, F.G, F.vcu}; g8::EpiMoeDown E{b.y, b.ltok}; g8::gemm_phase<g8::EpiMoeDown, g8::MoeDownOrder>(ring, g, S, E); });
    PH(7, phase_combine(F, b););
#if defined(PROBE_PHASE) && PROBE_PHASE == 8
    if (IN(8)) { g8::Gemm g{b.h2, b.WpgT, D}; g8::StaticOrder S; S.init(T, D, F.G, (int)blockIdx.x); g8::EpiPle E{b.out, b.h2, b.pw16, b.r3, (float*)(b.ws + WS_R1)}; g8::gemm_phase<g8::EpiPle, g8::StaticOrder>(ring, g, S, E); xcd_barrier(bar); }
#endif
    PH(8, { g8::Gemm g{b.h2, b.WpgT, D}; g8::StaticOrder S; S.init(T, D, F.G, (int)blockIdx.x); g8::EpiPle E{b.out, b.h2, b.pw16, b.r3, b.ssq}; g8::gemm_phase<g8::EpiPle, g8::StaticOrder>(ring, g, S, E); });
    PH(9, phase_final(F, b););
#undef IN
#undef SEAM
#undef PH
}

static int g_grid = 0;
static bool mega_setup() {
    if (g_grid) return g_grid > 0;
    int dev = 0, cus = 0, per_cu = 0;
    if (hipGetDevice(&dev) != hipSuccess || hipDeviceGetAttribute(&cus, hipDeviceAttributeMultiprocessorCount, dev) != hipSuccess) { g_grid = -1; return false; }
    if (hipFuncSetAttribute((const void*)mega, hipFuncAttributeMaxDynamicSharedMemorySize, LDS_BYTES) != hipSuccess) { fprintf(stderr, "hipFuncSetAttribute failed\n"); g_grid = -1; return false; }
    if (hipOccupancyMaxActiveBlocksPerMultiprocessor(&per_cu, (const void*)mega, NWAVES * 64, LDS_BYTES) != hipSuccess || per_cu < 1) { fprintf(stderr, "occupancy query: %d\n", per_cu); (void)hipGetLastError(); g_grid = -1; return false; }
    g_grid = cus;
    return true;
}
static void mega_run(const Bufs& b, int lo, int hi, int li, hipStream_t s) {
    Args a{}; a.b = b; a.ph_lo = lo; a.ph_hi = hi; a.li = li; a.pad = 0;
    hipLaunchKernelGGL(mega, dim3(g_grid), dim3(NWAVES * 64), LDS_BYTES, s, a);
}
extern "C" void kernel_launch(void* const* d_in, const int* in_sizes, int n_in, void* d_out, int out_size, void* d_ws, size_t ws_size, hipStream_t stream) {
    if (n_in != 18 || out_size != T * D || ws_size < WS_END) { fprintf(stderr, "kernel_launch: unexpected shapes: n_in %d out %d ws %zu\n", n_in, out_size, ws_size); return; }
    if (!mega_setup()) return;
    Bufs b = make_bufs(d_in, d_out, d_ws);
    (void)hipMemsetAsync((char*)d_ws + WS_CTL, 0, CTL_ZERO_BYTES, stream);
    mega_run(b, 0, NPH, 0, stream);
}
```

```cpp
#include <hip/hip_runtime.h>
#include <cstdint>
#include <cstdio>
#include <cmath>

typedef _Float16 h16;
typedef _Float16 half8 __attribute__((ext_vector_type(8)));
typedef _Float16 h16x4 __attribute__((ext_vector_type(4)));
typedef _Float16 h16x2 __attribute__((ext_vector_type(2)));
typedef float f32x4 __attribute__((ext_vector_type(4)));
typedef float f32x2 __attribute__((ext_vector_type(2)));
typedef float f32x16 __attribute__((ext_vector_type(16)));
typedef unsigned u32x4 __attribute__((ext_vector_type(4)));
typedef unsigned u32x2 __attribute__((ext_vector_type(2)));
#define UNR _Pragma("unroll")

constexpr int BATCH = 8, SEQ = 2048, T = BATCH * SEQ, D = 2048, PLE = 256;
constexpr int AH = 8, AHD = 128, BH = 16, BHD = 64, BKV = 2, BG = 8;
constexpr int NIN = 4352;
constexpr int NE = 32, DE = 256;
constexpr float EPS = 1e-6f;
constexpr float LOG2E = 1.4426950408889634f;
constexpr float QSCALE_A = 0.08838834764831845f * LOG2E;
constexpr float QSCALE_B = 0.125f * LOG2E;

constexpr size_t MiB = 1u << 20;
constexpr size_t WS_CTL = 0, CTL_ZERO_BYTES = 1 * MiB;
constexpr size_t CTL_CNT = 256 * 1024, CTL_SSQ = 320 * 1024;
constexpr size_t WS_R1 = 1 * MiB, WS_R2 = WS_R1 + 64 * 1024, WS_R3 = WS_R2 + 64 * 1024;
constexpr size_t WS_LTOK = 2 * MiB, WS_LW = 4 * MiB, WS_WR = 6 * MiB, WS_WR16 = 7 * MiB;
constexpr size_t WS_WIN = 8 * MiB, WS_WOUT = 25 * MiB, WS_WGU = 33 * MiB, WS_WD = 97 * MiB, WS_WPLE = 129 * MiB, WS_WPG = 130 * MiB;
constexpr size_t WS_P16 = 138 * MiB, WS_PW16 = 146 * MiB;
constexpr size_t WS_RA = 210 * MiB;
constexpr size_t WS_RB = 274 * MiB;
constexpr size_t WS_RD = 410 * MiB;
constexpr size_t WS_END = 474 * MiB;

namespace nv {

__device__ __forceinline__ float wave_sum(float v) {
#pragma unroll
    for (int o = 1; o < 64; o <<= 1) v += __shfl_xor(v, o);
    return v;
}
__device__ __forceinline__ float wave_max(float v) {
#pragma unroll
    for (int o = 1; o < 64; o <<= 1) v = fmaxf(v, __shfl_xor(v, o));
    return v;
}

__global__ __launch_bounds__(256) void k_prep_x(const float* __restrict__ x, h16* __restrict__ x16, float* __restrict__ r1,
                                                const float* __restrict__ p, h16* __restrict__ p16) {
    const int wid = threadIdx.x >> 6, lane = threadIdx.x & 63;
    const int row = blockIdx.x * 4 + wid;
    if (row >= T) return;
    const float* xr = x + (size_t)row * D;
    float ss = 0.f;
    for (int j = 0; j < D / 256; ++j) {
        const f32x4 v = *(const f32x4*)(xr + j * 256 + lane * 4);
        ss += v.x * v.x + v.y * v.y + v.z * v.z + v.w * v.w;
        h16x4 o = {(h16)v.x, (h16)v.y, (h16)v.z, (h16)v.w};
        *(h16x4*)(x16 + (size_t)row * D + j * 256 + lane * 4) = o;
    }
    ss = wave_sum(ss);
    if (lane == 0) r1[row] = 1.0f / sqrtf(ss * (1.0f / D) + EPS);
    {
        const f32x4 v = *(const f32x4*)(p + (size_t)row * PLE + lane * 4);
        h16x4 o = {(h16)v.x, (h16)v.y, (h16)v.z, (h16)v.w};
        *(h16x4*)(p16 + (size_t)row * PLE + lane * 4) = o;
    }
}

struct TrJob { const float* src; const float* src2; h16* dst; const float* gain; int pitch, K, N, mode; long src_z, dst_z; };
__global__ __launch_bounds__(256) void k_transpose(TrJob j) {
    __shared__ float tile[64][65];
    const int z = blockIdx.z;
    const int k0 = blockIdx.y * 64, n0 = blockIdx.x * 64;
    const int tx = threadIdx.x & 63, ty = threadIdx.x >> 6;
    const float* src = j.src; const float* src2 = j.src2; h16* dst = j.dst + (size_t)z * j.dst_z;
    int pn = 0;
    if (j.mode == 2) { const int e = z >> 1; pn = z & 1; src += (size_t)e * j.src_z; src2 += (size_t)e * j.src_z; }
    else { src += (size_t)z * j.src_z; }
    {
        const int n = n0 + tx;
        const float* s = src; int col = n;
        if (j.mode == 2) { s = (n < 128) ? src : src2; col = 128 * pn + (n & 127); }
        float cs = 1.f;
        if (j.mode == 1) { if (n < 1024) cs = QSCALE_A; else if (n >= 3072 && n < 4096) cs = QSCALE_B; }
        for (int i = 0; i < 16; ++i) {
            const int k = k0 + ty + 4 * i;
            float v = s[(size_t)k * j.pitch + col] * cs;
            if (j.gain) v *= j.gain[k];
            tile[ty + 4 * i][tx] = v;
        }
    }
    __syncthreads();
    for (int i = 0; i < 16; ++i) {
        const int n = n0 + ty + 4 * i;
        dst[(size_t)n * j.K + k0 + tx] = (h16)tile[tx][ty + 4 * i];
    }
}
__global__ void k_router_w(const float* __restrict__ w_grp, const float* __restrict__ w_exp, const float* __restrict__ g, float* __restrict__ Wr) {
    const int idx = blockIdx.x * blockDim.x + threadIdx.x;
    if (idx >= 36 * D) return;
    const int c = idx / D, k = idx % D;
    const float v = (c < 4) ? w_grp[(size_t)k * 4 + c] : w_exp[(size_t)k * 32 + (c - 4)];
    Wr[idx] = v * g[k];
}

template <class Op> __global__ __launch_bounds__(256) void k_gemm(Op op) {
    const int z = blockIdx.z;
    const int M = op.mrows(z);
    const int row0 = blockIdx.y * 128; if (row0 >= M) return;
    const int col0 = blockIdx.x * 128;
    const int wid = threadIdx.x >> 6, lane = threadIdx.x & 63, wy = wid >> 1, wx = wid & 1, fr = lane & 15, fq = lane >> 4;
    f32x4 acc[4][4];
#pragma unroll
    for (int a = 0; a < 4; ++a)
#pragma unroll
        for (int b = 0; b < 4; ++b) acc[a][b] = (f32x4){0.f, 0.f, 0.f, 0.f};
    const h16* ap[4]; const h16* bp[4];
#pragma unroll
    for (int mi = 0; mi < 4; ++mi) ap[mi] = op.arow(z, row0 + wy * 64 + mi * 16 + fr) + fq * 8;
#pragma unroll
    for (int ni = 0; ni < 4; ++ni) bp[ni] = op.brow(z, col0 + wx * 64, ni, fr) + fq * 8;
    for (int k0 = 0; k0 < op.K; k0 += 32) {
        half8 a[4], b[4];
#pragma unroll
        for (int i = 0; i < 4; ++i) { a[i] = *(const half8*)(ap[i] + k0); b[i] = *(const half8*)(bp[i] + k0); }
#pragma unroll
        for (int mi = 0; mi < 4; ++mi)
#pragma unroll
            for (int ni = 0; ni < 4; ++ni) acc[mi][ni] = __builtin_amdgcn_mfma_f32_16x16x32_f16(a[mi], b[ni], acc[mi][ni], 0, 0, 0);
    }
    op.epi(z, row0 + wy * 64, col0 + wx * 64, acc, fr, fq);
}

struct OpBase { int K; };
struct OpG1 : OpBase {
    const h16* A; const h16* Bt; const float* r1; h16* out;
    __device__ int mrows(int) const { return T; }
    __device__ const h16* arow(int, int r) const { return A + (size_t)r * D; }
    __device__ const h16* brow(int, int cb, int ni, int fr) const { return Bt + (size_t)(cb + ni * 16 + fr) * D; }
    __device__ void epi(int, int rb, int cb, f32x4 (&acc)[4][4], int fr, int fq) const {
        UNR for (int mi = 0; mi < 4; ++mi) UNR for (int r = 0; r < 4; ++r) { const int row = rb + mi * 16 + fq * 4 + r; const float s = r1[row];
            UNR for (int ni = 0; ni < 4; ++ni) out[(size_t)row * NIN + cb + ni * 16 + fr] = (h16)(acc[mi][ni][r] * s); }
    }
};
struct OpG3 : OpBase {
    const h16* A; const h16* Bt; const float* x; h16* out;
    __device__ int mrows(int) const { return T; }
    __device__ const h16* arow(int, int r) const { return A + (size_t)r * D; }
    __device__ const h16* brow(int, int cb, int ni, int fr) const { return Bt + (size_t)(cb + ni * 16 + fr) * D; }
    __device__ void epi(int, int rb, int cb, f32x4 (&acc)[4][4], int fr, int fq) const {
        UNR for (int mi = 0; mi < 4; ++mi) UNR for (int r = 0; r < 4; ++r) { const int row = rb + mi * 16 + fq * 4 + r;
            UNR for (int ni = 0; ni < 4; ++ni) { const size_t o = (size_t)row * D + cb + ni * 16 + fr; out[o] = (h16)(x[o] + acc[mi][ni][r]); } }
    }
};
__device__ __forceinline__ void moe_offsets(const int* cnt, int e, int& off, int& n) {
    int o = 0; for (int i = 0; i < e; ++i) o += (cnt[i] + 255) & ~255; off = o; n = cnt[e];
}
struct OpMU : OpBase {
    const h16* A; const h16* Wgu; const int* cnt; const int* ltok; const float* lw; const float* r2; h16* hid;
    __device__ int mrows(int z) const { return cnt[z]; }
    __device__ const h16* arow(int z, int r) const { const int n = cnt[z]; const int tok = (r < n) ? (ltok[(size_t)z * T + r] & 0x3fff) : 0; return A + (size_t)tok * D; }
    __device__ const h16* brow(int z, int cb, int ni, int fr) const {
        const int hc = (cb >> 6) * 32 + (ni & 1) * 16 + fr; const int pn = hc >> 7, i = hc & 127;
        return Wgu + ((size_t)(z * 2 + pn) * 256 + (ni >> 1) * 128 + i) * D;
    }
    __device__ void epi(int z, int rb, int cb, f32x4 (&acc)[4][4], int fr, int fq) const {
        int off, n; moe_offsets(cnt, z, off, n);
        UNR for (int mi = 0; mi < 4; ++mi) UNR for (int r = 0; r < 4; ++r) { const int pos = rb + mi * 16 + fq * 4 + r; if (pos >= n) continue;
            const int tok = ltok[(size_t)z * T + pos] & 0x3fff; const float s = r2[tok], w = lw[(size_t)z * T + pos];
            UNR for (int ni = 0; ni < 2; ++ni) { const float g = acc[mi][ni][r] * s, u = acc[mi][ni + 2][r] * s;
                const float v = g / (1.f + __expf(-g)) * u * w; const int hc = (cb >> 6) * 32 + ni * 16 + fr;
                hid[(size_t)(off + pos) * DE + hc] = (h16)v; } }
    }
};
struct OpMD : OpBase {
    const h16* hid; const h16* Wd; const int* cnt; const int* ltok; h16* y;
    __device__ int mrows(int z) const { return cnt[z]; }
    __device__ const h16* arow(int z, int r) const { int off, n; moe_offsets(cnt, z, off, n); return hid + (size_t)(off + r) * DE; }
    __device__ const h16* brow(int z, int cb, int ni, int fr) const { return Wd + ((size_t)z * D + cb + ni * 16 + fr) * DE; }
    __device__ void epi(int z, int rb, int cb, f32x4 (&acc)[4][4], int fr, int fq) const {
        const int n = cnt[z];
        UNR for (int mi = 0; mi < 4; ++mi) UNR for (int r = 0; r < 4; ++r) { const int pos = rb + mi * 16 + fq * 4 + r; if (pos >= n) continue;
            const int lt = ltok[(size_t)z * T + pos]; const int tok = lt & 0x3fff, slot = (lt >> 30) & 1;
            UNR for (int ni = 0; ni < 4; ++ni) y[((size_t)slot * T + tok) * D + cb + ni * 16 + fr] = (h16)acc[mi][ni][r]; }
    }
};
struct OpPW : OpBase {
    const h16* A; const h16* Bt; h16* out;
    __device__ int mrows(int) const { return T; }
    __device__ const h16* arow(int, int r) const { return A + (size_t)r * PLE; }
    __device__ const h16* brow(int, int cb, int ni, int fr) const { return Bt + (size_t)(cb + ni * 16 + fr) * PLE; }
    __device__ void epi(int, int rb, int cb, f32x4 (&acc)[4][4], int fr, int fq) const {
        UNR for (int mi = 0; mi < 4; ++mi) UNR for (int r = 0; r < 4; ++r) { const int row = rb + mi * 16 + fq * 4 + r;
            UNR for (int ni = 0; ni < 4; ++ni) out[(size_t)row * D + cb + ni * 16 + fr] = (h16)acc[mi][ni][r]; }
    }
};
struct OpG5 : OpBase {
    const h16* A; const h16* Bt; const float* r3; const h16* pw; float* out; float* ssq;
    __device__ int mrows(int) const { return T; }
    __device__ const h16* arow(int, int r) const { return A + (size_t)r * D; }
    __device__ const h16* brow(int, int cb, int ni, int fr) const { return Bt + (size_t)(cb + ni * 16 + fr) * D; }
    __device__ void epi(int, int rb, int cb, f32x4 (&acc)[4][4], int fr, int fq) const {
        UNR for (int mi = 0; mi < 4; ++mi) UNR for (int r = 0; r < 4; ++r) { const int row = rb + mi * 16 + fq * 4 + r; const float s = r3[row]; float q = 0.f;
            UNR for (int ni = 0; ni < 4; ++ni) { const size_t o = (size_t)row * D + cb + ni * 16 + fr; const float g = 1.f / (1.f + __expf(-acc[mi][ni][r] * s));
                const float h3 = (float)A[o] + g * (float)pw[o]; out[o] = h3; q += h3 * h3; }
            q += __shfl_xor(q, 1); q += __shfl_xor(q, 2); q += __shfl_xor(q, 4); q += __shfl_xor(q, 8);
            if (fr == 0) atomicAdd(ssq + row, q); }
    }
};

template <int HD, int NBR, int NJ> __global__ __launch_bounds__(256) void k_attn(const h16* __restrict__ proj, h16* __restrict__ mixed, const float* __restrict__ sinks) {
    constexpr int NH = (NBR == 3) ? AH : BH;
    __shared__ float qs[4][HD];
    __shared__ float sc[4][NBR * NJ + 1];
    const int wid = threadIdx.x >> 6, lane = threadIdx.x & 63;
    const int id = blockIdx.x * 4 + wid;
    const int tok = id / NH, head = id % NH;
    const int b = tok / SEQ, tpos = tok % SEQ;
    int qcol, kcol, vcol, ocol; float slope2, sink2 = -INFINITY;
    if (NBR == 3) { qcol = head * 128; kcol = 1024 + head * 128; vcol = 2048 + head * 128; ocol = head * 128; slope2 = exp2f(-(float)(head + 1)) * LOG2E; }
    else { const int kv = head / BG; qcol = 3072 + head * 64; kcol = 4096 + kv * 64; vcol = 4224 + kv * 64; ocol = 1024 + head * 64;
           slope2 = exp2f(-0.5f * (float)(head + 1)) * LOG2E; sink2 = sinks[head] * LOG2E; }
    const h16* base = proj + (size_t)b * SEQ * NIN;
    for (int d = lane; d < HD; d += 64) qs[wid][d] = (float)base[(size_t)tpos * NIN + qcol + d];
    __syncthreads();
    float mx = -INFINITY;
    for (int i = lane; i < NBR * NJ; i += 64) {
        const int br = i / NJ, j = i % NJ; const int dil = (br == 0) ? 1 : (br == 1 ? 4 : 16);
        const int s = tpos - dil * j; float v = -INFINITY;
        if (s >= 0) { const h16* kr = base + (size_t)s * NIN + kcol; float a = 0.f;
            for (int d = 0; d < HD; d += 8) { const half8 kk = *(const half8*)(kr + d);
#pragma unroll
                for (int e = 0; e < 8; ++e) a += qs[wid][d + e] * (float)kk[e]; }
            v = a - slope2 * (float)(dil * j); }
        sc[wid][i] = v; mx = fmaxf(mx, v);
    }
    mx = wave_max(mx); mx = fmaxf(mx, sink2);
    __syncthreads();
    float sum = 0.f;
    for (int i = lane; i < NBR * NJ; i += 64) { const float pv = exp2f(sc[wid][i] - mx); sc[wid][i] = pv; sum += pv; }
    sum = wave_sum(sum); sum += exp2f(sink2 - mx);
    __syncthreads();
    constexpr int DPL = HD / 64;
    float o[DPL]; UNR for (int e = 0; e < DPL; ++e) o[e] = 0.f;
    for (int i = 0; i < NBR * NJ; ++i) {
        const float pv = sc[wid][i]; if (pv == 0.f) continue;
        const int br = i / NJ, j = i % NJ; const int dil = (br == 0) ? 1 : (br == 1 ? 4 : 16);
        const int s = tpos - dil * j; const h16* vr = base + (size_t)s * NIN + vcol + lane * DPL;
        UNR for (int e = 0; e < DPL; ++e) o[e] += pv * (float)vr[e];
    }
    const float inv = 1.f / sum;
    UNR for (int e = 0; e < DPL; ++e) mixed[(size_t)tok * D + ocol + lane * DPL + e] = (h16)(o[e] * inv);
}

__global__ __launch_bounds__(256) void k_route(const h16* __restrict__ h1, const float* __restrict__ Wr, const float* __restrict__ b_grp, const float* __restrict__ b_exp,
                                               float* __restrict__ r2, int* __restrict__ cnt, int* __restrict__ ltok, float* __restrict__ lw) {
    const int wid = threadIdx.x >> 6, lane = threadIdx.x & 63; const int tok = blockIdx.x * 4 + wid;
    float v[32];
    float ss = 0.f;
    UNR for (int j = 0; j < 4; ++j) { const half8 hv = *(const half8*)(h1 + (size_t)tok * D + j * 512 + lane * 8);
#pragma unroll
        for (int e = 0; e < 8; ++e) { v[j * 8 + e] = (float)hv[e]; ss += v[j * 8 + e] * v[j * 8 + e]; } }
    ss = wave_sum(ss); const float rs = 1.0f / sqrtf(ss * (1.0f / D) + EPS);
    __shared__ float slg[4][40];
    float* lg = slg[wid];
    for (int c = 0; c < 36; ++c) { float a = 0.f;
        UNR for (int j = 0; j < 4; ++j) { const float* w = Wr + (size_t)c * D + j * 512 + lane * 8;
#pragma unroll
            for (int e = 0; e < 8; ++e) a += v[j * 8 + e] * w[e]; }
        a = wave_sum(a); if (lane == 0) lg[c] = a * rs + (c < 4 ? b_grp[c] : b_exp[c - 4]); }
    __builtin_amdgcn_s_waitcnt(0);
    if (lane == 0) {
        r2[tok] = rs;
        int gi = 0; float gm = lg[0]; for (int g = 1; g < 4; ++g) if (lg[g] > gm) { gm = lg[g]; gi = g; }
        float gs = 0.f; for (int g = 0; g < 4; ++g) gs += __expf(lg[g] - gm);
        const float gw = 1.f / gs;
        int i0 = 0; float v0 = lg[4 + gi * 8]; for (int e = 1; e < 8; ++e) if (lg[4 + gi * 8 + e] > v0) { v0 = lg[4 + gi * 8 + e]; i0 = e; }
        int i1 = -1; float v1 = -INFINITY; for (int e = 0; e < 8; ++e) if (e != i0 && lg[4 + gi * 8 + e] > v1) { v1 = lg[4 + gi * 8 + e]; i1 = e; }
        const float e1 = __expf(v1 - v0); const float w0 = gw / (1.f + e1), w1 = gw * e1 / (1.f + e1);
        const int ea = gi * 8 + i0, eb = gi * 8 + i1;
        const int pa = atomicAdd(cnt + ea, 1); ltok[(size_t)ea * T + pa] = tok; lw[(size_t)ea * T + pa] = w0;
        const int pb = atomicAdd(cnt + eb, 1); ltok[(size_t)eb * T + pb] = tok | (1 << 30); lw[(size_t)eb * T + pb] = w1;
    }
}
__global__ __launch_bounds__(256) void k_combine(const h16* __restrict__ h1, const h16* __restrict__ y, h16* __restrict__ h2, float* __restrict__ r3) {
    const int wid = threadIdx.x >> 6, lane = threadIdx.x & 63; const int tok = blockIdx.x * 4 + wid;
    float ss = 0.f;
    UNR for (int j = 0; j < 4; ++j) { const size_t o = (size_t)tok * D + j * 512 + lane * 8;
        const half8 a = *(const half8*)(h1 + o), b = *(const half8*)(y + o), c = *(const half8*)(y + (size_t)T * D + o); half8 r;
#pragma unroll
        for (int e = 0; e < 8; ++e) { const float s = (float)a[e] + (float)b[e] + (float)c[e]; ss += s * s; r[e] = (h16)s; }
        *(half8*)(h2 + o) = r; }
    ss = wave_sum(ss); if (lane == 0) r3[tok] = 1.0f / sqrtf(ss * (1.0f / D) + EPS);
}
__global__ __launch_bounds__(256) void k_final(float* __restrict__ out, const float* __restrict__ ssq, const float* __restrict__ g) {
    const int wid = threadIdx.x >> 6, lane = threadIdx.x & 63; const int tok = blockIdx.x * 4 + wid;
    const float rs = 1.0f / sqrtf(ssq[tok] * (1.0f / D) + EPS);
    for (int j = 0; j < 8; ++j) { const size_t o = (size_t)tok * D + j * 256 + lane * 4; f32x4 v = *(f32x4*)(out + o); const f32x4 gg = *(const f32x4*)(g + j * 256 + lane * 4);
        v.x *= rs * gg.x; v.y *= rs * gg.y; v.z *= rs * gg.z; v.w *= rs * gg.w; *(f32x4*)(out + o) = v; }
}

}
struct Bufs {
    const float *x, *p, *w_in, *w_out, *sinks, *g_mix, *g_moe, *g_ple, *g_final, *w_grp, *b_grp, *w_exp, *b_exp, *w_gate, *w_up, *w_down, *w_ple, *w_pg;
    float* out; unsigned char* ws;
    float *r1, *r2, *r3, *ssq, *lw, *Wr; int *cnt, *ltok; h16* Wr16;
    h16 *WinT, *WoutT, *WguT, *WdT, *WpleT, *WpgT, *p16, *pw16, *x16, *mixed, *hid, *h2, *proj, *y, *h1;
};
static Bufs make_bufs(void* const* d_in, void* d_out, void* d_ws) {
    Bufs b{};
    const float** f = (const float**)d_in;
    b.x = f[0]; b.p = f[1]; b.w_in = f[2]; b.w_out = f[3]; b.sinks = f[4]; b.g_mix = f[5]; b.g_moe = f[6]; b.g_ple = f[7]; b.g_final = f[8];
    b.w_grp = f[9]; b.b_grp = f[10]; b.w_exp = f[11]; b.b_exp = f[12]; b.w_gate = f[13]; b.w_up = f[14]; b.w_down = f[15]; b.w_ple = f[16]; b.w_pg = f[17];
    b.out = (float*)d_out; b.ws = (unsigned char*)d_ws; unsigned char* w = b.ws;
    b.cnt = (int*)(w + WS_CTL + CTL_CNT); b.ssq = (float*)(w + WS_CTL + CTL_SSQ);
    b.r1 = (float*)(w + WS_R1); b.r2 = (float*)(w + WS_R2); b.r3 = (float*)(w + WS_R3);
    b.ltok = (int*)(w + WS_LTOK); b.lw = (float*)(w + WS_LW); b.Wr = (float*)(w + WS_WR); b.Wr16 = (h16*)(w + WS_WR16);
    b.WinT = (h16*)(w + WS_WIN); b.WoutT = (h16*)(w + WS_WOUT); b.WguT = (h16*)(w + WS_WGU); b.WdT = (h16*)(w + WS_WD); b.WpleT = (h16*)(w + WS_WPLE); b.WpgT = (h16*)(w + WS_WPG);
    b.p16 = (h16*)(w + WS_P16); b.pw16 = (h16*)(w + WS_PW16);
    b.x16 = (h16*)(w + WS_RA); b.mixed = b.x16; b.hid = b.x16; b.h2 = b.x16;
    b.proj = (h16*)(w + WS_RB); b.y = b.proj; b.h1 = (h16*)(w + WS_RD);
    return b;
}
static void naive_prep(const Bufs& b, hipStream_t s) {
    nv::k_prep_x<<<T / 4, 256, 0, s>>>(b.x, b.x16, b.r1, b.p, b.p16);
    { nv::TrJob j{b.w_in, nullptr, b.WinT, b.g_mix, NIN, D, NIN, 1, 0, 0}; nv::k_transpose<<<dim3(NIN / 64, D / 64, 1), 256, 0, s>>>(j); }
    { nv::TrJob j{b.w_out, nullptr, b.WoutT, nullptr, D, D, D, 0, 0, 0}; nv::k_transpose<<<dim3(D / 64, D / 64, 1), 256, 0, s>>>(j); }
    { nv::TrJob j{b.w_gate, b.w_up, b.WguT, b.g_moe, DE, D, 256, 2, (long)D * DE, (long)256 * D}; nv::k_transpose<<<dim3(256 / 64, D / 64, NE * 2), 256, 0, s>>>(j); }
    { nv::TrJob j{b.w_down, nullptr, b.WdT, nullptr, D, DE, D, 0, (long)DE * D, (long)D * DE}; nv::k_transpose<<<dim3(D / 64, DE / 64, NE), 256, 0, s>>>(j); }
    { nv::TrJob j{b.w_ple, nullptr, b.WpleT, nullptr, D, PLE, D, 0, 0, 0}; nv::k_transpose<<<dim3(D / 64, PLE / 64, 1), 256, 0, s>>>(j); }
    { nv::TrJob j{b.w_pg, nullptr, b.WpgT, b.g_ple, D, D, D, 0, 0, 0}; nv::k_transpose<<<dim3(D / 64, D / 64, 1), 256, 0, s>>>(j); }
    nv::k_router_w<<<(36 * D + 255) / 256, 256, 0, s>>>(b.w_grp, b.w_exp, b.g_moe, b.Wr);
}
static void naive_gemm1(const Bufs& b, hipStream_t s) { nv::OpG1 o; o.K = D; o.A = b.x16; o.Bt = b.WinT; o.r1 = b.r1; o.out = b.proj; nv::k_gemm<<<dim3(NIN / 128, T / 128, 1), 256, 0, s>>>(o); }
static void naive_pw(const Bufs& b, hipStream_t s) { nv::OpPW o; o.K = PLE; o.A = b.p16; o.Bt = b.WpleT; o.out = b.pw16; nv::k_gemm<<<dim3(D / 128, T / 128, 1), 256, 0, s>>>(o); }
static void naive_attn(const Bufs& b, hipStream_t s) {
    nv::k_attn<128, 3, 129><<<T * AH / 4, 256, 0, s>>>(b.proj, b.mixed, b.sinks);
    nv::k_attn<64, 1, 128><<<T * BH / 4, 256, 0, s>>>(b.proj, b.mixed, b.sinks);
}
static void naive_gemm3(const Bufs& b, hipStream_t s) { nv::OpG3 o; o.K = D; o.A = b.mixed; o.Bt = b.WoutT; o.x = b.x; o.out = b.h1; nv::k_gemm<<<dim3(D / 128, T / 128, 1), 256, 0, s>>>(o); }
static void naive_route(const Bufs& b, hipStream_t s) { nv::k_route<<<T / 4, 256, 0, s>>>(b.h1, b.Wr, b.b_grp, b.b_exp, b.r2, b.cnt, b.ltok, b.lw); }
static void naive_moe_up(const Bufs& b, hipStream_t s) { nv::OpMU o; o.K = D; o.A = b.h1; o.Wgu = b.WguT; o.cnt = b.cnt; o.ltok = b.ltok; o.lw = b.lw; o.r2 = b.r2; o.hid = b.hid;
    nv::k_gemm<<<dim3(512 / 128, T / 128, NE), 256, 0, s>>>(o); }
static void naive_moe_down(const Bufs& b, hipStream_t s) { nv::OpMD o; o.K = DE; o.hid = b.hid; o.Wd = b.WdT; o.cnt = b.cnt; o.ltok = b.ltok; o.y = b.y;
    nv::k_gemm<<<dim3(D / 128, T / 128, NE), 256, 0, s>>>(o); }
static void naive_combine(const Bufs& b, hipStream_t s) { nv::k_combine<<<T / 4, 256, 0, s>>>(b.h1, b.y, b.h2, b.r3); }
static void naive_gemm5(const Bufs& b, hipStream_t s) { nv::OpG5 o; o.K = D; o.A = b.h2; o.Bt = b.WpgT; o.r3 = b.r3; o.pw = b.pw16; o.out = b.out; o.ssq = b.ssq;
    nv::k_gemm<<<dim3(D / 128, T / 128, 1), 256, 0, s>>>(o); }
static void naive_final(const Bufs& b, hipStream_t s) { nv::k_final<<<T / 4, 256, 0, s>>>(b.out, b.ssq, b.g_final); }
namespace g8 {
#define G8_LAS __attribute__((address_space(3)))
constexpr int BM = 256, BK = 64, HALF = 128, HTB = HALF * BK * 2  , STAGE_BYTES = 8 * HTB, NXCD = 8, WGM = 8;

__host__ __device__ __forceinline__ int lds_byte(int r, int c) { const int st = (r >> 4) * 2 + (c >> 5), rr = r & 15, cc = c & 31, ob = rr * 64 + cc * 2; return st * 1024 + (ob ^ (((ob >> 9) & 1) << 5)); }
__host__ __device__ __forceinline__ void stage_rc(int b, int& R, int& C) { const int st = b / 1024, sb = b % 1024, swz = sb ^ (((sb >> 9) & 1) << 5); R = (st >> 1) * 16 + swz / 64; C = (st & 1) * 32 + (swz % 64) / 2; }
__host__ __device__ __forceinline__ int perm32(int rho) { const int n = rho >> 4, i = rho & 15; return 8 * (i >> 2) + 4 * n + (i & 3); }

struct Unit { int pm, pn, a0, a1, a2, a3; };
struct Gemm { const h16* A; const h16* Bt; int K; };

struct StaticOrder {
    int nM, nN, nwg, G, c;
    __device__ void init(int M, int N, int G_, int c_) { nM = M / BM; nN = N / BM; nwg = nM * nN; G = G_; c = c_; }
    __device__ bool next(int i, Unit& u) const {
        const long L = (long)i * G + c; if (L >= nwg) return false;
        int wgid = (int)L; { const int q = nwg / NXCD, r = nwg % NXCD, xcd = wgid % NXCD, off = wgid / NXCD; wgid = (xcd < r ? xcd * (q + 1) : r * (q + 1) + (xcd - r) * q) + off; }
        const int nig = WGM * nN, gid = wgid / nig, fm = gid * WGM, gsz = (nM - fm) < WGM ? (nM - fm) : WGM;
        u.pm = fm + ((wgid % nig) % gsz); u.pn = (wgid % nig) / gsz; u.a0 = u.a1 = u.a2 = u.a3 = 0; return true;
    }
    __device__ __forceinline__ unsigned arow(const Unit& u, int r) const { return (unsigned)(u.pm * BM + r); }
};

__device__ __forceinline__ unsigned pk_h2(float lo, float hi) { f32x2 v = {lo, hi}; return __builtin_bit_cast(unsigned, __builtin_convertvector(v, h16x2)); }

template <class Epi, class Sched, bool ALIGN_EPI = true>
__device__ __forceinline__ void gemm_phase(G8_LAS unsigned char* lds, const Gemm g, const Sched& S, const Epi& E) {
    const int tid = threadIdx.x, wid = __builtin_amdgcn_readfirstlane(tid >> 6), lane = tid & 63, wr = wid >> 2, wc = wid & 3, fr = lane & 15, fq = lane >> 4;
    const int K = g.K, nt = K / BK;
    unsigned voffB[2];
#pragma unroll
    for (int i = 0; i < 2; ++i) { int R, C; stage_rc(tid * 16 + i * 8192, R, C); const int Rb = Epi::PERM ? ((R & ~31) + perm32(R & 31)) : R; voffB[i] = (unsigned)(Rb * K + C) * 2u; }
    const unsigned pitch = (unsigned)K * 2u;
    const size_t kstep = (size_t)(BK * 2);
    const size_t hstep = (size_t)HALF * K * 2;
    const size_t tstep = 2 * hstep;
    const unsigned ldsw = (unsigned)wid * 1024u;
    const int aoff = lds_byte(wr * 64 + fr, fq * 8), boff = lds_byte(wc * 32 + fr, fq * 8);
#define G8_SA(b, h) (((b) * 2 + (h)) * HTB)
#define G8_SB(b, h) ((4 + (b) * 2 + (h)) * HTB)
#define G8_STAGE(bufoff, gbase, voff) do { _Pragma("unroll") for (int _i = 0; _i < 2; ++_i) \
        __builtin_amdgcn_global_load_lds((const unsigned*)((const char*)(gbase) + (voff)[_i]), (G8_LAS unsigned*)(lds + (bufoff) + ldsw + _i * 8192), 16, 0, 0); } while (0)
#define G8_LDA(dst, b, h) do { _Pragma("unroll") for (int m = 0; m < 4; ++m) _Pragma("unroll") for (int k = 0; k < 2; ++k) dst[m][k] = *(const G8_LAS half8*)(lds + G8_SA(b, h) + aoff + m * 2048 + k * 1024); } while (0)
#define G8_LDB(dst, b, h) do { _Pragma("unroll") for (int n = 0; n < 2; ++n) _Pragma("unroll") for (int k = 0; k < 2; ++k) dst[n][k] = *(const G8_LAS half8*)(lds + G8_SB(b, h) + boff + n * 2048 + k * 1024); } while (0)
#define G8_MMA(ai, bj, At, Bt) do { __builtin_amdgcn_s_setprio(1); _Pragma("unroll") for (int m = 0; m < 4; ++m) _Pragma("unroll") for (int n = 0; n < 2; ++n) _Pragma("unroll") for (int k = 0; k < 2; ++k) \
        acc[ai][bj][m][n] = __builtin_amdgcn_mfma_f32_16x16x32_f16(Bt[n][k], At[m][k], acc[ai][bj][m][n], 0, 0, 0); __builtin_amdgcn_s_setprio(0); } while (0)
#define G8_WAIT_V(n) asm volatile("s_waitcnt vmcnt(" #n ")" ::: "memory")
#define G8_WAIT_L(n) asm volatile("s_waitcnt lgkmcnt(" #n ")" ::: "memory")
#define G8_BAR __builtin_amdgcn_s_barrier()
#define G8_SCHED __builtin_amdgcn_sched_barrier(0)
#define G8_SETVO(dst, u) do { int _t = tid; asm volatile("" : "+v"(_t)); _Pragma("unroll") for (int _i = 0; _i < 2; ++_i) { int _R, _C; stage_rc(_t * 16 + _i * 8192, _R, _C); \
        _Pragma("unroll") for (int _h = 0; _h < 2; ++_h) dst[_h][_i] = S.arow(u, _h * HALF + _R) * pitch + (unsigned)_C * 2u; } } while (0)
    Unit cur, nxt; int ui = 0;
    if (!S.next(0, cur)) return;
    f32x4 acc[2][2][4][2];
#pragma unroll
    for (int a = 0; a < 2; ++a)
#pragma unroll
        for (int b = 0; b < 2; ++b)
#pragma unroll
            for (int m = 0; m < 4; ++m)
#pragma unroll
                for (int n = 0; n < 2; ++n) acc[a][b][m][n] = (f32x4){0.f, 0.f, 0.f, 0.f};
    half8 At[4][2], B0[2][2], B1[2][2];
    unsigned cv[2][2], nv[2][2];
    G8_SETVO(cv, cur);
    const char* const gA = (const char*)g.A;
    const char* cB = (const char*)g.Bt + (size_t)cur.pn * tstep;
    G8_STAGE(G8_SB(0, 0), cB, voffB); G8_STAGE(G8_SB(0, 1), cB + hstep, voffB); G8_STAGE(G8_SA(0, 0), gA, cv[0]); G8_STAGE(G8_SA(0, 1), gA, cv[1]);
    if (wr == 1) G8_BAR;
    G8_WAIT_V(2); G8_BAR;
    G8_STAGE(G8_SB(1, 0), cB + kstep, voffB); G8_STAGE(G8_SA(1, 0), gA + kstep, cv[0]); G8_STAGE(G8_SB(1, 1), cB + hstep + kstep, voffB);
    G8_WAIT_V(6); G8_BAR;
    for (;;) {
        const bool has_next = S.next(ui + 1, nxt);
        if (has_next) { G8_SETVO(nv, nxt); } else {
#pragma unroll
            for (int _h = 0; _h < 2; ++_h)
#pragma unroll
                for (int _i = 0; _i < 2; ++_i) nv[_h][_i] = cv[_h][_i]; }
        const char* nB = has_next ? (const char*)g.Bt + (size_t)nxt.pn * tstep : cB;
#pragma nounroll
        for (int t = 0; t < nt; t += 2) {
            const bool last = (t == nt - 2);
            const char* a1 = gA + (size_t)(t + 1) * kstep;
            const char* a2 = last ? gA : gA + (size_t)(t + 2) * kstep; const char* b2 = last ? nB : cB + (size_t)(t + 2) * kstep;
            const char* a3 = a2 + kstep; const char* b3 = b2 + kstep;
            unsigned v20[2], v21[2];
#pragma unroll
            for (int _i = 0; _i < 2; ++_i) { v20[_i] = last ? nv[0][_i] : cv[0][_i]; v21[_i] = last ? nv[1][_i] : cv[1][_i]; }
            G8_LDB(B0, 0, 0); G8_LDB(B1, 0, 1); G8_SCHED; G8_LDA(At, 0, 0); G8_STAGE(G8_SA(1, 1), a1, cv[1]);
            G8_WAIT_V(8); G8_WAIT_L(0); G8_BAR; G8_MMA(0, 0, At, B0); G8_MMA(0, 1, At, B1); G8_BAR; G8_SCHED;
            G8_LDA(At, 0, 1); G8_STAGE(G8_SB(0, 0), b2, voffB); G8_STAGE(G8_SB(0, 1), b2 + hstep, voffB); G8_STAGE(G8_SA(0, 0), a2, v20);
            G8_WAIT_V(8); G8_WAIT_L(0); G8_BAR; G8_MMA(1, 0, At, B0); G8_MMA(1, 1, At, B1); G8_BAR; G8_SCHED;
            G8_LDB(B0, 1, 0); G8_LDB(B1, 1, 1); G8_SCHED; G8_LDA(At, 1, 0); G8_STAGE(G8_SA(0, 1), a2, v21);
            G8_WAIT_V(8); G8_WAIT_L(0); G8_BAR; G8_MMA(0, 0, At, B0); G8_MMA(0, 1, At, B1); G8_BAR; G8_SCHED;
            G8_LDA(At, 1, 1); G8_STAGE(G8_SB(1, 0), b3, voffB); G8_STAGE(G8_SB(1, 1), b3 + hstep, voffB); G8_STAGE(G8_SA(1, 0), a3, v20);
            G8_WAIT_V(8); G8_WAIT_L(0); G8_BAR; G8_MMA(1, 0, At, B0); G8_MMA(1, 1, At, B1); G8_BAR; G8_SCHED;
        }
        if constexpr (ALIGN_EPI) { if (wr == 0) G8_BAR; }
        E(acc, cur, wr, wc, fr, fq);
        if (!has_next) break;
#pragma unroll
        for (int a = 0; a < 2; ++a)
#pragma unroll
            for (int b = 0; b < 2; ++b)
#pragma unroll
                for (int m = 0; m < 4; ++m)
#pragma unroll
                    for (int n = 0; n < 2; ++n) acc[a][b][m][n] = (f32x4){0.f, 0.f, 0.f, 0.f};
        cur = nxt; cB = nB; ++ui;
#pragma unroll
        for (int _h = 0; _h < 2; ++_h)
#pragma unroll
            for (int _i = 0; _i < 2; ++_i) cv[_h][_i] = nv[_h][_i];
        if constexpr (ALIGN_EPI) { if (wr == 1) G8_BAR; }
    }
    G8_WAIT_V(0);
    if constexpr (!ALIGN_EPI) { if (wr == 0) G8_BAR; }
    G8_BAR;
#undef G8_SA
#undef G8_SB
#undef G8_STAGE
#undef G8_LDA
#undef G8_LDB
#undef G8_MMA
#undef G8_WAIT_V
#undef G8_WAIT_L
#undef G8_BAR
#undef G8_SCHED
#undef G8_SETVO
}
}
namespace g8 {
#define EPI_ROWS UNR for (int ai = 0; ai < 2; ++ai) UNR for (int m = 0; m < 4; ++m)
#define EPI_FENCE asm volatile("" ::: "memory")
#define RFL(x) __builtin_amdgcn_readfirstlane(x)

struct EpiProj {
    static constexpr bool PERM = true;
    h16* out; const float* r1;
    __device__ __forceinline__ void operator()(const f32x4 (&acc)[2][2][4][2], const Unit& u, int wr, int wc, int fr, int fq) const {
        const int row0 = u.pm * BM + wr * 64 + fr, col0 = u.pn * BM + wc * 32 + 8 * fq;
        EPI_ROWS { const int row = row0 + ai * HALF + m * 16; const float s = r1[row]; h16* rp = out + (size_t)row * NIN + col0;
            UNR for (int bj = 0; bj < 2; ++bj) { const f32x4 v0 = acc[ai][bj][m][0] * s, v1 = acc[ai][bj][m][1] * s;
                u32x4 w; w.x = pk_h2(v0[0], v0[1]); w.y = pk_h2(v0[2], v0[3]); w.z = pk_h2(v1[0], v1[1]); w.w = pk_h2(v1[2], v1[3]); *(u32x4*)(rp + bj * HALF) = w; } EPI_FENCE; }
    }
};
struct EpiPlain {
    static constexpr bool PERM = true;
    h16* out; int ldc;
    __device__ __forceinline__ void operator()(const f32x4 (&acc)[2][2][4][2], const Unit& u, int wr, int wc, int fr, int fq) const {
        const int row0 = u.pm * BM + wr * 64 + fr, col0 = u.pn * BM + wc * 32 + 8 * fq;
        EPI_ROWS { const int row = row0 + ai * HALF + m * 16; h16* rp = out + (size_t)row * ldc + col0;
            UNR for (int bj = 0; bj < 2; ++bj) { const f32x4 v0 = acc[ai][bj][m][0], v1 = acc[ai][bj][m][1];
                u32x4 w; w.x = pk_h2(v0[0], v0[1]); w.y = pk_h2(v0[2], v0[3]); w.z = pk_h2(v1[0], v1[1]); w.w = pk_h2(v1[2], v1[3]); *(u32x4*)(rp + bj * HALF) = w; } EPI_FENCE; }
    }
};
struct EpiRes {
    static constexpr bool PERM = true;
    h16* out; const float* x;
    __device__ __forceinline__ void operator()(const f32x4 (&acc)[2][2][4][2], const Unit& u, int wr, int wc, int fr, int fq) const {
        const int row0 = u.pm * BM + wr * 64 + fr, col0 = u.pn * BM + wc * 32 + 8 * fq;
        EPI_ROWS { const int row = row0 + ai * HALF + m * 16; const size_t o = (size_t)row * D + col0;
            UNR for (int bj = 0; bj < 2; ++bj) { const f32x4 x0 = *(const f32x4*)(x + o + bj * HALF), x1 = *(const f32x4*)(x + o + bj * HALF + 4);
                const f32x4 v0 = acc[ai][bj][m][0] + x0, v1 = acc[ai][bj][m][1] + x1;
                u32x4 w; w.x = pk_h2(v0[0], v0[1]); w.y = pk_h2(v0[2], v0[3]); w.z = pk_h2(v1[0], v1[1]); w.w = pk_h2(v1[2], v1[3]); *(u32x4*)(out + o + bj * HALF) = w; } EPI_FENCE; }
    }
};
struct EpiMoeUp {
    static constexpr bool PERM = true;
    h16* hid; const int* ltok; const float* lw; const float* r2;
    __device__ __forceinline__ void operator()(const f32x4 (&acc)[2][2][4][2], const Unit& u, int wr, int wc, int fr, int fq) const {
        const int e = u.a0, hc0 = (u.pn & 1) * 128 + wc * 32 + 8 * fq;
        EPI_ROWS { const int rr = ai * HALF + wr * 64 + m * 16 + fr; if (rr < u.a1) {
            const size_t li = (size_t)e * T + u.a3 + rr; const int tok = ltok[li] & 0x3fff; const float s = r2[tok], w = lw[li];
            float hv[8];
            UNR for (int n = 0; n < 2; ++n) UNR for (int j = 0; j < 4; ++j) { const float gt = acc[ai][0][m][n][j] * s, up = acc[ai][1][m][n][j] * s;
                hv[n * 4 + j] = gt / (1.f + __expf(-gt)) * up * w; }
            u32x4 o; o.x = pk_h2(hv[0], hv[1]); o.y = pk_h2(hv[2], hv[3]); o.z = pk_h2(hv[4], hv[5]); o.w = pk_h2(hv[6], hv[7]);
            *(u32x4*)(hid + (size_t)(u.a2 + rr) * DE + hc0) = o; } EPI_FENCE; }
    }
};
struct EpiMoeDown {
    static constexpr bool PERM = true;
    h16* y; const int* ltok;
    __device__ __forceinline__ void operator()(const f32x4 (&acc)[2][2][4][2], const Unit& u, int wr, int wc, int fr, int fq) const {
        const int e = u.a0, col0 = u.a2 * BM + wc * 32 + 8 * fq;
        EPI_ROWS { const int rr = ai * HALF + wr * 64 + m * 16 + fr; if (rr < u.a1) {
            const int lt = ltok[(size_t)e * T + u.a3 + rr]; const int tok = lt & 0x3fff, slot = (lt >> 30) & 1; h16* rp = y + ((size_t)slot * T + tok) * D + col0;
            UNR for (int bj = 0; bj < 2; ++bj) { const f32x4 v0 = acc[ai][bj][m][0], v1 = acc[ai][bj][m][1];
                u32x4 w; w.x = pk_h2(v0[0], v0[1]); w.y = pk_h2(v0[2], v0[3]); w.z = pk_h2(v1[0], v1[1]); w.w = pk_h2(v1[2], v1[3]); *(u32x4*)(rp + bj * HALF) = w; } } EPI_FENCE; }
    }
};
struct EpiPle {
    static constexpr bool PERM = true;
    float* out; const h16* h2; const h16* pw; const float* r3; float* ssq;
    __device__ __forceinline__ void operator()(const f32x4 (&acc)[2][2][4][2], const Unit& u, int wr, int wc, int fr, int fq) const {
        const int row0 = u.pm * BM + wr * 64 + fr, col0 = u.pn * BM + wc * 32 + 8 * fq;
        EPI_ROWS { const int row = row0 + ai * HALF + m * 16; const float s = r3[row]; const size_t o = (size_t)row * D + col0; float q = 0.f;
            UNR for (int bj = 0; bj < 2; ++bj) { const half8 hh = *(const half8*)(h2 + o + bj * HALF), pp = *(const half8*)(pw + o + bj * HALF); f32x4 r0, r1v;
                UNR for (int j = 0; j < 4; ++j) { const float g0 = 1.f / (1.f + __expf(-acc[ai][bj][m][0][j] * s)), g1 = 1.f / (1.f + __expf(-acc[ai][bj][m][1][j] * s));
                    r0[j] = (float)hh[j] + g0 * (float)pp[j]; r1v[j] = (float)hh[4 + j] + g1 * (float)pp[4 + j]; q += r0[j] * r0[j] + r1v[j] * r1v[j]; }
                *(f32x4*)(out + o + bj * HALF) = r0; *(f32x4*)(out + o + bj * HALF + 4) = r1v; }
            q += __shfl_xor(q, 16); q += __shfl_xor(q, 32);
            if (fq == 0) atomicAdd(ssq + row, q); EPI_FENCE; }
    }
};

__device__ __forceinline__ void moe_table(volatile G8_LAS int* tab, const int* cnt) {
    if (threadIdx.x == 0) { int o = 0; for (int e = 0; e < NE; ++e) { tab[e] = o; tab[64 + e] = cnt[e]; o += (cnt[e] + 255) >> 8; } tab[32] = o; }
}
struct MoeUpOrder {
    const volatile G8_LAS int* tab; const int* ltok; int G, v;
    __device__ bool next(int i, Unit& u) const {
        const int L = i * G + v; const int total = RFL(tab[32]); if (L >= 2 * total) return false;
        int e = 0; UNR for (int k = 1; k < NE; ++k) e = (L >= 2 * tab[k]) ? k : e;
        const int base = tab[e], nte = tab[e + 1] - base, l = L - 2 * base, pn = l / nte, rt = l - pn * nte;
        u.pm = RFL(rt); u.pn = RFL(e * 2 + pn); u.a0 = RFL(e); u.a1 = RFL(tab[64 + e] - rt * 256); u.a2 = RFL((base + rt) * 256); u.a3 = RFL(rt * 256); return true;
    }
    __device__ __forceinline__ unsigned arow(const Unit& u, int r) const { return (r < u.a1) ? (unsigned)(ltok[(size_t)u.a0 * T + u.a3 + r] & 0x3fff) : 0u; }
};
struct MoeDownOrder {
    const volatile G8_LAS int* tab; int G, v;
    __device__ bool next(int i, Unit& u) const {
        const int L = i * G + v; const int total = RFL(tab[32]); if (L >= 8 * total) return false;
        const int gt = L >> 3, pn = L & 7;
        int e = 0; UNR for (int k = 1; k < NE; ++k) e = (gt >= tab[k]) ? k : e;
        const int rt = gt - tab[e];
        u.pm = RFL(gt); u.pn = RFL(e * 8 + pn); u.a0 = RFL(e); u.a1 = RFL(tab[64 + e] - rt * 256); u.a2 = RFL(pn); u.a3 = RFL(rt * 256); return true;
    }
    __device__ __forceinline__ unsigned arow(const Unit& u, int r) const { return (unsigned)(u.pm * BM + r); }
};
}
constexpr int NWAVES = 8;
constexpr int RING_OFF = 0, RING_BYTES = 131072;
constexpr int LDSCTL_OFF = RING_BYTES, MISC_OFF = LDSCTL_OFF, TAB_OFF = LDSCTL_OFF + 512;
constexpr int LDS_BYTES = 147456;
constexpr int CW_TMO = 0, CW_CODE = 1, CW_BAR = 4096;

#define GAS __attribute__((address_space(1)))
#define LAS __attribute__((address_space(3)))
typedef GAS unsigned gu32;
#define RLX_AGENT __ATOMIC_RELAXED, __HIP_MEMORY_SCOPE_AGENT
#define LDS_WAIT() asm volatile("s_waitcnt lgkmcnt(0)" ::: "memory")
#define VM_WAIT() asm volatile("s_waitcnt vmcnt(0)" ::: "memory")

#define XB_TMO      128
#define XB_XCNT(j)  (256  + 64 * (j))
#define XB_XSUB(j)  (1280 + 64 * (j))
#define XB_XGEN(j)  (2304 + 64 * (j))
#define XB_TOP      3328
#define XB_TOPGEN   3392
#define XCD_BAR_WORDS 3456
#define XB_SPIN_CAP (1u << 18)
__device__ __forceinline__ unsigned xb_ld(unsigned* p)              { return __hip_atomic_load(p, __ATOMIC_RELAXED, __HIP_MEMORY_SCOPE_AGENT); }
__device__ __forceinline__ unsigned xb_add(unsigned* p, unsigned v) { return __hip_atomic_fetch_add(p, v, __ATOMIC_RELAXED, __HIP_MEMORY_SCOPE_AGENT); }
__device__ __forceinline__ unsigned xb_xcc_id() { return (unsigned)__builtin_amdgcn_s_getreg((3 << 11) | 20) & 0xFu; }
#define XB_SPIN(cond, bar) do { unsigned _sp = 0; while (cond) { __builtin_amdgcn_s_sleep(1); \
    if ((++_sp & 255u) == 0u) { if (xb_ld(&(bar)[XB_TMO])) break; if (_sp > XB_SPIN_CAP) { atomicAdd(&(bar)[XB_TMO], 1u); break; } } } } while (0)
struct XcdBarrier { unsigned* bar; unsigned x; volatile LAS unsigned* st; };
__device__ __forceinline__ XcdBarrier xcd_barrier_post(unsigned* bar, volatile LAS unsigned* st) {
    XcdBarrier b; b.bar = bar; b.x = xb_xcc_id(); b.st = st;
    if (threadIdx.x == 0) (void)xb_add(&bar[XB_XCNT(b.x)], 1u);
    return b;
}
__device__ __forceinline__ void xcd_barrier_complete(unsigned* bar, unsigned x, unsigned& nloc, unsigned& nx) {
    const unsigned G = gridDim.x * gridDim.y * gridDim.z;
    unsigned sum, cnt, mine, sp = 0u;
    for (;;) {
        sum = 0u; cnt = 0u; mine = 0u;
#pragma unroll
        for (unsigned j = 0; j < 16; ++j) { const unsigned c = xb_ld(&bar[XB_XCNT(j)]); sum += c; cnt += (c > 0u) ? 1u : 0u; mine = (j == x) ? c : mine; }
        if (sum == G) break;
        __builtin_amdgcn_s_sleep(1);
        if ((++sp & 255u) == 0u) { if (xb_ld(&bar[XB_TMO])) break; if (sp > XB_SPIN_CAP) { atomicAdd(&bar[XB_TMO], 1u); break; } }
    }
    nloc = mine > 0u ? mine : 1u; nx = cnt > 0u ? cnt : 1u;
}
__device__ __forceinline__ void xcd_barrier(const XcdBarrier& b) {
    asm volatile("s_waitcnt vmcnt(0)" ::: "memory");
    __syncthreads();
    if (threadIdx.x == 0) {
        unsigned* bar = b.bar;
        __builtin_amdgcn_s_waitcnt(0);
        unsigned nloc = b.st[0], nx = b.st[1];
        if (nloc == 0u) { xcd_barrier_complete(bar, b.x, nloc, nx); b.st[0] = nloc; b.st[1] = nx; }
        const unsigned old = xb_add(&bar[XB_XSUB(b.x)], 1u);
        const unsigned gen = old / nloc;
        if (old + 1u == (gen + 1u) * nloc) {
            __builtin_amdgcn_fence(__ATOMIC_RELEASE, "agent");
            asm volatile("s_waitcnt vmcnt(0)" ::: "memory");
            const unsigned og = xb_add(&bar[XB_TOP], 1u);
            const unsigned tg = og / nx;
            if (og + 1u == (tg + 1u) * nx) xb_add(&bar[XB_TOPGEN], 1u);
            else XB_SPIN(xb_ld(&bar[XB_TOPGEN]) == tg, bar);
            __builtin_amdgcn_fence(__ATOMIC_ACQUIRE, "agent");
            xb_add(&bar[XB_XGEN(b.x)], 1u);
            asm volatile("s_waitcnt vmcnt(0)" ::: "memory");
        } else {
            XB_SPIN(xb_ld(&bar[XB_XGEN(b.x)]) == gen, bar);
            __builtin_amdgcn_fence(__ATOMIC_ACQUIRE, "agent");
            asm volatile("s_waitcnt vmcnt(0)" ::: "memory");
        }
    }
    __syncthreads();
}

struct Args { Bufs b; int ph_lo, ph_hi, li, pad; };

struct Frame {
    LAS unsigned char* lds;
    int tid, lane, wave, vcu, G;
};
__device__ __forceinline__ float wave_sum(float v) {
#pragma unroll
    for (int o = 1; o < 64; o <<= 1) v += __shfl_xor(v, o);
    return v;
}
__device__ __forceinline__ float wave_max(float v) {
#pragma unroll
    for (int o = 1; o < 64; o <<= 1) v = fmaxf(v, __shfl_xor(v, o));
    return v;
}

__device__ __forceinline__ void p0_item(const float* W, int pitch, int K, h16* WT, int scol0, int drow0, int k0, const float* gain, float cs, LAS float* scr, int lane) {
    const int kr = lane >> 3, nc = (lane & 7) * 4;
    f32x4 v[8]; float gn[8];
#pragma unroll
    for (int i = 0; i < 8; ++i) v[i] = *(const f32x4*)(W + (size_t)(k0 + kr + 8 * i) * pitch + scol0 + nc);
#pragma unroll
    for (int i = 0; i < 8; ++i) gn[i] = gain ? gain[k0 + kr + 8 * i] * cs : cs;
#pragma unroll
    for (int i = 0; i < 8; ++i) { LAS float* d = scr + (kr + 8 * i) * 33 + nc; d[0] = v[i].x * gn[i]; d[1] = v[i].y * gn[i]; d[2] = v[i].z * gn[i]; d[3] = v[i].w * gn[i]; }
    LDS_WAIT(); asm volatile("" ::: "memory");
    const int c = lane & 7;
#pragma unroll
    for (int j = 0; j < 4; ++j) { const int n = (lane >> 3) + 8 * j; const LAS float* s = scr + (8 * c) * 33 + n;
        u32x4 o; o.x = g8::pk_h2(s[0 * 33], s[1 * 33]); o.y = g8::pk_h2(s[2 * 33], s[3 * 33]); o.z = g8::pk_h2(s[4 * 33], s[5 * 33]); o.w = g8::pk_h2(s[6 * 33], s[7 * 33]);
        *(u32x4*)(WT + (size_t)(drow0 + n) * K + k0 + 8 * c) = o; }
    LDS_WAIT(); asm volatile("" ::: "memory");
}
__device__ __forceinline__ void phase_prologue(const Frame& F, const Bufs& b) {
    LAS float* scr = (LAS float*)(F.lds + RING_OFF + F.wave * 16384);
    const int gw = F.vcu * NWAVES + F.wave, NGW = F.G * NWAVES, lane = F.lane;
    constexpr int I0 = 32 * 136, I1 = 32 * 64, I2 = 64 * 256, I3 = 32 * 256, I4 = 4 * 64, I5 = 32 * 64, NITEMS = I0 + I1 + I2 + I3 + I4 + I5;
    for (int row = gw; row < T; row += NGW) {
        const float* xr = b.x + (size_t)row * D; float ss = 0.f;
#pragma unroll
        for (int j = 0; j < D / 256; ++j) { const f32x4 v = *(const f32x4*)(xr + j * 256 + lane * 4); ss += v.x * v.x + v.y * v.y + v.z * v.z + v.w * v.w;
            u32x2 o; o.x = g8::pk_h2(v.x, v.y); o.y = g8::pk_h2(v.z, v.w); *(u32x2*)(b.x16 + (size_t)row * D + j * 256 + lane * 4) = o; }
        ss = wave_sum(ss); if (lane == 0) b.r1[row] = 1.0f / sqrtf(ss * (1.0f / D) + EPS);
        { const f32x4 v = *(const f32x4*)(b.p + (size_t)row * PLE + lane * 4); u32x2 o; o.x = g8::pk_h2(v.x, v.y); o.y = g8::pk_h2(v.z, v.w); *(u32x2*)(b.p16 + (size_t)row * PLE + lane * 4) = o; }
    }
    for (int it = gw; it < NITEMS; it += NGW) {
        int r = it;
        if (r < I0) { const int kb = r / 136, nb = r % 136, n0 = 32 * nb; const float cs = (n0 < 1024) ? QSCALE_A : ((n0 >= 3072 && n0 < 4096) ? QSCALE_B : 1.f);
            p0_item(b.w_in, NIN, D, b.WinT, n0, n0, 64 * kb, b.g_mix, cs, scr, lane); continue; } r -= I0;
        if (r < I1) { const int kb = r / 64, nb = r % 64; p0_item(b.w_out, D, D, b.WoutT, 32 * nb, 32 * nb, 64 * kb, nullptr, 1.f, scr, lane); continue; } r -= I1;
        if (r < I2) { const int z = r / 256, q = r % 256, kb = q / 8, nb = q % 8, n0 = 32 * nb, e = z >> 1, pn = z & 1;
            const float* src = ((n0 < 128) ? b.w_gate : b.w_up) + (size_t)e * D * DE;
            p0_item(src, DE, D, b.WguT + (size_t)z * 256 * D, 128 * pn + (n0 & 127), n0, 64 * kb, b.g_moe, 1.f, scr, lane); continue; } r -= I2;
        if (r < I3) { const int e = r / 256, q = r % 256, kb = q / 64, nb = q % 64;
            p0_item(b.w_down + (size_t)e * DE * D, D, DE, b.WdT + (size_t)e * D * DE, 32 * nb, 32 * nb, 64 * kb, nullptr, 1.f, scr, lane); continue; } r -= I3;
        if (r < I4) { const int kb = r / 64, nb = r % 64; p0_item(b.w_ple, D, PLE, b.WpleT, 32 * nb, 32 * nb, 64 * kb, nullptr, 1.f, scr, lane); continue; } r -= I4;
        { const int kb = r / 64, nb = r % 64; p0_item(b.w_pg, D, D, b.WpgT, 32 * nb, 32 * nb, 64 * kb, b.g_ple, 1.f, scr, lane); }
    }
    for (int idx = (F.vcu * NWAVES * 64) + F.tid; idx < 80 * D; idx += F.G * NWAVES * 64) {
        const int c = idx / D, k = idx % D; h16 o = (h16)0.f;
        if (c < 72) { const int cc = (c < 36) ? c : c - 36; const float v = ((cc < 4) ? b.w_grp[(size_t)k * 4 + cc] : b.w_exp[(size_t)k * 32 + (cc - 4)]) * b.g_moe[k];
            const h16 hi = (h16)v; o = (c < 36) ? hi : (h16)(v - (float)hi); }
        b.Wr16[idx] = o;
    }
}

template <int HD, int NBR, int NJ> __device__ __forceinline__ void attn_wave_task(const Bufs& b, int id, LAS float* qs, LAS float* sc, int lane) {
    constexpr int NH = (NBR == 3) ? AH : BH;
    const int tok = id / NH, head = id % NH; const int bb = tok / SEQ, tpos = tok % SEQ;
    int qcol, kcol, vcol, ocol; float slope2, sink2 = -INFINITY;
    if (NBR == 3) { qcol = head * 128; kcol = 1024 + head * 128; vcol = 2048 + head * 128; ocol = head * 128; slope2 = exp2f(-(float)(head + 1)) * LOG2E; }
    else { const int kv = head / BG; qcol = 3072 + head * 64; kcol = 4096 + kv * 64; vcol = 4224 + kv * 64; ocol = 1024 + head * 64; slope2 = exp2f(-0.5f * (float)(head + 1)) * LOG2E; sink2 = b.sinks[head] * LOG2E; }
    const h16* base = b.proj + (size_t)bb * SEQ * NIN;
    for (int d = lane; d < HD; d += 64) qs[d] = (float)base[(size_t)tpos * NIN + qcol + d];
    LDS_WAIT();
    float mx = -INFINITY;
    for (int i = lane; i < NBR * NJ; i += 64) {
        const int br = i / NJ, j = i % NJ; const int dil = (br == 0) ? 1 : (br == 1 ? 4 : 16); const int s = tpos - dil * j; float v = -INFINITY;
        if (s >= 0) { const h16* kr = base + (size_t)s * NIN + kcol; float a = 0.f;
            for (int d = 0; d < HD; d += 8) { const half8 kk = *(const half8*)(kr + d);
#pragma unroll
                for (int e = 0; e < 8; ++e) a += qs[d + e] * (float)kk[e]; }
            v = a - slope2 * (float)(dil * j); }
        sc[i] = v; mx = fmaxf(mx, v);
    }
    mx = wave_max(mx); mx = fmaxf(mx, sink2);
    LDS_WAIT();
    float sum = 0.f;
    for (int i = lane; i < NBR * NJ; i += 64) { const float pv = exp2f(sc[i] - mx); sc[i] = pv; sum += pv; }
    sum = wave_sum(sum); sum += exp2f(sink2 - mx);
    LDS_WAIT();
    constexpr int DPL = HD / 64;
    float o[DPL];
#pragma unroll
    for (int e = 0; e < DPL; ++e) o[e] = 0.f;
    for (int i = 0; i < NBR * NJ; ++i) {
        const float pv = sc[i]; if (pv == 0.f) continue;
        const int br = i / NJ, j = i % NJ; const int dil = (br == 0) ? 1 : (br == 1 ? 4 : 16); const int s = tpos - dil * j; const h16* vr = base + (size_t)s * NIN + vcol + lane * DPL;
#pragma unroll
        for (int e = 0; e < DPL; ++e) o[e] += pv * (float)vr[e];
    }
    const float inv = 1.f / sum;
#pragma unroll
    for (int e = 0; e < DPL; ++e) b.mixed[(size_t)tok * D + ocol + lane * DPL + e] = (h16)(o[e] * inv);
    LDS_WAIT();
}
__device__ __forceinline__ void phase_attn_simple(const Frame& F, const Bufs& b) {
    LAS float* qs = (LAS float*)(F.lds + RING_OFF + F.wave * 4096); LAS float* sc = qs + 128;
    const int gw = F.vcu * NWAVES + F.wave, NGW = F.G * NWAVES;
    for (int id = gw; id < T * AH; id += NGW) attn_wave_task<128, 3, 129>(b, id, qs, sc, F.lane);
    for (int id = gw; id < T * BH; id += NGW) attn_wave_task<64, 1, 128>(b, id, qs, sc, F.lane);
}

__device__ __forceinline__ void phase_route(const Frame& F, const Bufs& b) {
    constexpr int SLOT = 18432, NSLOT = 6, NCH = D / 64, AHEAD = 5;
    const int lane = F.lane, fr = lane & 15, fq = lane >> 4, w = F.wave, rt = w & 3, cg = w >> 2;
    LAS unsigned char* ring = F.lds + RING_OFF;
    LAS float* lg = (LAS float*)ring;
    LAS float* sq = lg + 64 * 81;
    LAS int* lcnt = (LAS int*)(sq + 64);
    LAS int* lbase = lcnt + 32;
    const int prow = lane >> 3, pch = (lane & 7) ^ (prow & 7);
    for (int tb = F.vcu; tb < T / 64; tb += F.G) {
        const int r0 = tb * 64;
        const h16* asrc = b.h1 + (size_t)(r0 + 8 * w + prow) * D + pch * 8;
        const h16* bsrc0 = b.Wr16 + (size_t)(8 * w + prow) * D + pch * 8;
        const h16* bsrc1 = b.Wr16 + (size_t)(64 + 8 * w + prow) * D + pch * 8;
#define RT_ISSUE(c) do { const int _sl = ((c) % NSLOT) * SLOT; \
        __builtin_amdgcn_global_load_lds((const unsigned*)(asrc + (c) * 64), (LAS unsigned*)(ring + _sl + w * 1024), 16, 0, 0); \
        __builtin_amdgcn_global_load_lds((const unsigned*)(bsrc0 + (c) * 64), (LAS unsigned*)(ring + _sl + 8192 + w * 1024), 16, 0, 0); \
        if (w < 2) __builtin_amdgcn_global_load_lds((const unsigned*)(bsrc1 + (c) * 64), (LAS unsigned*)(ring + _sl + 8192 + 8192 + w * 1024), 16, 0, 0); } while (0)
        for (int c = 0; c < AHEAD; ++c) RT_ISSUE(c);
        f32x4 acc0 = {0.f, 0.f, 0.f, 0.f}, acc1 = acc0, acc2 = acc0; float ss = 0.f;
        const int arow = rt * 16 + fr, brow = cg * 48 + fr;
#pragma unroll 1
        for (int c = 0; c < NCH; ++c) {
            if (c + AHEAD <= NCH) { if (w < 2) asm volatile("s_waitcnt vmcnt(12)" ::: "memory"); else asm volatile("s_waitcnt vmcnt(8)" ::: "memory"); }
            else asm volatile("s_waitcnt vmcnt(0)" ::: "memory");
            __builtin_amdgcn_s_barrier();
            asm volatile("" ::: "memory");
            if (c + AHEAD < NCH) RT_ISSUE(c + AHEAD);
            asm volatile("" ::: "memory");
            const LAS unsigned char* sl = ring + (c % NSLOT) * SLOT;
#pragma unroll
            for (int ks = 0; ks < 2; ++ks) {
                const half8 a = *(const LAS half8*)(sl + arow * 128 + (((ks * 4 + fq) ^ (arow & 7)) << 4));
                const half8 b0 = *(const LAS half8*)(sl + 8192 + brow * 128 + (((ks * 4 + fq) ^ (brow & 7)) << 4));
                const half8 b1 = *(const LAS half8*)(sl + 8192 + (brow + 16) * 128 + (((ks * 4 + fq) ^ (brow & 7)) << 4));
                acc0 = __builtin_amdgcn_mfma_f32_16x16x32_f16(a, b0, acc0, 0, 0, 0);
                acc1 = __builtin_amdgcn_mfma_f32_16x16x32_f16(a, b1, acc1, 0, 0, 0);
                if (cg == 0) { const half8 b2 = *(const LAS half8*)(sl + 8192 + (brow + 32) * 128 + (((ks * 4 + fq) ^ (brow & 7)) << 4));
                    acc2 = __builtin_amdgcn_mfma_f32_16x16x32_f16(a, b2, acc2, 0, 0, 0);
#pragma unroll
                    for (int j = 0; j < 8; ++j) { const float v = (float)a[j]; ss += v * v; } }
            }
        }
#undef RT_ISSUE
        LDS_WAIT(); __syncthreads();
#pragma unroll
        for (int r = 0; r < 4; ++r) { const int row = rt * 16 + 4 * fq + r; lg[row * 81 + cg * 48 + fr] = acc0[r]; lg[row * 81 + cg * 48 + 16 + fr] = acc1[r]; if (cg == 0) lg[row * 81 + 32 + fr] = acc2[r]; }
        if (cg == 0) { ss += __shfl_xor(ss, 16); ss += __shfl_xor(ss, 32); if (fq == 0) sq[rt * 16 + fr] = ss; }
        if (F.tid < 32) lcnt[F.tid] = 0;
        LDS_WAIT(); __syncthreads();
        int ea = 0, eb = 0, ra = 0, rb = 0; float w0 = 0.f, w1 = 0.f;
        if (F.tid < 64) {
            const LAS float* L = lg + F.tid * 81;
            const float rs = 1.0f / sqrtf(sq[F.tid] * (1.0f / D) + EPS);
            float gl[4];
#pragma unroll
            for (int g = 0; g < 4; ++g) gl[g] = (L[g] + L[36 + g]) * rs + b.b_grp[g];
            int gi = 0; float gm = gl[0];
#pragma unroll
            for (int g = 1; g < 4; ++g) if (gl[g] > gm) { gm = gl[g]; gi = g; }
            float gs = 0.f;
#pragma unroll
            for (int g = 0; g < 4; ++g) gs += __expf(gl[g] - gm);
            const float gw = 1.f / gs;
            int i0 = 0, i1 = 0; float v0 = -INFINITY, v1 = -INFINITY;
            for (int e = 0; e < 8; ++e) { const float v = (L[4 + gi * 8 + e] + L[40 + gi * 8 + e]) * rs + b.b_exp[gi * 8 + e];
                if (v > v0) { v1 = v0; i1 = i0; v0 = v; i0 = e; } else if (v > v1) { v1 = v; i1 = e; } }
            const float e1 = __expf(v1 - v0); w0 = gw / (1.f + e1); w1 = gw * e1 / (1.f + e1);
            ea = gi * 8 + i0; eb = gi * 8 + i1;
            b.r2[r0 + F.tid] = rs;
            ra = atomicAdd((int*)(lcnt + ea), 1); rb = atomicAdd((int*)(lcnt + eb), 1);
        }
        LDS_WAIT(); __syncthreads();
        if (F.tid < 32) { const int n = lcnt[F.tid]; lbase[F.tid] = n ? atomicAdd(b.cnt + F.tid, n) : 0; }
        LDS_WAIT(); __syncthreads();
        if (F.tid < 64) {
            const int tok = r0 + F.tid; const int pa = lbase[ea] + ra, pb = lbase[eb] + rb;
            b.ltok[(size_t)ea * T + pa] = tok; b.lw[(size_t)ea * T + pa] = w0;
            b.ltok[(size_t)eb * T + pb] = tok | (1 << 30); b.lw[(size_t)eb * T + pb] = w1;
        }
        __syncthreads();
    }
}

__device__ __forceinline__ void phase_combine(const Frame& F, const Bufs& b) {
    const int gw = F.vcu * NWAVES + F.wave, NGW = F.G * NWAVES, lane = F.lane;
    for (int tok = gw; tok < T; tok += NGW) {
        float ss = 0.f;
#pragma unroll
        for (int j = 0; j < 4; ++j) { const size_t o = (size_t)tok * D + j * 512 + lane * 8;
            const half8 a = *(const half8*)(b.h1 + o), c0 = *(const half8*)(b.y + o), c1 = *(const half8*)(b.y + (size_t)T * D + o); half8 r;
#pragma unroll
            for (int e = 0; e < 8; ++e) { const float s = (float)a[e] + (float)c0[e] + (float)c1[e]; ss += s * s; r[e] = (h16)s; }
            *(half8*)(b.h2 + o) = r; }
        ss = wave_sum(ss); if (lane == 0) b.r3[tok] = 1.0f / sqrtf(ss * (1.0f / D) + EPS);
    }
}
__device__ __forceinline__ void phase_final(const Frame& F, const Bufs& b) {
    const int gw = F.vcu * NWAVES + F.wave, NGW = F.G * NWAVES, lane = F.lane;
    for (int tok = gw; tok < T; tok += NGW) {
        const float rs = 1.0f / sqrtf(b.ssq[tok] * (1.0f / D) + EPS);
#pragma unroll
        for (int j = 0; j < 8; ++j) { const size_t o = (size_t)tok * D + j * 256 + lane * 4; f32x4 v = *(f32x4*)(b.out + o); const f32x4 gg = *(const f32x4*)(b.g_final + j * 256 + lane * 4);
            v.x *= rs * gg.x; v.y *= rs * gg.y; v.z *= rs * gg.z; v.w *= rs * gg.w; *(f32x4*)(b.out + o) = v; }
    }
}
namespace at {
typedef short v4i16 __attribute__((ext_vector_type(4)));
struct Task {
    const h16* qbase;
    const h16* kbase;
    const h16* vbase;
    int dil, rho;
    int ql0;
    int maxdelta;
    float slope2;
};
__device__ __forceinline__ void glds16(const void* gsrc, unsigned lds_dst) { unsigned keep;
    asm volatile("s_mov_b32 %0, m0\n\ts_mov_b32 m0, %2\n\ts_nop 0\n\tglobal_load_lds_dwordx4 %1, off\n\ts_mov_b32 m0, %0" : "=&s"(keep) : "v"(gsrc), "s"(lds_dst) : "memory"); }
__device__ __forceinline__ half8 tr_pair(const LAS unsigned char* p) {
    const v4i16 lo = __builtin_amdgcn_ds_read_tr16_b64_v4i16((LAS v4i16*)p), hi = __builtin_amdgcn_ds_read_tr16_b64_v4i16((LAS v4i16*)(p + 512));
    typedef short s8 __attribute__((ext_vector_type(8)));
    const s8 r = {lo[0], lo[1], lo[2], lo[3], hi[0], hi[1], hi[2], hi[3]};
    return __builtin_bit_cast(half8, r);
}
template <int HD> __device__ __forceinline__ void run_task(const Task& t, LAS unsigned char* wbuf, int lane, float& m_out, float& l_out, f32x16 (&O)[HD / 32]) {
    constexpr int ND0 = HD / 16, NDB = HD / 32, NP = NDB * 2, KB = HD * 64;
    constexpr int CPR = HD / 8, RPP = 64 / CPR;
    constexpr float THR = 6.f;
    const int r32 = lane & 31, hi = lane >> 5;
    LAS unsigned char* kbuf = wbuf; LAS unsigned char* vbuf = wbuf + KB;
    half8 qf[ND0];
    { const h16* qp = t.qbase + (size_t)(t.dil * (t.ql0 + r32) + t.rho) * NIN + hi * 8;
#pragma unroll
      for (int d0 = 0; d0 < ND0; ++d0) qf[d0] = *(const half8*)(qp + 16 * d0); }
    const int j1 = t.ql0 >> 5, j0 = (j1 - 4) > 0 ? (j1 - 4) : 0;
    const int krow = lane / CPR, kcp = lane % CPR;
    const h16* kp = t.kbase + (size_t)(t.dil * krow + t.rho) * NIN;
    const h16* vp = t.vbase + (size_t)(t.dil * (lane >> 2) + t.rho) * NIN + (lane & 3) * 8;
    const size_t tile_step = (size_t)32 * t.dil * NIN, ks_step = (size_t)16 * t.dil * NIN, kp_step = (size_t)RPP * t.dil * NIN;
    const int laneoff = ((lane >> 4) & 1) * 32 + (lane & 3) * 8 + (4 * hi + ((lane & 15) >> 2)) * 64;
    const unsigned klds = (unsigned)(uintptr_t)kbuf, vlds = (unsigned)(uintptr_t)vbuf;
#define AT_DMAK(jj) do { asm volatile("s_waitcnt lgkmcnt(0)" ::: "memory"); _Pragma("unroll") for (int _p = 0; _p < NP; ++_p) \
        glds16(kp + (size_t)(jj) * tile_step + _p * kp_step + ((kcp ^ ((RPP * _p + krow) & (CPR - 1))) << 3), (unsigned)__builtin_amdgcn_readfirstlane(klds + _p * 1024)); } while (0)
#define AT_DMAV(jj) do { asm volatile("s_waitcnt lgkmcnt(0)" ::: "memory"); _Pragma("unroll") for (int _p = 0; _p < NP; ++_p) \
        glds16(vp + (size_t)(jj) * tile_step + (_p & 1) * ks_step + (_p >> 1) * 32, (unsigned)__builtin_amdgcn_readfirstlane(vlds + _p * 1024)); } while (0)
#define AT_JOF(s_) (j0 + ((((s_) - j0) % 5) + 5) % 5)
    const float slope2d = t.slope2 * (float)t.dil;
    float cr[16];
#pragma unroll
    for (int r = 0; r < 16; ++r) cr[r] = slope2d * (float)((r & 3) + 8 * (r >> 2));
    float m = -1e30f, l = 0.f;
#pragma unroll
    for (int b = 0; b < NDB; ++b)
#pragma unroll
        for (int r = 0; r < 16; ++r) O[b][r] = 0.f;
    int s = 0; while (AT_JOF(s) > j1) ++s;
    int j = AT_JOF(s);
    AT_DMAK(j); AT_DMAV(j);
    const LAS unsigned char* kfp = kbuf + r32 * (HD * 2);
    for (;;) {
        int ns = s + 1; while (ns < 5 && AT_JOF(ns) > j1) ++ns;
        const bool has_next = ns < 5; const int jn = has_next ? AT_JOF(ns) : j;
        if (NP == 8) asm volatile("s_waitcnt vmcnt(8)" ::: "memory"); else asm volatile("s_waitcnt vmcnt(4)" ::: "memory");
        half8 kf[ND0];
#pragma unroll
        for (int d0 = 0; d0 < ND0; ++d0) kf[d0] = *(const LAS half8*)(kfp + (((2 * d0 + hi) ^ (r32 & (CPR - 1))) << 4));
        f32x16 S;
#pragma unroll
        for (int r = 0; r < 16; ++r) S[r] = 0.f;
#pragma unroll
        for (int d0 = 0; d0 < ND0; ++d0) S = __builtin_amdgcn_mfma_f32_32x32x16_f16(kf[d0], qf[d0], S, 0, 0, 0);
        asm volatile("" ::: "memory");
        if (has_next) AT_DMAK(jn);
        asm volatile("" ::: "memory");
#pragma unroll
        for (int r = 0; r < 16; ++r) S[r] += cr[r];
        if (j == j1) {
            const int dq = r32 - 4 * hi;
#pragma unroll
            for (int r = 0; r < 16; ++r) S[r] = (dq - ((r & 3) + 8 * (r >> 2)) >= 0) ? S[r] : -INFINITY;
        }
        if (j == j1 - 4) {
            const int dq = 128 + r32 - 4 * hi - t.maxdelta;
#pragma unroll
            for (int r = 0; r < 16; ++r) S[r] = (dq - ((r & 3) + 8 * (r >> 2)) <= 0) ? S[r] : -INFINITY;
        }
        float mx = fmaxf(fmaxf(S[0], S[1]), S[2]);
#pragma unroll
        for (int r = 3; r < 15; r += 2) mx = fmaxf(fmaxf(mx, S[r]), S[r + 1]);
        mx = fmaxf(mx, S[15]);
        const float tb = t.slope2 * (float)(t.dil * (32 * j + 4 * hi) + t.rho);
        float mxt = mx + tb; mxt = fmaxf(mxt, __shfl_xor(mxt, 32));
        if (__any(mxt > m + THR)) {
            const float mn = fmaxf(m, mxt), alpha = __builtin_amdgcn_exp2f(m - mn); m = mn; l *= alpha;
#pragma unroll
            for (int b = 0; b < NDB; ++b)
#pragma unroll
                for (int r = 0; r < 16; ++r) O[b][r] *= alpha;
        }
        const float e = m - tb; float ps = 0.f;
#pragma unroll
        for (int r = 0; r < 16; ++r) { S[r] = __builtin_amdgcn_exp2f(S[r] - e); ps += S[r]; }
        l += ps;
        half8 pf[2];
#pragma unroll
        for (int sx = 0; sx < 2; ++sx) { u32x4 w; w.x = g8::pk_h2(S[8 * sx + 0], S[8 * sx + 1]); w.y = g8::pk_h2(S[8 * sx + 2], S[8 * sx + 3]); w.z = g8::pk_h2(S[8 * sx + 4], S[8 * sx + 5]); w.w = g8::pk_h2(S[8 * sx + 6], S[8 * sx + 7]); pf[sx] = __builtin_bit_cast(half8, w); }
        if (has_next) { if (NP == 8) asm volatile("s_waitcnt vmcnt(8)" ::: "memory"); else asm volatile("s_waitcnt vmcnt(4)" ::: "memory"); }
        else asm volatile("s_waitcnt vmcnt(0)" ::: "memory");
#pragma unroll
        for (int b = 0; b < NDB; ++b)
#pragma unroll
            for (int sx = 0; sx < 2; ++sx) { const half8 vf = tr_pair(vbuf + b * 2048 + sx * 1024 + laneoff); O[b] = __builtin_amdgcn_mfma_f32_32x32x16_f16(vf, pf[sx], O[b], 0, 0, 0); }
        asm volatile("" ::: "memory");
        if (!has_next) break;
        AT_DMAV(jn);
        s = ns; j = jn;
    }
    asm volatile("s_waitcnt lgkmcnt(0)" ::: "memory");
#undef AT_DMAK
#undef AT_DMAV
#undef AT_JOF
    l += __shfl_xor(l, 32);
    m_out = m; l_out = l;
}
template <int HD> __device__ __forceinline__ void stage_rows(LAS unsigned char* wbuf, const f32x16 (&O)[HD / 32], float sc, int r32, int hi) {
    constexpr int PITCH = HD * 2 + 16;
#pragma unroll
    for (int b = 0; b < HD / 32; ++b)
#pragma unroll
        for (int g = 0; g < 4; ++g) { u32x2 w; w.x = g8::pk_h2(O[b][4 * g] * sc, O[b][4 * g + 1] * sc); w.y = g8::pk_h2(O[b][4 * g + 2] * sc, O[b][4 * g + 3] * sc);
            *(LAS u32x2*)(wbuf + r32 * PITCH + (32 * b + 8 * g + 4 * hi) * 2) = w; }
    asm volatile("s_waitcnt lgkmcnt(0)" ::: "memory");
}
template <int HD> __device__ __forceinline__ void flush_rows(const LAS unsigned char* wbuf, h16* out, size_t ld, int tok0, int tstride, int lane) {
    constexpr int PITCH = HD * 2 + 16, CPR = HD / 8, RPI = 64 / CPR;
    const int rr = lane / CPR, ch = lane % CPR;
#pragma unroll
    for (int i = 0; i < 32 / RPI; ++i) { const int row = i * RPI + rr; const u32x4 v = *(const LAS u32x4*)(wbuf + row * PITCH + ch * 16);
        *(u32x4*)(out + (size_t)(tok0 + tstride * row) * ld + ch * 8) = v; }
    asm volatile("s_waitcnt lgkmcnt(0)" ::: "memory");
}
template <int PART = 3> __device__ __forceinline__ void phase_attn(const Frame& F, const Bufs& b, h16* exo, float* exl) {
    const int lane = F.lane, w = F.wave, r32 = lane & 31, hi = lane >> 5;
    LAS unsigned char* vbuf = F.lds + RING_OFF + w * 16384;
    if (PART & 1) for (int u = F.vcu; u < BATCH * AH * 4; u += F.G) {
        const int c = u & 3, h = (u >> 2) & 7, bb = u >> 5;
        const h16* base = b.proj + (size_t)bb * SEQ * NIN;
        Task t; t.qbase = base + h * 128; t.kbase = base + 1024 + h * 128; t.vbase = base + 2048 + h * 128; t.maxdelta = 128;
        t.slope2 = exp2f(-(float)(h + 1)) * LOG2E;
        f32x16 O[4]; float m, l;
#pragma unroll 1
        for (int k = w; k < 32; k += 8) {
            const int br = k >> 4, kk = k & 15;
            if (br == 0) { t.dil = 1; t.rho = 0; t.ql0 = 512 * c + 32 * kk; } else { t.dil = 4; t.rho = kk >> 2; t.ql0 = 128 * c + 32 * (kk & 3); }
            run_task<128>(t, vbuf, lane, m, l, O);
            const int tok = bb * SEQ + t.dil * (t.ql0 + r32) + t.rho;
            stage_rows<128>(vbuf, O, 1.f / l, r32, hi);
            flush_rows<128>(vbuf, exo + (size_t)br * T * 1024 + h * 128, 1024, bb * SEQ + t.dil * t.ql0 + t.rho, t.dil, lane);
            if (hi == 0) exl[((size_t)br * T + tok) * 8 + h] = m + __builtin_amdgcn_logf(l);
        }
        asm volatile("s_waitcnt vmcnt(0)" ::: "memory"); __syncthreads();
#pragma unroll 1
        for (int rho = w; rho < 16; rho += 8) {
            t.dil = 16; t.rho = rho; t.ql0 = 32 * c;
            run_task<128>(t, vbuf, lane, m, l, O);
            const int tok = bb * SEQ + 16 * (t.ql0 + r32) + rho;
            const float l3 = m + __builtin_amdgcn_logf(l);
            const float l1 = exl[(size_t)tok * 8 + h], l2 = exl[((size_t)T + tok) * 8 + h];
            const float M = fmaxf(fmaxf(l1, l2), l3);
            const float w1 = __builtin_amdgcn_exp2f(l1 - M), w2 = __builtin_amdgcn_exp2f(l2 - M), w3 = __builtin_amdgcn_exp2f(l3 - M);
            const float inv = 1.f / (w1 + w2 + w3); const float s1 = w1 * inv, s2 = w2 * inv, s3 = w3 * inv / l;
            stage_rows<128>(vbuf, O, s3, r32, hi);
            LAS float* sw = (LAS float*)(vbuf + 32 * 272);
            if (hi == 0) { sw[r32] = s1; sw[32 + r32] = s2; }
            asm volatile("s_waitcnt lgkmcnt(0)" ::: "memory");
            { const int rr = lane >> 4, ch = lane & 15; const int tok0 = bb * SEQ + 16 * t.ql0 + rho;
#pragma unroll
              for (int i = 0; i < 8; ++i) { const int row = 4 * i + rr; const size_t tk = (size_t)(tok0 + 16 * row);
                const half8 o3 = *(const LAS half8*)(vbuf + row * 272 + ch * 16); const float a1 = sw[row], a2 = sw[32 + row];
                const half8 x1 = *(const half8*)(exo + tk * 1024 + h * 128 + ch * 8), x2 = *(const half8*)(exo + ((size_t)T + tk) * 1024 + h * 128 + ch * 8);
                u32x4 wv; float f[8];
#pragma unroll
                for (int e = 0; e < 8; ++e) f[e] = (float)o3[e] + a1 * (float)x1[e] + a2 * (float)x2[e];
                wv.x = g8::pk_h2(f[0], f[1]); wv.y = g8::pk_h2(f[2], f[3]); wv.z = g8::pk_h2(f[4], f[5]); wv.w = g8::pk_h2(f[6], f[7]);
                *(u32x4*)(b.mixed + tk * D + h * 128 + ch * 8) = wv; }
              asm volatile("s_waitcnt lgkmcnt(0)" ::: "memory"); }
        }
        asm volatile("s_waitcnt vmcnt(0)" ::: "memory"); __syncthreads();
    }
    if (PART & 2) for (int u = F.vcu; u < BATCH * BKV * 16; u += F.G) {
        const int qb = u & 15, kv = (u >> 4) & 1, bb = u >> 5; const int hq = kv * 8 + w;
        const h16* base = b.proj + (size_t)bb * SEQ * NIN;
        Task t; t.qbase = base + 3072 + hq * 64; t.kbase = base + 4096 + kv * 64; t.vbase = base + 4224 + kv * 64; t.maxdelta = 127; t.dil = 1; t.rho = 0;
        t.slope2 = exp2f(-0.5f * (float)(hq + 1)) * LOG2E;
        const float sink2b = b.sinks[hq] * LOG2E;
        f32x16 O[2]; float m, l;
#pragma unroll 1
        for (int i = 0; i < 4; ++i) {
            t.ql0 = 128 * qb + 32 * i;
            run_task<64>(t, vbuf, lane, m, l, O);
            const float sink2 = sink2b + t.slope2 * (float)(t.ql0 + r32);
            const float mf = fmaxf(m, sink2); const float a = __builtin_amdgcn_exp2f(m - mf); const float den = l * a + __builtin_amdgcn_exp2f(sink2 - mf);
            const int tok = bb * SEQ + t.ql0 + r32;
            stage_rows<64>(vbuf, O, a / den, r32, hi);
            flush_rows<64>(vbuf, b.mixed + 1024 + hq * 64, D, bb * SEQ + t.ql0, 1, lane);
        }
    }
}
}
constexpr int NPH = 10;
__global__ void __launch_bounds__(NWAVES * 64, 2) mega(Args args) {
    extern __shared__ __attribute__((aligned(16))) unsigned char lds[];
    const Bufs& b = args.b;
    Frame F;
    F.lds = (LAS unsigned char*)lds;
    F.tid = threadIdx.x; F.lane = F.tid & 63; F.wave = __builtin_amdgcn_readfirstlane(F.tid >> 6);
    F.G = gridDim.x; { const int bx = blockIdx.x; F.vcu = (F.G % 8 == 0) ? (bx % 8) * (F.G / 8) + bx / 8 : bx; }
    volatile LAS unsigned* MISC = (volatile LAS unsigned*)(F.lds + MISC_OFF);
    volatile LAS int* tab = (volatile LAS int*)(F.lds + TAB_OFF);
    for (int u = F.tid; u < (LDS_BYTES - LDSCTL_OFF) / 4; u += NWAVES * 64) ((LAS unsigned*)(F.lds + LDSCTL_OFF))[u] = 0u;
    __syncthreads();
    unsigned* ctl = (unsigned*)(b.ws + WS_CTL);
    XcdBarrier bar = xcd_barrier_post(ctl + CW_BAR + args.li * XCD_BAR_WORDS, MISC + 8);
    const int lo = args.ph_lo, hi = args.ph_hi;
#ifdef ONLY_PHASE
#define IN(k) ((k) == ONLY_PHASE && lo <= (k) && (k) < hi)
#else
#define IN(k) (lo <= (k) && (k) < hi)
#endif
#define SEAM(k) do { if (IN(k) && IN((k) + 1)) xcd_barrier(bar); } while (0)
#ifdef PROBE_PHASE
#define PH(k, ...) do { if (IN(k)) { __VA_ARGS__ if ((k) == PROBE_PHASE) { xcd_barrier(bar); __VA_ARGS__ } } SEAM(k); } while (0)
#else
#define PH(k, ...) do { if (IN(k)) { __VA_ARGS__ } SEAM(k); } while (0)
#endif
    G8_LAS unsigned char* ring = F.lds + RING_OFF;

    PH(0, phase_prologue(F, b););
    PH(1,
        { g8::Gemm g{b.x16, b.WinT, D}; g8::StaticOrder S; S.init(T, NIN, F.G, (int)blockIdx.x); g8::EpiProj E{b.proj, b.r1}; g8::gemm_phase<g8::EpiProj, g8::StaticOrder>(ring, g, S, E); }
        { g8::Gemm g{b.p16, b.WpleT, PLE}; g8::StaticOrder S; S.init(T, D, F.G, (int)blockIdx.x); g8::EpiPlain E{b.pw16, D}; g8::gemm_phase<g8::EpiPlain, g8::StaticOrder>(ring, g, S, E); });
#if defined(PROBE_PHASE) && (PROBE_PHASE >= 21 && PROBE_PHASE <= 29)
    if (IN(2)) { at::phase_attn<(PROBE_PHASE <= 22 ? PROBE_PHASE - 20 : 1), (PROBE_PHASE <= 22 ? 0 : PROBE_PHASE - 22)>(F, b, (h16*)(b.ws + WS_RD), (float*)(b.ws + WS_LTOK)); xcd_barrier(bar); at::phase_attn(F, b, (h16*)(b.ws + WS_RD), (float*)(b.ws + WS_LTOK)); } SEAM(2);
#else
    PH(2, at::phase_attn(F, b, (h16*)(b.ws + WS_RD), (float*)(b.ws + WS_LTOK)););
#endif
    PH(3, { g8::Gemm g{b.mixed, b.WoutT, D}; g8::StaticOrder S; S.init(T, D, F.G, (int)blockIdx.x); g8::EpiRes E{b.h1, b.x}; g8::gemm_phase<g8::EpiRes, g8::StaticOrder>(ring, g, S, E); });
#if defined(PROBE_PHASE) && PROBE_PHASE == 4
    if (IN(4)) { phase_route(F, b); xcd_barrier(bar); if (blockIdx.x == 0 && F.tid < 32) b.cnt[F.tid] = 0; xcd_barrier(bar); phase_route(F, b); } SEAM(4);
#else
    PH(4, phase_route(F, b););
#endif
    PH(5, { g8::moe_table(tab, b.cnt); LDS_WAIT(); __syncthreads();
        g8::Gemm g{b.h1, b.WguT, D}; g8::MoeUpOrder S{tab, b.ltok, F.G, F.vcu}; g8::EpiMoeUp E{b.hid, b.ltok, b.lw, b.r2}; g8::gemm_phase<g8::EpiMoeUp, g8::MoeUpOrder>(ring, g, S, E); });
    PH(6, { g8::moe_table(tab, b.cnt); LDS_WAIT(); __syncthreads();
        g8::Gemm g{b.hid, b.WdT, DE}; g8::MoeDownOrder S{tab, F.G, F.vcu}; g8::EpiMoeDown E{b.y, b.ltok}; g8::gemm_phase<g8::EpiMoeDown, g8::MoeDownOrder>(ring, g, S, E); });
    PH(7, phase_combine(F, b););
#if defined(PROBE_PHASE) && PROBE_PHASE == 8
    if (IN(8)) { { g8::Gemm g{b.h2, b.WpgT, D}; g8::StaticOrder S; S.init(T, D, F.G, (int)blockIdx.x); g8::EpiPle E{b.out, b.h2, b.pw16, b.r3, (float*)(b.ws + WS_R1)}; g8::gemm_phase<g8::EpiPle, g8::StaticOrder>(ring, g, S, E); } xcd_barrier(bar);
                 { g8::Gemm g{b.h2, b.WpgT, D}; g8::StaticOrder S; S.init(T, D, F.G, (int)blockIdx.x); g8::EpiPle E{b.out, b.h2, b.pw16, b.r3, b.ssq}; g8::gemm_phase<g8::EpiPle, g8::StaticOrder>(ring, g, S, E); } } SEAM(8);
#else
    PH(8, { g8::Gemm g{b.h2, b.WpgT, D}; g8::StaticOrder S; S.init(T, D, F.G, (int)blockIdx.x); g8::EpiPle E{b.out, b.h2, b.pw16, b.r3, b.ssq}; g8::gemm_phase<g8::EpiPle, g8::StaticOrder>(ring, g, S, E); });
#endif
    PH(9, phase_final(F, b););
#undef IN
#undef SEAM
#undef PH
}

static int g_grid = 0;
static bool mega_setup() {
    if (g_grid) return g_grid > 0;
    int dev = 0, cus = 0, per_cu = 0;
    if (hipGetDevice(&dev) != hipSuccess || hipDeviceGetAttribute(&cus, hipDeviceAttributeMultiprocessorCount, dev) != hipSuccess) { g_grid = -1; return false; }
    if (hipFuncSetAttribute((const void*)mega, hipFuncAttributeMaxDynamicSharedMemorySize, LDS_BYTES) != hipSuccess) { fprintf(stderr, "hipFuncSetAttribute failed\n"); g_grid = -1; return false; }
    if (hipOccupancyMaxActiveBlocksPerMultiprocessor(&per_cu, (const void*)mega, NWAVES * 64, LDS_BYTES) != hipSuccess || per_cu < 1) { fprintf(stderr, "occupancy query: %d\n", per_cu); (void)hipGetLastError(); g_grid = -1; return false; }
    g_grid = cus;
    return true;
}
static void mega_run(const Bufs& b, int lo, int hi, int li, hipStream_t s) {
    Args a{}; a.b = b; a.ph_lo = lo; a.ph_hi = hi; a.li = li; a.pad = 0;
    hipLaunchKernelGGL(mega, dim3(g_grid), dim3(NWAVES * 64), LDS_BYTES, s, a);
}
extern "C" void kernel_launch(void* const* d_in, const int* in_sizes, int n_in, void* d_out, int out_size, void* d_ws, size_t ws_size, hipStream_t stream) {
    if (n_in != 18 || out_size != T * D || ws_size < WS_END) { fprintf(stderr, "kernel_launch: unexpected shapes: n_in %d out %d ws %zu\n", n_in, out_size, ws_size); return; }
    if (!mega_setup()) return;
    Bufs b = make_bufs(d_in, d_out, d_ws);
    (void)hipMemsetAsync((char*)d_ws + WS_CTL, 0, CTL_ZERO_BYTES, stream);
    mega_run(b, 0, NPH, 0, stream);
}
```
